# Optimizing an MI355X kernel written in HIP

```python
import jax
import jax.numpy as jnp
from jax import lax
import numpy as np

D_MODEL = 1024
BATCH = 16
SEQ = 2048
DEPTH = 2

M_HEADS = 4
M_DQK = 128
M_DV = 256
M_CONV = 4
M_CHUNK = 64
GATE_CAP = 15.0
G_HEADS = 4
G_DK = 128
G_DV = 256
G_RANK = 16
G_TAU = 16.0
G_CHUNK = 64
N_EXPERTS = 64
TOP_K = 8
N_GROUPS = 8
TOPK_GROUPS = 4
D_EXPERT = 256
D_SHARED = 256
ROUTED_SCALE = 2.5
MOE_BLOCK = 256
EPS = 1e-6

M_QK_COLS = 2 * M_HEADS * M_DQK
M_V_COLS = M_HEADS * M_DV
G_K_COLS = G_HEADS * G_DK
G_V_COLS = G_HEADS * G_DV
IN_SPLITS = (M_QK_COLS, M_V_COLS, M_V_COLS, M_HEADS, M_HEADS,
             G_K_COLS, G_K_COLS, G_V_COLS, G_RANK, G_V_COLS, D_MODEL, D_MODEL)
D_IN = M_QK_COLS + 2 * M_V_COLS + 2 * M_HEADS + 2 * G_K_COLS + 2 * G_V_COLS + G_RANK + 2 * D_MODEL

kernel_name = 'hybrid_mlstm_gla_moe_adaln'


def _rmsnorm(x, w):
    xf = x.astype(jnp.float32)
    y = xf * lax.rsqrt(jnp.mean(xf * xf, axis=-1, keepdims=True) + EPS)
    return (y * w.astype(jnp.float32)).astype(x.dtype)


def _head_rmsnorm(h, w):
    y = h * lax.rsqrt(jnp.mean(h * h, axis=-1, keepdims=True) + EPS)
    return y.reshape(h.shape[0], h.shape[1], -1) * w.astype(jnp.float32)


def _causal_conv(x, w):
    k = w.shape[0]
    s = x.shape[1]
    xp = jnp.pad(x, ((0, 0), (k - 1, 0), (0, 0)))
    return sum(xp[:, j:j + s] * w[j] for j in range(k))


def _to_chunks(t, size):
    b, s = t.shape[:2]
    t = t.reshape(b, s // size, size, *t.shape[2:])
    return jnp.moveaxis(t, 3, 1)


def _from_chunks(t):
    t = jnp.moveaxis(t, 1, 3)
    b, nc, l = t.shape[:3]
    return t.reshape(b, nc * l, *t.shape[3:])


def _mlstm_chunkwise(q, k, v, li, lf):
    f32 = jnp.float32
    q = _to_chunks(q.astype(f32) * (M_DQK ** -0.5), M_CHUNK)
    k = _to_chunks(k.astype(f32), M_CHUNK)
    v = _to_chunks(v.astype(f32), M_CHUNK)
    li = _to_chunks(li, M_CHUNK)
    b = jnp.cumsum(_to_chunks(lf, M_CHUNK), axis=-1)
    g = b[..., -1]
    a = g[..., None] - b + li

    def step(carry, inp):
        c_st, n_st, m_st = carry
        k_c, v_c, a_c, g_c = inp
        m_new = jnp.maximum(g_c + m_st, jnp.max(a_c, axis=-1))
        decay = jnp.exp(g_c + m_st - m_new)
        wk = jnp.exp(a_c - m_new[..., None])[..., None] * k_c
        c_new = decay[..., None, None] * c_st + jnp.einsum('bhld,bhle->bhde', wk, v_c)
        n_new = decay[..., None] * n_st + jnp.sum(wk, axis=2)
        return (c_new, n_new, m_new), (c_st, n_st, m_st)

    bsz, nh = q.shape[:2]
    init = (jnp.zeros((bsz, nh, M_DQK, M_DV), f32),
            jnp.zeros((bsz, nh, M_DQK), f32),
            jnp.zeros((bsz, nh), f32))
    xs = (jnp.moveaxis(k, 2, 0), jnp.moveaxis(v, 2, 0), jnp.moveaxis(a, 2, 0), jnp.moveaxis(g, 2, 0))
    _, (c_prev, n_prev, m_prev) = lax.scan(step, init, xs)
    c_prev = jnp.moveaxis(c_prev, 0, 2)
    n_prev = jnp.moveaxis(n_prev, 0, 2)
    m_prev = jnp.moveaxis(m_prev, 0, 2)

    causal = jnp.tril(jnp.ones((M_CHUNK, M_CHUNK), dtype=bool))
    d_mat = jnp.where(causal, b[..., :, None] - b[..., None, :] + li[..., None, :], -jnp.inf)
    m_inter = b + m_prev[..., None]
    m_t = jnp.maximum(jnp.max(d_mat, axis=-1), m_inter)
    p = jnp.exp(d_mat - m_t[..., None]) * jnp.einsum('bhcld,bhcsd->bhcls', q, k)
    w_inter = jnp.exp(m_inter - m_t)
    num = (jnp.einsum('bhcls,bhcse->bhcle', p, v)
           + w_inter[..., None] * jnp.einsum('bhcld,bhcde->bhcle', q, c_prev))
    den = jnp.sum(p, axis=-1) + w_inter * jnp.einsum('bhcld,bhcd->bhcl', q, n_prev)
    h = num / jnp.maximum(jnp.abs(den), jnp.exp(-m_t))[..., None]
    return _from_chunks(h)


def _gla_chunked(q, k, v, la):
    f32 = jnp.float32
    q = _to_chunks(q.astype(f32) * (G_DK ** -0.5), G_CHUNK)
    k = _to_chunks(k.astype(f32), G_CHUNK)
    v = _to_chunks(v.astype(f32), G_CHUNK)
    bc = jnp.cumsum(_to_chunks(la, G_CHUNK), axis=3)
    gc = bc[:, :, :, -1]
    q_in = q * jnp.exp(bc)
    k_in = k * jnp.exp(-bc)
    k_out = k * jnp.exp(gc[:, :, :, None, :] - bc)

    def step(s_st, inp):
        k_c, v_c, g_c = inp
        s_new = jnp.exp(g_c)[..., None] * s_st + jnp.einsum('bhld,bhle->bhde', k_c, v_c)
        return s_new, s_st

    bsz, nh = q.shape[:2]
    init = jnp.zeros((bsz, nh, G_DK, G_DV), f32)
    xs = (jnp.moveaxis(k_out, 2, 0), jnp.moveaxis(v, 2, 0), jnp.moveaxis(gc, 2, 0))
    _, s_prev = lax.scan(step, init, xs)
    s_prev = jnp.moveaxis(s_prev, 0, 2)

    causal = jnp.tril(jnp.ones((G_CHUNK, G_CHUNK), dtype=bool))
    att = jnp.where(causal, jnp.einsum('bhcld,bhcsd->bhcls', q_in, k_in), 0.0)
    o = jnp.einsum('bhcls,bhcse->bhcle', att, v) + jnp.einsum('bhcld,bhcde->bhcle', q_in, s_prev)
    return _from_chunks(o)


def _mixer(u, w_in, conv_w, gate_b, m_norm_w, alpha_w, alpha_b, g_norm_w, w_pa, w_pb, w_o):
    f32 = jnp.float32
    dt = u.dtype
    bsz, s = u.shape[:2]
    proj = u @ w_in
    parts = []
    off = 0
    for n in IN_SPLITS:
        parts.append(proj[..., off:off + n])
        off += n
    qk_m, v_m, o_m, i_m, f_m, q_g, k_g, v_g, r_g, z_g, g_a, g_b = parts

    qk_m = jax.nn.silu(_causal_conv(qk_m, conv_w))
    half = M_QK_COLS // 2
    q_m = qk_m[..., :half].reshape(bsz, s, M_HEADS, M_DQK)
    k_m = qk_m[..., half:].reshape(bsz, s, M_HEADS, M_DQK)
    li = GATE_CAP * jnp.tanh((i_m.astype(f32) + gate_b[0]) / GATE_CAP)
    lf = jax.nn.log_sigmoid(GATE_CAP * jnp.tanh((f_m.astype(f32) + gate_b[1]) / GATE_CAP))
    h_a = _mlstm_chunkwise(q_m, k_m, v_m.reshape(bsz, s, M_HEADS, M_DV), li, lf)
    h_a = _head_rmsnorm(h_a, m_norm_w) * jax.nn.sigmoid(o_m.astype(f32))

    la = jax.nn.log_sigmoid((r_g @ alpha_w + alpha_b).astype(f32)) / G_TAU
    h_b = _gla_chunked(q_g.reshape(bsz, s, G_HEADS, G_DK), k_g.reshape(bsz, s, G_HEADS, G_DK),
                       v_g.reshape(bsz, s, G_HEADS, G_DV), la.reshape(bsz, s, G_HEADS, G_DK))
    h_b = _head_rmsnorm(h_b, g_norm_w) * jax.nn.silu(z_g.astype(f32))

    y = (jax.nn.sigmoid(g_a) * (h_a.astype(dt) @ w_pa)
         + jax.nn.sigmoid(g_b) * (h_b.astype(dt) @ w_pb))
    return y @ w_o


def _moe(u, router_w, router_b, w1, w3, w2, s1, s3, s2):
    bsz, s, d = u.shape
    t = bsz * s
    xm = u.reshape(t, d)
    scores = jax.nn.sigmoid((xm @ router_w).astype(jnp.float32))
    sel = scores + router_b.astype(jnp.float32)
    grp = sel.reshape(t, N_GROUPS, N_EXPERTS // N_GROUPS)
    grp_score = jnp.sum(lax.top_k(grp, 2)[0], axis=-1)
    _, gidx = lax.top_k(grp_score, TOPK_GROUPS)
    gmask = jnp.any(gidx[..., None] == jnp.arange(N_GROUPS), axis=1)
    gmask = jnp.repeat(gmask, N_EXPERTS // N_GROUPS, axis=-1)
    _, eidx = lax.top_k(jnp.where(gmask, sel, -jnp.inf), TOP_K)
    wts = jnp.take_along_axis(scores, eidx, axis=-1)
    wts = wts / jnp.sum(wts, axis=-1, keepdims=True) * ROUTED_SCALE

    n_assign = t * TOP_K
    flat_e = eidx.reshape(-1)
    flat_tok = jnp.arange(n_assign, dtype=jnp.int32) // TOP_K
    flat_w = wts.reshape(-1)
    order = jnp.argsort(flat_e)
    se, stok, sw = flat_e[order], flat_tok[order], flat_w[order]
    counts = jnp.bincount(flat_e, length=N_EXPERTS)
    padded = (counts + MOE_BLOCK - 1) // MOE_BLOCK * MOE_BLOCK
    pend = jnp.cumsum(padded)
    pstart = pend - padded
    sstart = jnp.cumsum(counts) - counts
    dest = pstart[se] + jnp.arange(n_assign) - sstart[se]
    n_rows = n_assign + N_EXPERTS * MOE_BLOCK
    n_blocks = n_rows // MOE_BLOCK
    row_tok = jnp.zeros((n_rows,), jnp.int32).at[dest].set(stok)
    row_w = jnp.zeros((n_rows,), jnp.float32).at[dest].set(sw)
    blk_e = jnp.minimum(jnp.searchsorted(pend, jnp.arange(n_blocks) * MOE_BLOCK, side='right'),
                        N_EXPERTS - 1)

    def run_block(args):
        tok_b, w_b, e = args
        xb = xm[tok_b]
        hb = jax.nn.silu(xb @ w1[e]) * (xb @ w3[e])
        return ((hb @ w2[e]) * w_b[:, None]).astype(xm.dtype)

    out = lax.map(run_block, (row_tok.reshape(n_blocks, MOE_BLOCK),
                              row_w.reshape(n_blocks, MOE_BLOCK), blk_e))
    routed = jax.ops.segment_sum(out.reshape(n_rows, d), row_tok, num_segments=t)
    shared = (jax.nn.silu(xm @ s1) * (xm @ s3)) @ s2
    return (routed + shared).astype(u.dtype).reshape(bsz, s, d)


def setup_inputs(seed: int = 0) -> dict:
    key = jax.random.key(seed)
    ks = jax.random.split(key, 26)

    def nrm(k, shape, scale):
        return jax.random.normal(k, shape, jnp.float32) * scale

    L = DEPTH
    D = D_MODEL
    return {
        'x': nrm(ks[0], (BATCH, SEQ, D), 1.0),
        'c': nrm(ks[1], (BATCH, D), 1.0),
        'ada_w': nrm(ks[2], (L, D, 6 * D), 0.5 * D ** -0.5),
        'ada_b': nrm(ks[3], (L, 6 * D), 0.02),
        'norm_mix_w': 1.0 + nrm(ks[4], (L, D), 0.02),
        'norm_moe_w': 1.0 + nrm(ks[5], (L, D), 0.02),
        'w_in': nrm(ks[6], (L, D, D_IN), D ** -0.5),
        'm_conv_w': nrm(ks[7], (L, M_CONV, M_QK_COLS), M_CONV ** -0.5),
        'm_gate_b': jnp.stack([nrm(ks[8], (L, M_HEADS), 0.1),
                               3.0 + nrm(ks[9], (L, M_HEADS), 0.5)], axis=1),
        'm_norm_w': 1.0 + nrm(ks[10], (L, M_V_COLS), 0.02),
        'g_alpha_w': nrm(ks[11], (L, G_RANK, G_K_COLS), G_RANK ** -0.5),
        'g_alpha_b': nrm(ks[12], (L, G_K_COLS), 0.1),
        'g_norm_w': 1.0 + nrm(ks[13], (L, G_V_COLS), 0.02),
        'w_pa': nrm(ks[14], (L, M_V_COLS, D), M_V_COLS ** -0.5),
        'w_pb': nrm(ks[15], (L, G_V_COLS, D), G_V_COLS ** -0.5),
        'w_o': nrm(ks[16], (L, D, D), D ** -0.5),
        'router_w': nrm(ks[17], (L, D, N_EXPERTS), D ** -0.5),
        'router_b': nrm(ks[18], (L, N_EXPERTS), 0.01),
        'exp_w1': nrm(ks[19], (L, N_EXPERTS, D, D_EXPERT), D ** -0.5),
        'exp_w3': nrm(ks[20], (L, N_EXPERTS, D, D_EXPERT), D ** -0.5),
        'exp_w2': nrm(ks[21], (L, N_EXPERTS, D_EXPERT, D), D_EXPERT ** -0.5),
        'sh_w1': nrm(ks[22], (L, D, D_SHARED), D ** -0.5),
        'sh_w3': nrm(ks[23], (L, D, D_SHARED), D ** -0.5),
        'sh_w2': nrm(ks[24], (L, D_SHARED, D), D_SHARED ** -0.5),
        'final_norm_w': 1.0 + nrm(ks[25], (D,), 0.02),
    }


def reference(x, c, ada_w, ada_b, norm_mix_w, norm_moe_w, w_in, m_conv_w, m_gate_b, m_norm_w,
              g_alpha_w, g_alpha_b, g_norm_w, w_pa, w_pb, w_o, router_w, router_b,
              exp_w1, exp_w3, exp_w2, sh_w1, sh_w3, sh_w2, final_norm_w):
    h = x
    cond = jax.nn.silu(c)
    for l in range(DEPTH):
        ada = cond @ ada_w[l] + ada_b[l]
        sh1, sc1, gt1, sh2, sc2, gt2 = jnp.split(ada, 6, axis=-1)
        u = _rmsnorm(h, norm_mix_w[l]) * (1.0 + sc1[:, None, :]) + sh1[:, None, :]
        h = h + gt1[:, None, :] * _mixer(u, w_in[l], m_conv_w[l], m_gate_b[l], m_norm_w[l],
                                         g_alpha_w[l], g_alpha_b[l], g_norm_w[l],
                                         w_pa[l], w_pb[l], w_o[l])
        u = _rmsnorm(h, norm_moe_w[l]) * (1.0 + sc2[:, None, :]) + sh2[:, None, :]
        h = h + gt2[:, None, :] * _moe(u, router_w[l], router_b[l], exp_w1[l], exp_w3[l], exp_w2[l],
                                       sh_w1[l], sh_w3[l], sh_w2[l])
    return _rmsnorm(h, final_norm_w)
```

```cpp
#include <hip/hip_runtime.h>
#include <cstdio>
#include <cstdint>

constexpr int D = 1024, NB = 16, S = 2048, T = NB * S, DEPTH = 2;
constexpr int DIN = 8216;
constexpr int C_QK = 0, C_VM = 1024, C_OM = 2048, C_IM = 3072, C_FM = 3076, C_QG = 3080, C_KG = 3592, C_VG = 4104, C_RG = 5128, C_ZG = 5144, C_GA = 6168, C_GB = 7192;
constexpr int NE = 64, TOPK = 8, DE = 256;
constexpr int NASSIGN = T * TOPK, NROWS = NASSIGN + NE * 256, NBLK = NROWS / 256;
constexpr float EPS = 1e-6f;

__device__ __forceinline__ float sigmoidf_(float x) { return 1.f / (1.f + __expf(-x)); }
__device__ __forceinline__ float siluf_(float x) { return x / (1.f + __expf(-x)); }
__device__ __forceinline__ float logsigmoidf_(float x) { return fminf(x, 0.f) - log1pf(__expf(-fabsf(x))); }
__device__ __forceinline__ float wave_sum(float v) {
#pragma unroll
    for (int o = 1; o < 64; o <<= 1) v += __shfl_xor(v, o);
    return v;
}

__global__ __launch_bounds__(256) void k_ada(const float* c, const float* ada_w, const float* ada_b, float* ada) {
    __shared__ float cond[NB][64];
    const int j = blockIdx.x * 256 + threadIdx.x;
    const int l = j / (6 * D), jj = j % (6 * D);
    float acc[NB];
#pragma unroll
    for (int b = 0; b < NB; ++b) acc[b] = 0.f;
    for (int k0 = 0; k0 < D; k0 += 64) {
        __syncthreads();
        for (int i = threadIdx.x; i < NB * 64; i += 256) { const int b = i / 64, kk = i % 64; cond[b][kk] = siluf_(c[b * D + k0 + kk]); }
        __syncthreads();
        for (int kk = 0; kk < 64; ++kk) {
            const float w = ada_w[((size_t)l * D + k0 + kk) * (6 * D) + jj];
#pragma unroll
            for (int b = 0; b < NB; ++b) acc[b] += cond[b][kk] * w;
        }
    }
    const float bb = ada_b[l * 6 * D + jj];
#pragma unroll
    for (int b = 0; b < NB; ++b) ada[((size_t)l * NB + b) * (6 * D) + jj] = acc[b] + bb;
}

__global__ __launch_bounds__(256) void k_norm_mod(const float* h, const float* w, const float* sh, const float* sc, float* out, int rows, int tok0) {
    const int row = blockIdx.x * 4 + (threadIdx.x >> 6), lane = threadIdx.x & 63;
    if (row >= rows) return;
    const int b = (tok0 + row) / S;
    const float* x = h + (size_t)row * D;
    float v[16]; float ss = 0.f;
#pragma unroll
    for (int i = 0; i < 16; ++i) { v[i] = x[lane + 64 * i]; ss += v[i] * v[i]; }
    ss = wave_sum(ss);
    const float r = rsqrtf(ss * (1.f / D) + EPS);
#pragma unroll
    for (int i = 0; i < 16; ++i) {
        const int cidx = lane + 64 * i;
        float y = v[i] * r * w[cidx];
        if (sc) y = y * (1.f + sc[(size_t)b * 6 * D + cidx]) + sh[(size_t)b * 6 * D + cidx];
        out[(size_t)row * D + cidx] = y;
    }
}

template <int MODE>
__global__ __launch_bounds__(256) void k_gemm(const float* A, int lda, const int* gather, const float* B, const float* B2, int ldb, size_t strideB, const int* blk_e,
                                               float* C, int ldc, int M, int N, int K, const int* scat_tok, const float* scat_w) {
    __shared__ float As[16][68], Bs[16][64], Bs2[MODE == 1 ? 16 : 1][64];
    const int tid = threadIdx.x, tx = tid & 15, ty = tid >> 4;
    const int m0 = blockIdx.y * 64, n0 = blockIdx.x * 64;
    const size_t eoff = blk_e ? (size_t)blk_e[m0 / 256] * strideB : 0;
    const float* Bp = B + eoff; const float* Bp2 = (MODE == 1) ? B2 + eoff : nullptr;
    const int ar = tid >> 2, ak = (tid & 3) * 4;
    const int am = m0 + ar;
    const float* Arow = nullptr;
    if (am < M) { const int src = gather ? gather[am] : am; Arow = A + (size_t)src * lda; }
    const int bk = tid >> 4, bn = (tid & 15) * 4;
    float acc[4][4], acc2[4][4];
#pragma unroll
    for (int i = 0; i < 4; ++i)
#pragma unroll
        for (int j = 0; j < 4; ++j) { acc[i][j] = 0.f; acc2[i][j] = 0.f; }
    for (int k0 = 0; k0 < K; k0 += 16) {
        float4 av = make_float4(0.f, 0.f, 0.f, 0.f);
        if (Arow) av = *(const float4*)(Arow + k0 + ak);
        float4 bv = make_float4(0.f, 0.f, 0.f, 0.f), bv2 = bv;
        if (n0 + bn < N) { bv = *(const float4*)(Bp + (size_t)(k0 + bk) * ldb + n0 + bn); if (MODE == 1) bv2 = *(const float4*)(Bp2 + (size_t)(k0 + bk) * ldb + n0 + bn); }
        __syncthreads();
        As[ak + 0][ar] = av.x; As[ak + 1][ar] = av.y; As[ak + 2][ar] = av.z; As[ak + 3][ar] = av.w;
        *(float4*)&Bs[bk][bn] = bv;
        if (MODE == 1) *(float4*)&Bs2[bk][bn] = bv2;
        __syncthreads();
#pragma unroll
        for (int kk = 0; kk < 16; ++kk) {
            const float4 a = *(const float4*)&As[kk][ty * 4];
            const float4 b = *(const float4*)&Bs[kk][tx * 4];
            const float aa[4] = {a.x, a.y, a.z, a.w}, bb[4] = {b.x, b.y, b.z, b.w};
#pragma unroll
            for (int i = 0; i < 4; ++i)
#pragma unroll
                for (int j = 0; j < 4; ++j) acc[i][j] += aa[i] * bb[j];
            if (MODE == 1) {
                const float4 b2 = *(const float4*)&Bs2[kk][tx * 4];
                const float bb2[4] = {b2.x, b2.y, b2.z, b2.w};
#pragma unroll
                for (int i = 0; i < 4; ++i)
#pragma unroll
                    for (int j = 0; j < 4; ++j) acc2[i][j] += aa[i] * bb2[j];
            }
        }
    }
#pragma unroll
    for (int i = 0; i < 4; ++i) {
        const int m = m0 + ty * 4 + i;
        if (m >= M) continue;
        if (MODE == 2) {
            const int tok = scat_tok ? scat_tok[m] : m; const float w = scat_w ? scat_w[m] : 1.f;
            if (w == 0.f) continue;
#pragma unroll
            for (int j = 0; j < 4; ++j) { const int n = n0 + tx * 4 + j; if (n < N) atomicAdd(&C[(size_t)tok * ldc + n], w * acc[i][j]); }
        } else {
#pragma unroll
            for (int j = 0; j < 4; ++j) { const int n = n0 + tx * 4 + j; if (n < N) C[(size_t)m * ldc + n] = (MODE == 1) ? siluf_(acc[i][j]) * acc2[i][j] : acc[i][j]; }
        }
    }
}

__global__ __launch_bounds__(256) void k_mlstm_seq(const float* proj, const float* conv_w, const float* gate_b, float* hraw) {
    __shared__ float qs[128], ks[128], ns[128], sc[4];
    const int bl = blockIdx.x >> 2, hd = blockIdx.x & 3, tid = threadIdx.x;
    const float* P = proj + (size_t)bl * S * DIN;
    float Cst[128];
#pragma unroll
    for (int d = 0; d < 128; ++d) Cst[d] = 0.f;
    if (tid < 128) ns[tid] = 0.f;
    float m_run = 0.f;
    const int col = (tid < 128) ? (512 + hd * 128 + tid) : (hd * 128 + tid - 128);
    const float w0 = conv_w[0 * 1024 + col], w1 = conv_w[1 * 1024 + col], w2 = conv_w[2 * 1024 + col], w3 = conv_w[3 * 1024 + col];
    const float gbi = gate_b[hd], gbf = gate_b[4 + hd];
    float x0 = 0.f, x1 = 0.f, x2 = 0.f;
    for (int t = 0; t < S; ++t) {
        const float* row = P + (size_t)t * DIN;
        const float x3 = row[C_QK + col];
        const float cv = siluf_(w0 * x0 + w1 * x1 + w2 * x2 + w3 * x3);
        x0 = x1; x1 = x2; x2 = x3;
        __syncthreads();
        if (tid < 128) ks[tid] = cv; else qs[tid - 128] = cv * 0.08838834764831845f;
        if (tid == 0) {
            const float li = 15.f * tanhf((row[C_IM + hd] + gbi) * (1.f / 15.f));
            const float lf = logsigmoidf_(15.f * tanhf((row[C_FM + hd] + gbf) * (1.f / 15.f)));
            const float m_new = fmaxf(lf + m_run, li);
            sc[0] = __expf(lf + m_run - m_new); sc[1] = __expf(li - m_new); sc[2] = __expf(-m_new);
            m_run = m_new;
        }
        __syncthreads();
        const float fd = sc[0], id = sc[1], lowb = sc[2];
        if (tid < 128) ns[tid] = fd * ns[tid] + id * ks[tid];
        __syncthreads();
        const float v = row[C_VM + hd * 256 + tid] * id;
        float num = 0.f, den = 0.f;
#pragma unroll
        for (int d = 0; d < 128; ++d) { Cst[d] = fd * Cst[d] + ks[d] * v; num += qs[d] * Cst[d]; den += qs[d] * ns[d]; }
        hraw[((size_t)bl * S + t) * D + hd * 256 + tid] = num / fmaxf(fabsf(den), lowb);
    }
}

__global__ __launch_bounds__(256) void k_gla_seq(const float* proj, const float* alpha_w, const float* alpha_b, float* hraw) {
    __shared__ float qs[128], ks[128], as[128];
    const int bl = blockIdx.x >> 2, hd = blockIdx.x & 3, tid = threadIdx.x;
    const float* P = proj + (size_t)bl * S * DIN;
    float Sst[128];
#pragma unroll
    for (int d = 0; d < 128; ++d) Sst[d] = 0.f;
    float aw[16]; float ab = 0.f;
    if (tid < 128) {
#pragma unroll
        for (int r = 0; r < 16; ++r) aw[r] = alpha_w[r * 512 + hd * 128 + tid];
        ab = alpha_b[hd * 128 + tid];
    }
    for (int t = 0; t < S; ++t) {
        const float* row = P + (size_t)t * DIN;
        __syncthreads();
        if (tid < 128) {
            float x = ab;
#pragma unroll
            for (int r = 0; r < 16; ++r) x += row[C_RG + r] * aw[r];
            as[tid] = __expf(logsigmoidf_(x) * (1.f / 16.f));
            ks[tid] = row[C_KG + hd * 128 + tid];
        } else qs[tid - 128] = row[C_QG + hd * 128 + tid - 128] * 0.08838834764831845f;
        __syncthreads();
        const float v = row[C_VG + hd * 256 + tid];
        float o = 0.f;
#pragma unroll
        for (int d = 0; d < 128; ++d) { Sst[d] = as[d] * Sst[d] + ks[d] * v; o += qs[d] * Sst[d]; }
        hraw[((size_t)bl * S + t) * D + hd * 256 + tid] = o;
    }
}

__global__ __launch_bounds__(256) void k_mix_post(float* hm, float* hg, const float* proj, const float* mnw, const float* gnw, int rows) {
    const int idx = blockIdx.x * 4 + (threadIdx.x >> 6), lane = threadIdx.x & 63;
    if (idx >= rows * 4) return;
    const int row = idx >> 2, hd = idx & 3;
    float* a = hm + (size_t)row * D + hd * 256; float* g = hg + (size_t)row * D + hd * 256;
    const float* pr = proj + (size_t)row * DIN;
    float va[4], vg[4], sa = 0.f, sg = 0.f;
#pragma unroll
    for (int i = 0; i < 4; ++i) { va[i] = a[lane + 64 * i]; vg[i] = g[lane + 64 * i]; sa += va[i] * va[i]; sg += vg[i] * vg[i]; }
    sa = wave_sum(sa); sg = wave_sum(sg);
    const float ra = rsqrtf(sa * (1.f / 256.f) + EPS), rg = rsqrtf(sg * (1.f / 256.f) + EPS);
#pragma unroll
    for (int i = 0; i < 4; ++i) {
        const int cidx = hd * 256 + lane + 64 * i;
        a[lane + 64 * i] = va[i] * ra * mnw[cidx] * sigmoidf_(pr[C_OM + cidx]);
        g[lane + 64 * i] = vg[i] * rg * gnw[cidx] * siluf_(pr[C_ZG + cidx]);
    }
}

__global__ __launch_bounds__(256) void k_ycomb(float* ya, const float* yb, const float* proj, int rows) {
    const size_t i = (size_t)blockIdx.x * 256 + threadIdx.x;
    if (i >= (size_t)rows * D) return;
    const int row = (int)(i / D), cidx = (int)(i % D);
    const float* pr = proj + (size_t)row * DIN;
    ya[i] = sigmoidf_(pr[C_GA + cidx]) * ya[i] + sigmoidf_(pr[C_GB + cidx]) * yb[i];
}

__global__ __launch_bounds__(256) void k_resid(const float* hin, const float* delta, const float* gate, float* hout, int rows, int tok0) {
    const size_t i = (size_t)blockIdx.x * 256 + threadIdx.x;
    if (i >= (size_t)rows * D) return;
    const int row = (int)(i / D), cidx = (int)(i % D), b = (tok0 + row) / S;
    hout[i] = hin[i] + gate[(size_t)b * 6 * D + cidx] * delta[i];
}

__global__ __launch_bounds__(256) void k_route(const float* logits, const float* router_b, int* eidx, float* wts, int* pos, int* counts) {
    const int t = blockIdx.x * 256 + threadIdx.x;
    if (t >= T) return;
    float sc[NE], sel[NE];
#pragma unroll
    for (int e = 0; e < NE; ++e) { sc[e] = sigmoidf_(logits[(size_t)t * NE + e]); sel[e] = sc[e] + router_b[e]; }
    float gs[8];
#pragma unroll
    for (int g = 0; g < 8; ++g) {
        float m1 = -INFINITY, m2 = -INFINITY;
#pragma unroll
        for (int j = 0; j < 8; ++j) { const float v = sel[g * 8 + j]; if (v > m1) { m2 = m1; m1 = v; } else if (v > m2) m2 = v; }
        gs[g] = m1 + m2;
    }
    unsigned gmask = 0;
#pragma unroll
    for (int k = 0; k < 4; ++k) {
        int best = -1; float bv = -INFINITY;
#pragma unroll
        for (int g = 0; g < 8; ++g) if (!((gmask >> g) & 1u) && (best < 0 || gs[g] > bv)) { best = g; bv = gs[g]; }
        gmask |= 1u << best;
    }
    unsigned long long taken = 0ull; int ei[TOPK]; float wv[TOPK]; float wsum = 0.f;
#pragma unroll
    for (int k = 0; k < TOPK; ++k) {
        int best = -1; float bv = -INFINITY;
#pragma unroll
        for (int e = 0; e < NE; ++e) {
            const bool ok = ((gmask >> (e >> 3)) & 1u) && !((taken >> e) & 1ull);
            if (ok && (best < 0 || sel[e] > bv)) { best = e; bv = sel[e]; }
        }
        taken |= 1ull << best; ei[k] = best;
        float s = 0.f;
#pragma unroll
        for (int e = 0; e < NE; ++e) s = (e == best) ? sc[e] : s;
        wv[k] = s; wsum += s;
    }
#pragma unroll
    for (int k = 0; k < TOPK; ++k) {
        eidx[t * TOPK + k] = ei[k]; wts[t * TOPK + k] = wv[k] / wsum * 2.5f;
        pos[t * TOPK + k] = atomicAdd(&counts[ei[k]], 1);
    }
}

__global__ void k_prefix(const int* counts, int* pstart, int* blk_e) {
    __shared__ int pend[NE];
    if (threadIdx.x == 0) { int acc = 0; for (int e = 0; e < NE; ++e) { pstart[e] = acc; acc += (counts[e] + 255) / 256 * 256; pend[e] = acc; } }
    __syncthreads();
    for (int j = threadIdx.x; j < NBLK; j += blockDim.x) { int e = 0; while (e < NE - 1 && pend[e] <= j * 256) ++e; blk_e[j] = e; }
}

__global__ __launch_bounds__(256) void k_fill(const int* eidx, const float* wts, const int* pos, const int* pstart, int* row_tok, float* row_w) {
    const int i = blockIdx.x * 256 + threadIdx.x;
    if (i >= NASSIGN) return;
    const int dest = pstart[eidx[i]] + pos[i];
    row_tok[dest] = i / TOPK; row_w[dest] = wts[i];
}

static inline size_t al(size_t x) { return (x + 255) & ~(size_t)255; }

extern "C" void kernel_launch(void* const* d_in, const int* in_sizes, int n_in, void* d_out, int out_size, void* d_ws, size_t ws_size, hipStream_t stream) {
    const float* x = (const float*)d_in[0]; const float* c = (const float*)d_in[1]; const float* ada_w = (const float*)d_in[2]; const float* ada_b = (const float*)d_in[3];
    const float* norm_mix_w = (const float*)d_in[4]; const float* norm_moe_w = (const float*)d_in[5]; const float* w_in = (const float*)d_in[6];
    const float* m_conv_w = (const float*)d_in[7]; const float* m_gate_b = (const float*)d_in[8]; const float* m_norm_w = (const float*)d_in[9];
    const float* g_alpha_w = (const float*)d_in[10]; const float* g_alpha_b = (const float*)d_in[11]; const float* g_norm_w = (const float*)d_in[12];
    const float* w_pa = (const float*)d_in[13]; const float* w_pb = (const float*)d_in[14]; const float* w_o = (const float*)d_in[15];
    const float* router_w = (const float*)d_in[16]; const float* router_b = (const float*)d_in[17];
    const float* exp_w1 = (const float*)d_in[18]; const float* exp_w3 = (const float*)d_in[19]; const float* exp_w2 = (const float*)d_in[20];
    const float* sh_w1 = (const float*)d_in[21]; const float* sh_w3 = (const float*)d_in[22]; const float* sh_w2 = (const float*)d_in[23];
    const float* final_norm_w = (const float*)d_in[24];
    float* out = (float*)d_out;
    constexpr int GB = 4, TG = GB * S;
    char* p = (char*)d_ws; size_t off = 0;
    auto take = [&](size_t bytes) { char* r = p + off; off += al(bytes); return r; };
    float* ada = (float*)take((size_t)DEPTH * NB * 6 * D * 4);
    int* counts = (int*)take(NE * 4); int* pstart = (int*)take(NE * 4); int* blk_e = (int*)take(NBLK * 4);
    int* eidx = (int*)take((size_t)NASSIGN * 4); float* wts = (float*)take((size_t)NASSIGN * 4); int* pos = (int*)take((size_t)NASSIGN * 4);
    int* row_tok = (int*)take((size_t)NROWS * 4); float* row_w = (float*)take((size_t)NROWS * 4);
    const size_t base = off;
    float* u = (float*)take((size_t)TG * D * 4); float* proj = (float*)take((size_t)TG * DIN * 4);
    float* hm = (float*)take((size_t)TG * D * 4); float* hg = (float*)take((size_t)TG * D * 4);
    float* ya = (float*)take((size_t)TG * D * 4); float* yb = (float*)take((size_t)TG * D * 4);
    const size_t end1 = off; off = base;
    float* u2 = (float*)take((size_t)T * D * 4); float* logits = (float*)take((size_t)T * NE * 4);
    float* hb = (float*)take((size_t)NROWS * DE * 4); float* hbs = (float*)take((size_t)T * DE * 4); float* moe_out = (float*)take((size_t)T * D * 4);
    const size_t end2 = off;
    if (ws_size < end1 || ws_size < end2) { fprintf(stderr, "workspace too small: %zu < %zu/%zu\n", ws_size, end1, end2); return; }

    k_ada<<<DEPTH * 6 * D / 256, 256, 0, stream>>>(c, ada_w, ada_b, ada);
    for (int l = 0; l < DEPTH; ++l) {
        const float* hin = (l == 0) ? x : out;
        const float* adal = ada + (size_t)l * NB * 6 * D;
        for (int g = 0; g < NB / GB; ++g) {
            const int tok0 = g * TG; const float* hin_g = hin + (size_t)tok0 * D; float* hout_g = out + (size_t)tok0 * D;
            k_norm_mod<<<TG / 4, 256, 0, stream>>>(hin_g, norm_mix_w + l * D, adal + 0 * D, adal + 1 * D, u, TG, tok0);
            k_gemm<0><<<dim3((DIN + 63) / 64, TG / 64), 256, 0, stream>>>(u, D, nullptr, w_in + (size_t)l * D * DIN, nullptr, DIN, 0, nullptr, proj, DIN, TG, DIN, D, nullptr, nullptr);
            k_mlstm_seq<<<GB * 4, 256, 0, stream>>>(proj, m_conv_w + (size_t)l * 4 * 1024, m_gate_b + l * 8, hm);
            k_gla_seq<<<GB * 4, 256, 0, stream>>>(proj, g_alpha_w + (size_t)l * 16 * 512, g_alpha_b + l * 512, hg);
            k_mix_post<<<TG, 256, 0, stream>>>(hm, hg, proj, m_norm_w + l * D, g_norm_w + l * D, TG);
            k_gemm<0><<<dim3(D / 64, TG / 64), 256, 0, stream>>>(hm, D, nullptr, w_pa + (size_t)l * D * D, nullptr, D, 0, nullptr, ya, D, TG, D, D, nullptr, nullptr);
            k_gemm<0><<<dim3(D / 64, TG / 64), 256, 0, stream>>>(hg, D, nullptr, w_pb + (size_t)l * D * D, nullptr, D, 0, nullptr, yb, D, TG, D, D, nullptr, nullptr);
            k_ycomb<<<TG * D / 256, 256, 0, stream>>>(ya, yb, proj, TG);
            k_gemm<0><<<dim3(D / 64, TG / 64), 256, 0, stream>>>(ya, D, nullptr, w_o + (size_t)l * D * D, nullptr, D, 0, nullptr, yb, D, TG, D, D, nullptr, nullptr);
            k_resid<<<TG * D / 256, 256, 0, stream>>>(hin_g, yb, adal + 2 * D, hout_g, TG, tok0);
        }
        k_norm_mod<<<T / 4, 256, 0, stream>>>(out, norm_moe_w + l * D, adal + 3 * D, adal + 4 * D, u2, T, 0);
        k_gemm<0><<<dim3(1, T / 64), 256, 0, stream>>>(u2, D, nullptr, router_w + (size_t)l * D * NE, nullptr, NE, 0, nullptr, logits, NE, T, NE, D, nullptr, nullptr);
        hipMemsetAsync(counts, 0, NE * 4, stream);
        hipMemsetAsync(row_tok, 0, (size_t)NROWS * 4, stream);
        hipMemsetAsync(row_w, 0, (size_t)NROWS * 4, stream);
        hipMemsetAsync(moe_out, 0, (size_t)T * D * 4, stream);
        k_route<<<T / 256, 256, 0, stream>>>(logits, router_b + l * NE, eidx, wts, pos, counts);
        k_prefix<<<1, 256, 0, stream>>>(counts, pstart, blk_e);
        k_fill<<<NASSIGN / 256, 256, 0, stream>>>(eidx, wts, pos, pstart, row_tok, row_w);
        k_gemm<1><<<dim3(DE / 64, NROWS / 64), 256, 0, stream>>>(u2, D, row_tok, exp_w1 + (size_t)l * NE * D * DE, exp_w3 + (size_t)l * NE * D * DE, DE, (size_t)D * DE, blk_e, hb, DE, NROWS, DE, D, nullptr, nullptr);
        k_gemm<2><<<dim3(D / 64, NROWS / 64), 256, 0, stream>>>(hb, DE, nullptr, exp_w2 + (size_t)l * NE * DE * D, nullptr, D, (size_t)DE * D, blk_e, moe_out, D, NROWS, D, DE, row_tok, row_w);
        k_gemm<1><<<dim3(DE / 64, T / 64), 256, 0, stream>>>(u2, D, nullptr, sh_w1 + (size_t)l * D * DE, sh_w3 + (size_t)l * D * DE, DE, 0, nullptr, hbs, DE, T, DE, D, nullptr, nullptr);
        k_gemm<2><<<dim3(D / 64, T / 64), 256, 0, stream>>>(hbs, DE, nullptr, sh_w2 + (size_t)l * DE * D, nullptr, D, 0, nullptr, moe_out, D, T, D, DE, nullptr, nullptr);
        k_resid<<<T * D / 256, 256, 0, stream>>>(out, moe_out, adal + 5 * D, out, T, 0);
    }
    k_norm_mod<<<T / 4, 256, 0, stream>>>(out, final_norm_w, nullptr, nullptr, out, T, 0);
}
```

```cpp
#include <hip/hip_runtime.h>
#include <cstdio>
#include <cstdint>

constexpr int D = 1024, NB = 16, S = 2048, T = NB * S, DEPTH = 2;
constexpr int DIN = 8216;
constexpr int C_QK = 0, C_VM = 1024, C_OM = 2048, C_IM = 3072, C_FM = 3076, C_QG = 3080, C_KG = 3592, C_VG = 4104, C_RG = 5128, C_ZG = 5144, C_GA = 6168, C_GB = 7192;
constexpr int NE = 64, TOPK = 8, DE = 256;
constexpr int NASSIGN = T * TOPK, NROWS = NASSIGN + NE * 256, NBLK = NROWS / 256;
constexpr float EPS = 1e-6f;

__device__ __forceinline__ float sigmoidf_(float x) { return 1.f / (1.f + __expf(-x)); }
__device__ __forceinline__ float siluf_(float x) { return x / (1.f + __expf(-x)); }
__device__ __forceinline__ float logsigmoidf_(float x) { return fminf(x, 0.f) - log1pf(__expf(-fabsf(x))); }
__device__ __forceinline__ float wave_sum(float v) {
#pragma unroll
    for (int o = 1; o < 64; o <<= 1) v += __shfl_xor(v, o);
    return v;
}

#define LAS __attribute__((address_space(3)))
typedef unsigned short bf16_t;
typedef short bf16x8 __attribute__((ext_vector_type(8)));
typedef float f32x4 __attribute__((ext_vector_type(4)));
typedef float f32x2 __attribute__((ext_vector_type(2)));
typedef unsigned u32x4 __attribute__((ext_vector_type(4)));
typedef unsigned u32x2 __attribute__((ext_vector_type(2)));

constexpr size_t MiB = 1u << 20;
constexpr int NWAVES = 8, NTHREADS = 512;
constexpr int LDS_BYTES = 147456;
constexpr int RING_BYTES = 131072, MISC_OFF = RING_BYTES;

constexpr size_t WS_CTL = 0, CTL_BYTES = 1 * MiB;
constexpr size_t WS_ADA = 1 * MiB;
constexpr size_t WS_WSM = 2 * MiB, WSM_STRIDE = 25 * MiB;
constexpr size_t WO_IN = 0, WO_GAB = 12 * MiB + 512 * 1024, WO_PA = WO_GAB + 4 * MiB, WO_PB = WO_PA + 2 * MiB, WO_O = WO_PB + 2 * MiB, WO_S13 = WO_O + 2 * MiB, WO_S2 = WO_S13 + 1 * MiB, WO_R = WO_S2 + 512 * 1024;
constexpr size_t WS_WEXP13 = 52 * MiB, WS_WEXP2 = 116 * MiB;
constexpr size_t WS_SMALL = 148 * MiB;
constexpr size_t WS_LOGITS = 152 * MiB, WS_EIDX = 160 * MiB, WS_WTS = 161 * MiB, WS_POS = 162 * MiB, WS_ROWTOK = 163 * MiB;
constexpr size_t WS_U = 166 * MiB;
constexpr size_t WS_PB = 230 * MiB, PB_STRIDE = 64 * MiB;
constexpr size_t WS_OPT_END = 614 * MiB;
static_assert(WO_R + 512 * 1024 <= WSM_STRIDE, "small weight map");

constexpr int CW_BAR = 4096;
constexpr int CW_CNT = 16384;
constexpr int CW_ERR = 20480;

__device__ __forceinline__ unsigned f2bf(float f) { unsigned u = __builtin_bit_cast(unsigned, f); return (u + 0x7fffu + ((u >> 16) & 1u)) >> 16; }
__device__ __forceinline__ unsigned pk2(float lo, float hi) { return f2bf(lo) | (f2bf(hi) << 16); }
__device__ __forceinline__ float bf2f(unsigned short b) { return __builtin_bit_cast(float, (unsigned)b << 16); }
__device__ __forceinline__ float bflo(unsigned w) { return __builtin_bit_cast(float, w << 16); }
__device__ __forceinline__ float bfhi(unsigned w) { return __builtin_bit_cast(float, w & 0xffff0000u); }
__device__ __forceinline__ unsigned cvt_pk_bf16(float lo, float hi) { unsigned r; asm volatile("v_cvt_pk_bf16_f32 %0, %1, %2" : "=v"(r) : "v"(lo), "v"(hi)); return r; }
#define LDS_WAIT() asm volatile("s_waitcnt lgkmcnt(0)" ::: "memory")
#define VM_WAIT() asm volatile("s_waitcnt vmcnt(0)" ::: "memory")

namespace pg8 {
constexpr int BM = 256, BK = 64, HALF = 128, HTB = HALF * BK * 2, STAGE_BYTES = 8 * HTB, NXCD = 8, WGM = 8;
__host__ __device__ __forceinline__ int lds_byte(int r, int c) { const int st = (r >> 4) * 2 + (c >> 5), rr = r & 15, cc = c & 31, ob = rr * 64 + cc * 2; return st * 1024 + (ob ^ (((ob >> 9) & 1) << 5)); }
__host__ __device__ __forceinline__ void stage_rc(int b, int& R, int& C) { const int st = b / 1024, sb = b % 1024, swz = sb ^ (((sb >> 9) & 1) << 5); R = (st >> 1) * 16 + swz / 64; C = (st & 1) * 32 + (swz % 64) / 2; }
__host__ __device__ __forceinline__ int perm32(int rho) { const int n = rho >> 4, i = rho & 15; return 8 * (i >> 2) + 4 * n + (i & 3); }

struct Unit { int pm, pn, e; };

struct TileOrder {
    int nM, nN, nwg, G, c;
    __device__ void init(int nM_, int nN_, int G_, int c_) { nM = nM_; nN = nN_; nwg = nM * nN; G = G_; c = c_; }
    __device__ bool tile(int i, int& pm, int& pn) const {
        const long L = (long)i * G + c; if (L >= nwg) return false;
        int wgid = (int)L; { const int q = nwg / NXCD, r = nwg % NXCD, xcd = wgid % NXCD, off = wgid / NXCD; wgid = (xcd < r ? xcd * (q + 1) : r * (q + 1) + (xcd - r) * q) + off; }
        const int nig = WGM * nN, gid = wgid / nig, fm = gid * WGM, gsz = (nM - fm) < WGM ? (nM - fm) : WGM;
        pm = fm + ((wgid % nig) % gsz); pn = (wgid % nig) / gsz; return true;
    }
};

template <class Epi, class Sched, bool GATHER>
__device__ __forceinline__ void gemm_phase(LAS unsigned char* lds, const int K, const Sched& S, const Epi& E) {
    const int tid = threadIdx.x, wid = __builtin_amdgcn_readfirstlane(tid >> 6), lane = tid & 63, wr = wid >> 2, wc = wid & 3, fr = lane & 15, fq = lane >> 4;
    const int nt = K / BK;
    unsigned rowA[2], colA[2], voffB[2];
#pragma unroll
    for (int i = 0; i < 2; ++i) { int R, C; stage_rc(tid * 16 + i * 8192, R, C); const int Rb = Epi::PERM ? ((R & ~31) + perm32(R & 31)) : R;
        rowA[i] = (unsigned)R; colA[i] = (unsigned)C * 2u; voffB[i] = (unsigned)(Rb * K + C) * 2u; }
    const size_t kstep = (size_t)(BK * 2);
    const size_t hstep = (size_t)HALF * K * 2;
    const unsigned ldsw = (unsigned)wid * 1024u;
    const int aoff = lds_byte(wr * 64 + fr, fq * 8), boff = lds_byte(wc * 32 + fr, fq * 8);
#define PG8_SA(b, h) (((b) * 2 + (h)) * HTB)
#define PG8_SB(b, h) ((4 + (b) * 2 + (h)) * HTB)
#define PG8_STAGE(bufoff, gbase, voff) do { _Pragma("unroll") for (int _i = 0; _i < 2; ++_i) \
        __builtin_amdgcn_global_load_lds((const unsigned*)((const char*)(gbase) + (voff)[_i]), (LAS unsigned*)(lds + (bufoff) + ldsw + _i * 8192), 16, 0, 0); } while (0)
#define PG8_LDA(dst, b, h) do { _Pragma("unroll") for (int m = 0; m < 4; ++m) _Pragma("unroll") for (int k = 0; k < 2; ++k) dst[m][k] = *(const LAS bf16x8*)(lds + PG8_SA(b, h) + aoff + m * 2048 + k * 1024); } while (0)
#define PG8_LDB(dst, b, h) do { _Pragma("unroll") for (int n = 0; n < 2; ++n) _Pragma("unroll") for (int k = 0; k < 2; ++k) dst[n][k] = *(const LAS bf16x8*)(lds + PG8_SB(b, h) + boff + n * 2048 + k * 1024); } while (0)
#define PG8_MMA(ai, bj, At, Bt) do { __builtin_amdgcn_s_setprio(1); _Pragma("unroll") for (int m = 0; m < 4; ++m) _Pragma("unroll") for (int n = 0; n < 2; ++n) _Pragma("unroll") for (int k = 0; k < 2; ++k) \
        acc[ai][bj][m][n] = __builtin_amdgcn_mfma_f32_16x16x32_bf16(Bt[n][k], At[m][k], acc[ai][bj][m][n], 0, 0, 0); __builtin_amdgcn_s_setprio(0); } while (0)
#define PG8_WAIT_V(n) asm volatile("s_waitcnt vmcnt(" #n ")" ::: "memory")
#define PG8_WAIT_L(n) asm volatile("s_waitcnt lgkmcnt(" #n ")" ::: "memory")
#define PG8_BAR __builtin_amdgcn_s_barrier()
#define PG8_SCHED __builtin_amdgcn_sched_barrier(0)
    Unit cur, nxt; int ui = 0;
    if (!S.next(0, cur)) return;
    unsigned offA[2][2], noffA[2][2];
    {
        const int* tk = GATHER ? S.a_rows(cur) : nullptr;
#pragma unroll
        for (int h = 0; h < 2; ++h)
#pragma unroll
            for (int i = 0; i < 2; ++i) offA[h][i] = (GATHER ? (unsigned)tk[h * HALF + rowA[i]] : (unsigned)(h * HALF) + rowA[i]) * (unsigned)(K * 2) + colA[i];
    }
    f32x4 acc[2][2][4][2];
#pragma unroll
    for (int a = 0; a < 2; ++a)
#pragma unroll
        for (int b = 0; b < 2; ++b)
#pragma unroll
            for (int m = 0; m < 4; ++m)
#pragma unroll
                for (int n = 0; n < 2; ++n) acc[a][b][m][n] = (f32x4){0.f, 0.f, 0.f, 0.f};
    bf16x8 At[4][2], B0[2][2], B1[2][2];
    const char* cA = S.a_ptr(cur); const char* cB = S.b_ptr(cur);
    PG8_STAGE(PG8_SB(0, 0), cB, voffB); PG8_STAGE(PG8_SB(0, 1), cB + hstep, voffB); PG8_STAGE(PG8_SA(0, 0), cA, offA[0]); PG8_STAGE(PG8_SA(0, 1), cA, offA[1]);
    if (wr == 1) PG8_BAR;
    PG8_WAIT_V(2); PG8_BAR;
    PG8_STAGE(PG8_SB(1, 0), cB + kstep, voffB); PG8_STAGE(PG8_SA(1, 0), cA + kstep, offA[0]); PG8_STAGE(PG8_SB(1, 1), cB + hstep + kstep, voffB);
    PG8_WAIT_V(6); PG8_BAR;
    for (;;) {
        const bool has_next = S.next(ui + 1, nxt);
        const char* nA = has_next ? S.a_ptr(nxt) : cA; const char* nB = has_next ? S.b_ptr(nxt) : cB;
        {
            const int* tk = (GATHER && has_next) ? S.a_rows(nxt) : nullptr;
#pragma unroll
            for (int h = 0; h < 2; ++h)
#pragma unroll
                for (int i = 0; i < 2; ++i) noffA[h][i] = (GATHER && has_next) ? (unsigned)tk[h * HALF + rowA[i]] * (unsigned)(K * 2) + colA[i] : offA[h][i];
        }
#pragma unroll 1
        for (int t = 0; t < nt; t += 2) {
            const bool last = (t == nt - 2);
            const char* a1 = cA + (size_t)(t + 1) * kstep;
            const char* a2 = last ? nA : cA + (size_t)(t + 2) * kstep; const char* b2 = last ? nB : cB + (size_t)(t + 2) * kstep;
            const char* a3 = a2 + kstep; const char* b3 = b2 + kstep;
            unsigned o2[2][2];
#pragma unroll
            for (int h = 0; h < 2; ++h)
#pragma unroll
                for (int i = 0; i < 2; ++i) o2[h][i] = (GATHER && last) ? noffA[h][i] : offA[h][i];
            PG8_LDB(B0, 0, 0); PG8_LDB(B1, 0, 1); PG8_SCHED; PG8_LDA(At, 0, 0); PG8_STAGE(PG8_SA(1, 1), a1, offA[1]);
            PG8_WAIT_V(8); PG8_WAIT_L(0); PG8_BAR; PG8_MMA(0, 0, At, B0); PG8_MMA(0, 1, At, B1); PG8_BAR; PG8_SCHED;
            PG8_LDA(At, 0, 1); PG8_STAGE(PG8_SB(0, 0), b2, voffB); PG8_STAGE(PG8_SB(0, 1), b2 + hstep, voffB); PG8_STAGE(PG8_SA(0, 0), a2, o2[0]);
            PG8_WAIT_V(8); PG8_WAIT_L(0); PG8_BAR; PG8_MMA(1, 0, At, B0); PG8_MMA(1, 1, At, B1); PG8_BAR; PG8_SCHED;
            PG8_LDB(B0, 1, 0); PG8_LDB(B1, 1, 1); PG8_SCHED; PG8_LDA(At, 1, 0); PG8_STAGE(PG8_SA(0, 1), a2, o2[1]);
            PG8_WAIT_V(8); PG8_WAIT_L(0); PG8_BAR; PG8_MMA(0, 0, At, B0); PG8_MMA(0, 1, At, B1); PG8_BAR; PG8_SCHED;
            PG8_LDA(At, 1, 1); PG8_STAGE(PG8_SB(1, 0), b3, voffB); PG8_STAGE(PG8_SB(1, 1), b3 + hstep, voffB); PG8_STAGE(PG8_SA(1, 0), a3, o2[0]);
            PG8_WAIT_V(8); PG8_WAIT_L(0); PG8_BAR; PG8_MMA(1, 0, At, B0); PG8_MMA(1, 1, At, B1); PG8_BAR; PG8_SCHED;
        }
        if (wr == 0) PG8_BAR;
        E(acc, cur, wr, wc, fr, fq);
        if (!has_next) break;
#pragma unroll
        for (int a = 0; a < 2; ++a)
#pragma unroll
            for (int b = 0; b < 2; ++b)
#pragma unroll
                for (int m = 0; m < 4; ++m)
#pragma unroll
                    for (int n = 0; n < 2; ++n) acc[a][b][m][n] = (f32x4){0.f, 0.f, 0.f, 0.f};
        cur = nxt; cA = nA; cB = nB; ++ui;
#pragma unroll
        for (int h = 0; h < 2; ++h)
#pragma unroll
            for (int i = 0; i < 2; ++i) offA[h][i] = noffA[h][i];
        if (wr == 1) PG8_BAR;
    }
    PG8_WAIT_V(0);
    PG8_BAR;
#undef PG8_SA
#undef PG8_SB
#undef PG8_STAGE
#undef PG8_LDA
#undef PG8_LDB
#undef PG8_MMA
#undef PG8_WAIT_V
#undef PG8_WAIT_L
#undef PG8_BAR
#undef PG8_SCHED
}
}

struct Args { const float* in[25]; float* out; unsigned char* ws; int ph_lo, ph_hi, layer, pad; };
struct Frame {
    LAS unsigned char* lds;
    unsigned char* ws;
    int tid, lane, wave, G, bid;
};
enum { I_X = 0, I_C, I_ADAW, I_ADAB, I_NMIXW, I_NMOEW, I_WIN, I_CONVW, I_GATEB, I_MNORMW, I_ALPHAW, I_ALPHAB, I_GNORMW, I_WPA, I_WPB, I_WO, I_RW, I_RB, I_EW1, I_EW3, I_EW2, I_SW1, I_SW3, I_SW2, I_FNW };

__device__ __forceinline__ bf16_t* wsm(unsigned char* ws, int l, size_t off) { return (bf16_t*)(ws + WS_WSM + (size_t)l * WSM_STRIDE + off); }

__device__ __forceinline__ void tr_item(const float* W, int ldw, int c0, int k0, bf16_t* WT, int r0, int K, LAS float* scr, int lane) {
#pragma unroll 8
    for (int i = 0; i < 32; ++i) { const int kk = 2 * i + (lane >> 5); scr[kk * 33 + (lane & 31)] = W[(size_t)(k0 + kk) * ldw + c0 + (lane & 31)]; }
    LDS_WAIT(); asm volatile("" ::: "memory");
    const int c = lane & 7;
#pragma unroll
    for (int j = 0; j < 4; ++j) { const int n = (lane >> 3) + 8 * j; const LAS float* s = scr + (8 * c) * 33 + n;
        u32x4 o; o.x = pk2(s[0 * 33], s[1 * 33]); o.y = pk2(s[2 * 33], s[3 * 33]); o.z = pk2(s[4 * 33], s[5 * 33]); o.w = pk2(s[6 * 33], s[7 * 33]);
        *(u32x4*)(WT + (size_t)(r0 + n) * K + k0 + 8 * c) = o; }
    LDS_WAIT(); asm volatile("" ::: "memory");
}
constexpr int SW_ITEMS = 96 * 16 + 3 * 32 * 16 + 64 * 16 + 3 * 32 * 16 + 4 * 4 * 16 + 32 * 4 + 8 * 16 + 8 * 16;
__device__ __forceinline__ void small_item(const Args& a, unsigned char* ws, int l, int r, LAS float* scr, int lane) {
    const float* win = a.in[I_WIN] + (size_t)l * D * DIN;
    bf16_t* Win_t = wsm(ws, l, WO_IN);
    if (r < 96 * 16) { const int nb = r % 96, kb = r / 96; tr_item(win, DIN, nb * 32, kb * 64, Win_t, nb * 32, D, scr, lane); return; } r -= 96 * 16;
    if (r < 32 * 16) { const int nb = r % 32, kb = r / 32; tr_item(win, DIN, C_QG + nb * 32, kb * 64, Win_t, 3072 + nb * 32, D, scr, lane); return; } r -= 32 * 16;
    if (r < 32 * 16) { const int nb = r % 32, kb = r / 32; tr_item(win, DIN, C_VG + nb * 32, kb * 64, Win_t, 4096 + nb * 32, D, scr, lane); return; } r -= 32 * 16;
    if (r < 32 * 16) { const int nb = r % 32, kb = r / 32; tr_item(win, DIN, C_ZG + nb * 32, kb * 64, Win_t, 5120 + nb * 32, D, scr, lane); return; } r -= 32 * 16;
    if (r < 64 * 16) { const int nb = r % 64, kb = r / 64; tr_item(win, DIN, C_GA + nb * 32, kb * 64, wsm(ws, l, WO_GAB), nb * 32, D, scr, lane); return; } r -= 64 * 16;
    if (r < 32 * 16) { const int nb = r % 32, kb = r / 32; tr_item(a.in[I_WPA] + (size_t)l * D * D, D, nb * 32, kb * 64, wsm(ws, l, WO_PA), nb * 32, D, scr, lane); return; } r -= 32 * 16;
    if (r < 32 * 16) { const int nb = r % 32, kb = r / 32; tr_item(a.in[I_WPB] + (size_t)l * D * D, D, nb * 32, kb * 64, wsm(ws, l, WO_PB), nb * 32, D, scr, lane); return; } r -= 32 * 16;
    if (r < 32 * 16) { const int nb = r % 32, kb = r / 32; tr_item(a.in[I_WO] + (size_t)l * D * D, D, nb * 32, kb * 64, wsm(ws, l, WO_O), nb * 32, D, scr, lane); return; } r -= 32 * 16;
    if (r < 4 * 4 * 16) { const int seg = r / 64, it = r % 64, nb = it % 4, kb = it / 4;
        const float* src = ((seg & 1) ? a.in[I_SW3] : a.in[I_SW1]) + (size_t)l * D * DE;
        tr_item(src, DE, (seg >> 1) * 128 + nb * 32, kb * 64, wsm(ws, l, WO_S13), seg * 128 + nb * 32, D, scr, lane); return; } r -= 256;
    if (r < 32 * 4) { const int nb = r % 32, kb = r / 32; tr_item(a.in[I_SW2] + (size_t)l * DE * D, D, nb * 32, kb * 64, wsm(ws, l, WO_S2), nb * 32, DE, scr, lane); return; } r -= 128;
    if (r < 8 * 16) {
        const int nb = r % 8, kb = r / 8; bf16_t* Wr = wsm(ws, l, WO_R);
        if (nb < 2) tr_item(a.in[I_RW] + (size_t)l * D * NE, NE, nb * 32, kb * 64, Wr, nb * 32, D, scr, lane);
        else for (int j = 0; j < 32; ++j) Wr[(size_t)(nb * 32 + j) * D + kb * 64 + lane] = 0;
        return; } r -= 128;
    {
        const int rb = r % 8, kb = r / 8;
        for (int j = 0; j < 32; ++j) {
            const int row = rb * 32 + j; float v = 0.f;
            if (row < 24) { const int srcc = row < 4 ? C_IM + row : (row < 8 ? C_FM + row - 4 : C_RG + row - 8); v = win[(size_t)(kb * 64 + lane) * DIN + srcc]; }
            Win_t[(size_t)(6144 + row) * D + kb * 64 + lane] = (bf16_t)f2bf(v);
        }
    }
}
constexpr int EX_ITEMS = 64 * 384;
__device__ __forceinline__ void expert_item(const Args& a, unsigned char* ws, int l, int idx, LAS float* scr, int lane) {
    const int e = idx / 384; int r = idx % 384;
    if (r < 256) { const int seg = r / 64, it = r % 64, nb = it % 4, kb = it / 4;
        const float* src = ((seg & 1) ? a.in[I_EW3] : a.in[I_EW1]) + ((size_t)l * NE + e) * D * DE;
        tr_item(src, DE, (seg >> 1) * 128 + nb * 32, kb * 64, (bf16_t*)(ws + WS_WEXP13) + (size_t)e * 512 * D, seg * 128 + nb * 32, D, scr, lane); return; }
    r -= 256; { const int nb = r % 32, kb = r / 32;
        tr_item(a.in[I_EW2] + ((size_t)l * NE + e) * DE * D, D, nb * 32, kb * 64, (bf16_t*)(ws + WS_WEXP2) + (size_t)e * D * DE, nb * 32, DE, scr, lane); }
}
__device__ __forceinline__ void p0a(const Args& a, Frame& F, bool experts0) {
    const int gw = F.bid * NWAVES + F.wave, NGW = F.G * NWAVES;
    LAS float* cond = (LAS float*)F.lds;
    LAS float* scr = (LAS float*)(F.lds + 65536 + F.wave * 8704);
    if (F.bid * NWAVES < 192) {
        const float* c = a.in[I_C];
        for (int i = F.tid; i < NB * D; i += NTHREADS) cond[i] = siluf_(c[i]);
        __syncthreads();
        if (gw < 192) {
            const int l = gw / 96, j = (gw % 96) * 64 + F.lane;
            const float* w = a.in[I_ADAW] + (size_t)l * D * 6 * D + j;
            float acc[NB];
#pragma unroll
            for (int b = 0; b < NB; ++b) acc[b] = 0.f;
            for (int k = 0; k < D; ++k) { const float wv = w[(size_t)k * 6 * D];
#pragma unroll
                for (int b = 0; b < NB; ++b) acc[b] += cond[b * D + k] * wv; }
            const float bb = a.in[I_ADAB][l * 6 * D + j];
            float* ada = (float*)(F.ws + WS_ADA);
#pragma unroll
            for (int b = 0; b < NB; ++b) ada[((size_t)l * NB + b) * 6 * D + j] = acc[b] + bb;
        }
        __syncthreads();
    }
    const int total = 2 * SW_ITEMS + (experts0 ? EX_ITEMS : 0);
    for (int it = gw; it < total; it += NGW) {
        if (it < 2 * SW_ITEMS) small_item(a, F.ws, it / SW_ITEMS, it % SW_ITEMS, scr, F.lane);
        else expert_item(a, F.ws, 0, it - 2 * SW_ITEMS, scr, F.lane);
    }
}
__device__ __forceinline__ void p_norm(Frame& F, const float* h, const float* w, const float* sh, const float* sc, bf16_t* U) {
    const int gw = F.bid * NWAVES + F.wave, NGW = F.G * NWAVES;
    f32x4 wv[4];
#pragma unroll
    for (int j = 0; j < 4; ++j) wv[j] = ((const f32x4*)w)[F.lane + 64 * j];
    for (int row = gw; row < T; row += NGW) {
        const int b = row / S;
        const f32x4* xr = (const f32x4*)(h + (size_t)row * D) + F.lane;
        f32x4 v[4]; float ss = 0.f;
#pragma unroll
        for (int j = 0; j < 4; ++j) { v[j] = xr[64 * j]; ss += (v[j].x * v[j].x + v[j].y * v[j].y) + (v[j].z * v[j].z + v[j].w * v[j].w); }
        const float r = rsqrtf(wave_sum(ss) * (1.f / D) + EPS);
        u32x2* o = (u32x2*)(U + (size_t)row * D) + F.lane;
#pragma unroll
        for (int j = 0; j < 4; ++j) {
            const f32x4 scv = ((const f32x4*)(sc + (size_t)b * 6 * D))[F.lane + 64 * j], shv = ((const f32x4*)(sh + (size_t)b * 6 * D))[F.lane + 64 * j];
            const f32x4 y = v[j] * r * wv[j] * (scv + 1.f) + shv;
            u32x2 pk; pk.x = pk2(y.x, y.y); pk.y = pk2(y.z, y.w); o[64 * j] = pk;
        }
    }
}
struct SchedDense {
    pg8::TileOrder O; const char* A; const char* B; size_t tstep;
    __device__ bool next(int i, pg8::Unit& u) const { u.e = 0; return O.tile(i, u.pm, u.pn); }
    __device__ const char* a_ptr(const pg8::Unit& u) const { return A + (size_t)u.pm * tstep; }
    __device__ const char* b_ptr(const pg8::Unit& u) const { return B + (size_t)u.pn * tstep; }
    __device__ const int* a_rows(const pg8::Unit&) const { return nullptr; }
};
struct EpiInProj {
    static constexpr bool PERM = true;
    bf16_t* PB; float* small;
    __device__ __forceinline__ void operator()(const f32x4 (&acc)[2][2][4][2], const pg8::Unit& u, int wr, int wc, int fr, int fq) const {
        const int row0 = u.pm * 256 + wr * 64 + fr;
        if (u.pn < 24) {
            bf16_t* base = PB + (size_t)(u.pn >> 2) * (PB_STRIDE / 2) + (u.pn & 3) * 256 + wc * 32 + 8 * fq;
#pragma unroll
            for (int ai = 0; ai < 2; ++ai)
#pragma unroll
                for (int m = 0; m < 4; ++m) { bf16_t* rowp = base + (size_t)(row0 + ai * 128 + m * 16) * D;
#pragma unroll
                    for (int bj = 0; bj < 2; ++bj) { const f32x4 v0 = acc[ai][bj][m][0], v1 = acc[ai][bj][m][1];
                        u32x4 w; w.x = cvt_pk_bf16(v0[0], v0[1]); w.y = cvt_pk_bf16(v0[2], v0[3]); w.z = cvt_pk_bf16(v1[0], v1[1]); w.w = cvt_pk_bf16(v1[2], v1[3]);
                        *(u32x4*)(rowp + bj * 128) = w; } }
        } else if (wc == 0) {
#pragma unroll
            for (int ai = 0; ai < 2; ++ai)
#pragma unroll
                for (int m = 0; m < 4; ++m) { float* rp = small + (size_t)(row0 + ai * 128 + m * 16) * 32 + 8 * fq;
                    *(f32x4*)rp = acc[ai][0][m][0]; *(f32x4*)(rp + 4) = acc[ai][0][m][1]; }
        }
    }
};
__device__ __forceinline__ void p_inproj(Frame& F, int l) {
    SchedDense Sd; Sd.O.init(T / 256, 25, F.G, F.bid); Sd.A = (const char*)(F.ws + WS_U); Sd.B = (const char*)wsm(F.ws, l, WO_IN); Sd.tstep = (size_t)256 * D * 2;
    EpiInProj E{(bf16_t*)(F.ws + WS_PB), (float*)(F.ws + WS_SMALL)};
    pg8::gemm_phase<EpiInProj, SchedDense, false>(F.lds, D, Sd, E);
}


struct EpiSig { static constexpr bool PERM = true;
    bf16_t* PB;
    __device__ __forceinline__ void operator()(const f32x4 (&acc)[2][2][4][2], const pg8::Unit& u, int wr, int wc, int fr, int fq) const {
        const int row0 = u.pm * 256 + wr * 64 + fr;
        bf16_t* base = PB + (size_t)(u.pn >> 2) * (PB_STRIDE / 2) + (u.pn & 3) * 256 + wc * 32 + 8 * fq;
#pragma unroll
        for (int ai = 0; ai < 2; ++ai)
#pragma unroll
            for (int m = 0; m < 4; ++m) { bf16_t* rowp = base + (size_t)(row0 + ai * 128 + m * 16) * D;
#pragma unroll
                for (int bj = 0; bj < 2; ++bj) { const f32x4 v0 = acc[ai][bj][m][0], v1 = acc[ai][bj][m][1];
                    u32x4 w; w.x = cvt_pk_bf16(sigmoidf_(v0[0]), sigmoidf_(v0[1])); w.y = cvt_pk_bf16(sigmoidf_(v0[2]), sigmoidf_(v0[3]));
                    w.z = cvt_pk_bf16(sigmoidf_(v1[0]), sigmoidf_(v1[1])); w.w = cvt_pk_bf16(sigmoidf_(v1[2]), sigmoidf_(v1[3]));
                    *(u32x4*)(rowp + bj * 128) = w; } }
    }
};
__device__ __forceinline__ void p_gates(Frame& F, int l) {
    SchedDense Sd; Sd.O.init(T / 256, 8, F.G, F.bid); Sd.A = (const char*)(F.ws + WS_U); Sd.B = (const char*)wsm(F.ws, l, WO_GAB); Sd.tstep = (size_t)256 * D * 2;
    EpiSig E{(bf16_t*)(F.ws + WS_PB)};
    pg8::gemm_phase<EpiSig, SchedDense, false>(F.lds, D, Sd, E);
}
struct SchedY {
    pg8::TileOrder O; const char* A0; const char* A1; const char* B0; const char* B1; size_t tstep;
    __device__ bool next(int i, pg8::Unit& u) const { u.e = i & 1; return O.tile(i >> 1, u.pm, u.pn); }
    __device__ const char* a_ptr(const pg8::Unit& u) const { return (u.e ? A1 : A0) + (size_t)u.pm * tstep; }
    __device__ const char* b_ptr(const pg8::Unit& u) const { return (u.e ? B1 : B0) + (size_t)u.pn * tstep; }
    __device__ const int* a_rows(const pg8::Unit&) const { return nullptr; }
};
struct EpiY { static constexpr bool PERM = true;
    const bf16_t* SA; const bf16_t* SB; bf16_t* Y;
    __device__ __forceinline__ void operator()(const f32x4 (&acc)[2][2][4][2], const pg8::Unit& u, int wr, int wc, int fr, int fq) const {
        const int row0 = u.pm * 256 + wr * 64 + fr; const size_t colb = (size_t)u.pn * 256 + wc * 32 + 8 * fq;
        const bf16_t* G = u.e ? SB : SA;
#pragma unroll
        for (int ai = 0; ai < 2; ++ai)
#pragma unroll
            for (int m = 0; m < 4; ++m) { const size_t ro = (size_t)(row0 + ai * 128 + m * 16) * D + colb;
#pragma unroll
                for (int bj = 0; bj < 2; ++bj) { const f32x4 v0 = acc[ai][bj][m][0], v1 = acc[ai][bj][m][1];
                    const u32x4 g = *(const u32x4*)(G + ro + bj * 128);
                    float r0 = bflo(g.x) * v0[0], r1 = bfhi(g.x) * v0[1], r2 = bflo(g.y) * v0[2], r3 = bfhi(g.y) * v0[3], r4 = bflo(g.z) * v1[0], r5 = bfhi(g.z) * v1[1], r6 = bflo(g.w) * v1[2], r7 = bfhi(g.w) * v1[3];
                    if (u.e) { const u32x4 y = *(const u32x4*)(Y + ro + bj * 128);
                        r0 += bflo(y.x); r1 += bfhi(y.x); r2 += bflo(y.y); r3 += bfhi(y.y); r4 += bflo(y.z); r5 += bfhi(y.z); r6 += bflo(y.w); r7 += bfhi(y.w); }
                    u32x4 w; w.x = cvt_pk_bf16(r0, r1); w.y = cvt_pk_bf16(r2, r3); w.z = cvt_pk_bf16(r4, r5); w.w = cvt_pk_bf16(r6, r7);
                    *(u32x4*)(Y + ro + bj * 128) = w; } }
    }
};
__device__ __forceinline__ void p_y(Frame& F, int l) {
    SchedY Sy; Sy.O.init(T / 256, 4, F.G, F.bid); Sy.A0 = (const char*)(F.ws + WS_PB + 2 * PB_STRIDE); Sy.A1 = (const char*)(F.ws + WS_PB + 5 * PB_STRIDE);
    Sy.B0 = (const char*)wsm(F.ws, l, WO_PA); Sy.B1 = (const char*)wsm(F.ws, l, WO_PB); Sy.tstep = (size_t)256 * D * 2;
    EpiY E{(const bf16_t*)(F.ws + WS_PB), (const bf16_t*)(F.ws + WS_PB + PB_STRIDE), (bf16_t*)(F.ws + WS_PB + 3 * PB_STRIDE)};
    pg8::gemm_phase<EpiY, SchedY, false>(F.lds, D, Sy, E);
}
struct EpiResid { static constexpr bool PERM = false;
    const float* hin; float* hout; const float* gate;
    __device__ __forceinline__ void operator()(const f32x4 (&acc)[2][2][4][2], const pg8::Unit& u, int wr, int wc, int fr, int fq) const {
        const int row0 = u.pm * 256 + wr * 64 + fr, col0 = u.pn * 256 + wc * 32 + 4 * fq;
        const int b = (u.pm * 256) / S;
        f32x4 gv[2][2];
#pragma unroll
        for (int bj = 0; bj < 2; ++bj)
#pragma unroll
            for (int n = 0; n < 2; ++n) gv[bj][n] = *(const f32x4*)(gate + (size_t)b * 6 * D + col0 + bj * 128 + n * 16);
#pragma unroll
        for (int ai = 0; ai < 2; ++ai)
#pragma unroll
            for (int m = 0; m < 4; ++m) { const size_t ro = (size_t)(row0 + ai * 128 + m * 16) * D + col0;
#pragma unroll
                for (int bj = 0; bj < 2; ++bj)
#pragma unroll
                    for (int n = 0; n < 2; ++n) { const f32x4 hv = *(const f32x4*)(hin + ro + bj * 128 + n * 16);
                        *(f32x4*)(hout + ro + bj * 128 + n * 16) = hv + gv[bj][n] * acc[ai][bj][m][n]; } }
    }
};
__device__ __forceinline__ void p_wo(const Args& a, Frame& F, int l) {
    SchedDense Sd; Sd.O.init(T / 256, 4, F.G, F.bid); Sd.A = (const char*)(F.ws + WS_PB + 3 * PB_STRIDE); Sd.B = (const char*)wsm(F.ws, l, WO_O); Sd.tstep = (size_t)256 * D * 2;
    EpiResid E{l == 0 ? a.in[I_X] : a.out, a.out, (const float*)(F.ws + WS_ADA) + (size_t)l * NB * 6 * D + 2 * D};
    pg8::gemm_phase<EpiResid, SchedDense, false>(F.lds, D, Sd, E);
}


constexpr size_t WS_IDENT = 165 * MiB;
constexpr size_t WS_Y2H = 166 * MiB;
constexpr int VTILES = NBLK + T / 256, VROWS = VTILES * 256;
constexpr size_t WS_HB = WS_Y2H + (size_t)VROWS * 512 * 2;
constexpr size_t WS_MOE_END = WS_HB + (size_t)VROWS * 256 * 2;
static_assert(WS_MOE_END <= 622 * MiB, "moe overlay");

__device__ __forceinline__ void p_norm2(const Args& a, Frame& F, int l) {
    const float* ada = (const float*)(F.ws + WS_ADA) + (size_t)l * NB * 6 * D;
    int* ident = (int*)(F.ws + WS_IDENT); int* row_tok = (int*)(F.ws + WS_ROWTOK);
    for (int i = F.bid * NTHREADS + F.tid; i < NROWS; i += F.G * NTHREADS) { row_tok[i] = 0; if (i < T) ident[i] = i; }
    p_norm(F, a.out, a.in[I_NMOEW] + l * D, ada + 3 * D, ada + 4 * D, (bf16_t*)(F.ws + WS_U));
}
struct EpiLogits { static constexpr bool PERM = false; float* L;
    __device__ __forceinline__ void operator()(const f32x4 (&acc)[2][2][4][2], const pg8::Unit& u, int wr, int wc, int fr, int fq) const {
        if (wc >= 2) return;
        const int row0 = u.pm * 256 + wr * 64 + fr, col0 = wc * 32 + 4 * fq;
#pragma unroll
        for (int ai = 0; ai < 2; ++ai)
#pragma unroll
            for (int m = 0; m < 4; ++m) { float* rp = L + (size_t)(row0 + ai * 128 + m * 16) * NE + col0;
#pragma unroll
                for (int n = 0; n < 2; ++n) *(f32x4*)(rp + n * 16) = acc[ai][0][m][n]; }
    }
};
__device__ __forceinline__ void p_router(Frame& F, int l) {
    SchedDense Sd; Sd.O.init(T / 256, 1, F.G, F.bid); Sd.A = (const char*)(F.ws + WS_U); Sd.B = (const char*)wsm(F.ws, l, WO_R); Sd.tstep = (size_t)256 * D * 2;
    EpiLogits E{(float*)(F.ws + WS_LOGITS)};
    pg8::gemm_phase<EpiLogits, SchedDense, false>(F.lds, D, Sd, E);
}
__device__ __forceinline__ void p_topk(const Args& a, Frame& F, int l) {
    LAS int* lcnt = (LAS int*)(F.lds); LAS int* lbase = lcnt + 64;
    const float* logits = (const float*)(F.ws + WS_LOGITS); const float* router_b = a.in[I_RB] + l * NE;
    int* eidx = (int*)(F.ws + WS_EIDX); float* wts = (float*)(F.ws + WS_WTS); int* pos = (int*)(F.ws + WS_POS);
    int* gcnt = (int*)(F.ws + WS_CTL) + CW_CNT + l * 64;
    for (int blk = F.bid; blk < T / 128; blk += F.G) {
        __syncthreads();
        if (F.tid < 64) lcnt[F.tid] = 0;
        __syncthreads();
        const int t = blk * 128 + F.tid;
        int ei[TOPK]; float wv[TOPK]; int lp[TOPK]; float wsum = 0.f;
        if (F.tid < 128) {
            float sc[NE], sel[NE];
#pragma unroll
            for (int e = 0; e < NE; ++e) { sc[e] = sigmoidf_(logits[(size_t)t * NE + e]); sel[e] = sc[e] + router_b[e]; }
            float gs[8];
#pragma unroll
            for (int g = 0; g < 8; ++g) { float m1 = -INFINITY, m2 = -INFINITY;
#pragma unroll
                for (int j = 0; j < 8; ++j) { const float v = sel[g * 8 + j]; if (v > m1) { m2 = m1; m1 = v; } else if (v > m2) m2 = v; }
                gs[g] = m1 + m2; }
            unsigned gmask = 0;
#pragma unroll
            for (int k = 0; k < 4; ++k) { int best = -1; float bv = -INFINITY;
#pragma unroll
                for (int g = 0; g < 8; ++g) if (!((gmask >> g) & 1u) && (best < 0 || gs[g] > bv)) { best = g; bv = gs[g]; }
                gmask |= 1u << best; }
            unsigned long long taken = 0ull;
#pragma unroll
            for (int k = 0; k < TOPK; ++k) { int best = -1; float bv = -INFINITY;
#pragma unroll
                for (int e = 0; e < NE; ++e) { const bool ok = ((gmask >> (e >> 3)) & 1u) && !((taken >> e) & 1ull); if (ok && (best < 0 || sel[e] > bv)) { best = e; bv = sel[e]; } }
                taken |= 1ull << best; ei[k] = best; float s = 0.f;
#pragma unroll
                for (int e = 0; e < NE; ++e) s = (e == best) ? sc[e] : s;
                wv[k] = s; wsum += s; }
#pragma unroll
            for (int k = 0; k < TOPK; ++k) lp[k] = __hip_atomic_fetch_add(&lcnt[ei[k]], 1, __ATOMIC_RELAXED, __HIP_MEMORY_SCOPE_WORKGROUP);
        }
        __syncthreads();
        if (F.tid < 64) lbase[F.tid] = atomicAdd(&gcnt[F.tid], lcnt[F.tid]);
        __syncthreads();
        if (F.tid < 128) {
#pragma unroll
            for (int k = 0; k < TOPK; ++k) { eidx[t * TOPK + k] = ei[k]; wts[t * TOPK + k] = wv[k] / wsum * 2.5f; pos[t * TOPK + k] = lbase[ei[k]] + lp[k]; }
        }
    }
}
__device__ __forceinline__ int load_pend(Frame& F, int l, LAS int* pend) {
    const int* gcnt = (const int*)(F.ws + WS_CTL) + CW_CNT + l * 64;
    __syncthreads();
    if (F.tid == 0) { int acc = 0; for (int e = 0; e < NE; ++e) { acc += (gcnt[e] + 255) / 256 * 256; pend[e] = acc; } }
    __syncthreads();
    return pend[NE - 1] / 256;
}
__device__ __forceinline__ void p_fill(Frame& F, int l) {
    LAS int* pend = (LAS int*)(F.lds + MISC_OFF + 1024);
    load_pend(F, l, pend);
    const int* eidx = (const int*)(F.ws + WS_EIDX); int* pos = (int*)(F.ws + WS_POS); int* row_tok = (int*)(F.ws + WS_ROWTOK);
    for (int i = F.bid * NTHREADS + F.tid; i < NASSIGN; i += F.G * NTHREADS) {
        const int e = eidx[i]; const int dest = (e ? pend[e - 1] : 0) + pos[i];
        row_tok[dest] = i / TOPK; pos[i] = dest;
    }
}
struct SchedMoe1 {
    int G, c, ntiles; const LAS int* pend; const char* Ubase; const char* W13; const char* Ws13; const int* row_tok; const int* ident;
    __device__ bool next(int i, pg8::Unit& u) const {
        const int q = i * G + c; if (q >= 2 * (ntiles + T / 256)) return false;
        const int j = q >> 1; u.pn = q & 1;
        if (j < ntiles) { u.pm = j; int e = 0; while (e < NE - 1 && pend[e] <= j * 256) ++e; u.e = e; } else { u.pm = NBLK + (j - ntiles); u.e = NE; }
        return true; }
    __device__ const char* a_ptr(const pg8::Unit&) const { return Ubase; }
    __device__ const char* b_ptr(const pg8::Unit& u) const { return (u.e < NE ? W13 + (size_t)u.e * 512 * D * 2 : Ws13) + (size_t)u.pn * 256 * D * 2; }
    __device__ const int* a_rows(const pg8::Unit& u) const { return u.e < NE ? row_tok + (size_t)u.pm * 256 : ident + (size_t)(u.pm - NBLK) * 256; }
};
struct EpiHb { static constexpr bool PERM = true; bf16_t* HB;
    __device__ __forceinline__ void operator()(const f32x4 (&acc)[2][2][4][2], const pg8::Unit& u, int wr, int wc, int fr, int fq) const {
        const int row0 = u.pm * 256 + wr * 64 + fr; bf16_t* base = HB + u.pn * 128 + wc * 32 + 8 * fq;
#pragma unroll
        for (int ai = 0; ai < 2; ++ai)
#pragma unroll
            for (int m = 0; m < 4; ++m) { const f32x4 a0 = acc[ai][0][m][0], a1 = acc[ai][0][m][1], b0 = acc[ai][1][m][0], b1 = acc[ai][1][m][1];
                u32x4 w; w.x = cvt_pk_bf16(siluf_(a0[0]) * b0[0], siluf_(a0[1]) * b0[1]); w.y = cvt_pk_bf16(siluf_(a0[2]) * b0[2], siluf_(a0[3]) * b0[3]);
                w.z = cvt_pk_bf16(siluf_(a1[0]) * b1[0], siluf_(a1[1]) * b1[1]); w.w = cvt_pk_bf16(siluf_(a1[2]) * b1[2], siluf_(a1[3]) * b1[3]);
                *(u32x4*)(base + (size_t)(row0 + ai * 128 + m * 16) * DE) = w; }
    }
};
__device__ __forceinline__ int vcu_of(const Frame& F) { return (F.G % 8 == 0) ? (F.bid % 8) * (F.G / 8) + F.bid / 8 : F.bid; }
__device__ __forceinline__ void p_gemm1(Frame& F, int l) {
    LAS int* pend = (LAS int*)(F.lds + MISC_OFF + 1024);
    const int ntiles = load_pend(F, l, pend);
    SchedMoe1 Sm{F.G, vcu_of(F), ntiles, pend, (const char*)(F.ws + WS_U), (const char*)(F.ws + WS_WEXP13), (const char*)wsm(F.ws, l, WO_S13), (const int*)(F.ws + WS_ROWTOK), (const int*)(F.ws + WS_IDENT)};
    EpiHb E{(bf16_t*)(F.ws + WS_HB)};
    pg8::gemm_phase<EpiHb, SchedMoe1, true>(F.lds, D, Sm, E);
}
struct SchedMoe2 {
    int G, c, ntiles, hh; const LAS int* pend; const char* HB; const char* W2; const char* Ws2;
    __device__ bool next(int i, pg8::Unit& u) const {
        const int q = i * G + c; if (q >= 2 * (ntiles + T / 256)) return false;
        const int j = q >> 1; u.pn = q & 1;
        if (j < ntiles) { u.pm = j; int e = 0; while (e < NE - 1 && pend[e] <= j * 256) ++e; u.e = e; } else { u.pm = NBLK + (j - ntiles); u.e = NE; }
        return true; }
    __device__ const char* a_ptr(const pg8::Unit& u) const { return HB + (size_t)u.pm * 256 * DE * 2; }
    __device__ const char* b_ptr(const pg8::Unit& u) const { return (u.e < NE ? W2 + (size_t)u.e * D * DE * 2 : Ws2) + (size_t)(512 * hh + 256 * u.pn) * DE * 2; }
    __device__ const int* a_rows(const pg8::Unit&) const { return nullptr; }
};
struct EpiY2 { static constexpr bool PERM = true; bf16_t* Y;
    __device__ __forceinline__ void operator()(const f32x4 (&acc)[2][2][4][2], const pg8::Unit& u, int wr, int wc, int fr, int fq) const {
        const int row0 = u.pm * 256 + wr * 64 + fr; bf16_t* base = Y + u.pn * 256 + wc * 32 + 8 * fq;
#pragma unroll
        for (int ai = 0; ai < 2; ++ai)
#pragma unroll
            for (int m = 0; m < 4; ++m) { bf16_t* rowp = base + (size_t)(row0 + ai * 128 + m * 16) * 512;
#pragma unroll
                for (int bj = 0; bj < 2; ++bj) { const f32x4 v0 = acc[ai][bj][m][0], v1 = acc[ai][bj][m][1];
                    u32x4 w; w.x = cvt_pk_bf16(v0[0], v0[1]); w.y = cvt_pk_bf16(v0[2], v0[3]); w.z = cvt_pk_bf16(v1[0], v1[1]); w.w = cvt_pk_bf16(v1[2], v1[3]);
                    *(u32x4*)(rowp + bj * 128) = w; } }
    }
};
__device__ __forceinline__ void p_gemm2(Frame& F, int l, int hh) {
    LAS int* pend = (LAS int*)(F.lds + MISC_OFF + 1024);
    const int ntiles = load_pend(F, l, pend);
    SchedMoe2 Sm{F.G, vcu_of(F), ntiles, hh, pend, (const char*)(F.ws + WS_HB), (const char*)(F.ws + WS_WEXP2), (const char*)wsm(F.ws, l, WO_S2)};
    EpiY2 E{(bf16_t*)(F.ws + WS_Y2H)};
    pg8::gemm_phase<EpiY2, SchedMoe2, false>(F.lds, DE, Sm, E);
}
__device__ __forceinline__ void p_combine(const Args& a, Frame& F, int l, int hh) {
    const int gw = F.bid * NWAVES + F.wave, NGW = F.G * NWAVES;
    const bf16_t* Y = (const bf16_t*)(F.ws + WS_Y2H); const int* slots = (const int*)(F.ws + WS_POS); const float* wts = (const float*)(F.ws + WS_WTS);
    const float* gt = (const float*)(F.ws + WS_ADA) + (size_t)l * NB * 6 * D + 5 * D + 512 * hh + F.lane * 8;
    for (int t = gw; t < T; t += NGW) {
        const int b = t / S;
        float acc[8];
        { const u32x4 v = *(const u32x4*)(Y + ((size_t)NBLK * 256 + t) * 512 + F.lane * 8);
          acc[0] = bflo(v.x); acc[1] = bfhi(v.x); acc[2] = bflo(v.y); acc[3] = bfhi(v.y); acc[4] = bflo(v.z); acc[5] = bfhi(v.z); acc[6] = bflo(v.w); acc[7] = bfhi(v.w); }
#pragma unroll
        for (int k = 0; k < TOPK; ++k) { const int slot = slots[t * TOPK + k]; const float w = wts[t * TOPK + k];
            const u32x4 v = *(const u32x4*)(Y + (size_t)slot * 512 + F.lane * 8);
            acc[0] += w * bflo(v.x); acc[1] += w * bfhi(v.x); acc[2] += w * bflo(v.y); acc[3] += w * bfhi(v.y); acc[4] += w * bflo(v.z); acc[5] += w * bfhi(v.z); acc[6] += w * bflo(v.w); acc[7] += w * bfhi(v.w); }
        float* o = a.out + (size_t)t * D + 512 * hh + F.lane * 8;
        const f32x4 g0 = *(const f32x4*)(gt + (size_t)b * 6 * D), g1 = *(const f32x4*)(gt + (size_t)b * 6 * D + 4);
        f32x4 o0 = *(const f32x4*)o, o1 = *(const f32x4*)(o + 4);
        o0 += g0 * (f32x4){acc[0], acc[1], acc[2], acc[3]}; o1 += g1 * (f32x4){acc[4], acc[5], acc[6], acc[7]};
        *(f32x4*)o = o0; *(f32x4*)(o + 4) = o1;
    }
}
__device__ __forceinline__ void p_expert_cvt(const Args& a, Frame& F, int l) {
    const int gw = F.bid * NWAVES + F.wave, NGW = F.G * NWAVES;
    LAS float* scr = (LAS float*)(F.lds + 65536 + F.wave * 8704);
    for (int it = gw; it < EX_ITEMS; it += NGW) expert_item(a, F.ws, l, it, scr, F.lane);
}
__device__ __forceinline__ void p_final(const Args& a, Frame& F) {
    const int gw = F.bid * NWAVES + F.wave, NGW = F.G * NWAVES;
    f32x4 wv[4];
#pragma unroll
    for (int j = 0; j < 4; ++j) wv[j] = ((const f32x4*)a.in[I_FNW])[F.lane + 64 * j];
    for (int row = gw; row < T; row += NGW) {
        f32x4* xr = (f32x4*)(a.out + (size_t)row * D) + F.lane;
        f32x4 v[4]; float ss = 0.f;
#pragma unroll
        for (int j = 0; j < 4; ++j) { v[j] = xr[64 * j]; ss += (v[j].x * v[j].x + v[j].y * v[j].y) + (v[j].z * v[j].z + v[j].w * v[j].w); }
        const float r = rsqrtf(wave_sum(ss) * (1.f / D) + EPS);
#pragma unroll
        for (int j = 0; j < 4; ++j) xr[64 * j] = v[j] * r * wv[j];
    }
}

__device__ __forceinline__ void mlstm_seq(const Args& a, Frame& F, int l, int b, int hd) {
    LAS float* qs = (LAS float*)F.lds; LAS float* ks = qs + 128; LAS float* ns = ks + 128; LAS float* sc = ns + 128; LAS float* pn = sc + 8; LAS float* pd = pn + 512; LAS float* red = pd + 512;
    const int tid = F.tid, e = tid & 255, dh = tid >> 8;
    const bf16_t* QK = (const bf16_t*)(F.ws + WS_PB) + (size_t)b * S * D; const bf16_t* VM = (const bf16_t*)(F.ws + WS_PB + PB_STRIDE) + (size_t)b * S * D;
    bf16_t* OM = (bf16_t*)(F.ws + WS_PB + 2 * PB_STRIDE) + (size_t)b * S * D; const float* SM = (const float*)(F.ws + WS_SMALL) + (size_t)b * S * 32;
    const float* conv_w = a.in[I_CONVW] + (size_t)l * 4 * 1024; const float* gate_b = a.in[I_GATEB] + l * 8;
    float Cst[64];
#pragma unroll
    for (int d = 0; d < 64; ++d) Cst[d] = 0.f;
    if (tid < 128) ns[tid] = 0.f;
    float m_run = 0.f;
    const int col = (tid < 128) ? (512 + hd * 128 + tid) : (hd * 128 + ((tid - 128) & 127));
    const float w0 = conv_w[0 * 1024 + col], w1 = conv_w[1 * 1024 + col], w2 = conv_w[2 * 1024 + col], w3 = conv_w[3 * 1024 + col];
    const float gbi = gate_b[hd], gbf = gate_b[4 + hd], mnw = a.in[I_MNORMW][l * D + hd * 256 + e];
    float x0 = 0.f, x1 = 0.f, x2 = 0.f;
    for (int t = 0; t < S; ++t) {
        float cv = 0.f;
        if (tid < 256) { const float x3 = bf2f(QK[(size_t)t * D + col]); cv = siluf_(w0 * x0 + w1 * x1 + w2 * x2 + w3 * x3); x0 = x1; x1 = x2; x2 = x3; }
        __syncthreads();
        if (tid < 128) ks[tid] = cv; else if (tid < 256) qs[tid - 128] = cv * 0.08838834764831845f;
        if (tid == 256) {
            const float li = 15.f * tanhf((SM[t * 32 + hd] + gbi) * (1.f / 15.f));
            const float lf = logsigmoidf_(15.f * tanhf((SM[t * 32 + 4 + hd] + gbf) * (1.f / 15.f)));
            const float m_new = fmaxf(lf + m_run, li);
            sc[0] = __expf(lf + m_run - m_new); sc[1] = __expf(li - m_new); sc[2] = __expf(-m_new); m_run = m_new;
        }
        __syncthreads();
        const float fd = sc[0], id = sc[1], lowb = sc[2];
        if (tid < 128) ns[tid] = fd * ns[tid] + id * ks[tid];
        __syncthreads();
        const float v = bf2f(VM[(size_t)t * D + hd * 256 + e]) * id;
        float num = 0.f, den = 0.f;
#pragma unroll
        for (int d = 0; d < 64; ++d) { const int dd = dh * 64 + d; Cst[d] = fd * Cst[d] + ks[dd] * v; num += qs[dd] * Cst[d]; den += qs[dd] * ns[dd]; }
        pn[dh * 256 + e] = num; pd[dh * 256 + e] = den;
        __syncthreads();
        float h = 0.f;
        if (dh == 0) { num = pn[e] + pn[256 + e]; den = pd[e] + pd[256 + e]; h = num / fmaxf(fabsf(den), lowb); const float ss = wave_sum(h * h); if (F.lane == 0) red[F.wave] = ss; }
        __syncthreads();
        if (dh == 0) { const float r = rsqrtf((red[0] + red[1] + red[2] + red[3]) * (1.f / 256.f) + EPS); const size_t idx = (size_t)t * D + hd * 256 + e;
            OM[idx] = (bf16_t)f2bf(h * r * mnw * sigmoidf_(bf2f(OM[idx]))); }
    }
}
__device__ __forceinline__ void gla_seq(const Args& a, Frame& F, int l, int b, int hd) {
    LAS float* qs = (LAS float*)F.lds; LAS float* ks = qs + 128; LAS float* as = ks + 128; LAS float* pn = as + 128 + 8; LAS float* red = pn + 512;
    const int tid = F.tid, e = tid & 255, dh = tid >> 8;
    const bf16_t* QKG = (const bf16_t*)(F.ws + WS_PB + 3 * PB_STRIDE) + (size_t)b * S * D; const bf16_t* VG = (const bf16_t*)(F.ws + WS_PB + 4 * PB_STRIDE) + (size_t)b * S * D;
    bf16_t* ZG = (bf16_t*)(F.ws + WS_PB + 5 * PB_STRIDE) + (size_t)b * S * D; const float* SM = (const float*)(F.ws + WS_SMALL) + (size_t)b * S * 32;
    const float* alpha_w = a.in[I_ALPHAW] + (size_t)l * 16 * 512; const float* alpha_b = a.in[I_ALPHAB] + l * 512;
    float Sst[64];
#pragma unroll
    for (int d = 0; d < 64; ++d) Sst[d] = 0.f;
    float aw[16]; float ab = 0.f;
#pragma unroll
    for (int r = 0; r < 16; ++r) aw[r] = alpha_w[r * 512 + hd * 128 + (tid & 127)];
    ab = alpha_b[hd * 128 + (tid & 127)];
    const float gnw = a.in[I_GNORMW][l * D + hd * 256 + e];
    for (int t = 0; t < S; ++t) {
        __syncthreads();
        if (tid < 128) {
            float x = ab;
#pragma unroll
            for (int r = 0; r < 16; ++r) x += SM[t * 32 + 8 + r] * aw[r];
            as[tid] = __expf(logsigmoidf_(x) * (1.f / 16.f));
            ks[tid] = bf2f(QKG[(size_t)t * D + 512 + hd * 128 + tid]);
        } else if (tid < 256) qs[tid - 128] = bf2f(QKG[(size_t)t * D + hd * 128 + tid - 128]) * 0.08838834764831845f;
        __syncthreads();
        const float v = bf2f(VG[(size_t)t * D + hd * 256 + e]);
        float o = 0.f;
#pragma unroll
        for (int d = 0; d < 64; ++d) { const int dd = dh * 64 + d; Sst[d] = as[dd] * Sst[d] + ks[dd] * v; o += qs[dd] * Sst[d]; }
        pn[dh * 256 + e] = o;
        __syncthreads();
        float h = 0.f;
        if (dh == 0) { h = pn[e] + pn[256 + e]; const float ss = wave_sum(h * h); if (F.lane == 0) red[F.wave] = ss; }
        __syncthreads();
        if (dh == 0) { const float r = rsqrtf((red[0] + red[1] + red[2] + red[3]) * (1.f / 256.f) + EPS); const size_t idx = (size_t)t * D + hd * 256 + e;
            ZG[idx] = (bf16_t)f2bf(h * r * gnw * siluf_(bf2f(ZG[idx]))); }
    }
}
__device__ __forceinline__ void p_mixers_seq(const Args& a, Frame& F, int l) {
    for (int s = F.bid; s < 128; s += F.G) {
        __syncthreads();
        if (s < 64) mlstm_seq(a, F, l, s >> 2, s & 3); else gla_seq(a, F, l, (s - 64) >> 2, s & 3);
    }
}
__global__ void __launch_bounds__(NTHREADS, 2) mega(Args a) {
    extern __shared__ __attribute__((aligned(16))) unsigned char lds_raw[];
    Frame F; F.lds = (LAS unsigned char*)lds_raw; F.ws = a.ws; F.tid = threadIdx.x; F.lane = F.tid & 63; F.wave = __builtin_amdgcn_readfirstlane(F.tid >> 6); F.G = gridDim.x; F.bid = blockIdx.x;
    const int lo = a.ph_lo, hi = a.ph_hi, l = a.layer;
#define IN(k) (lo <= (k) && (k) < hi)
    if (IN(0)) p0a(a, F, true);
    if (IN(1)) {
        const float* ada = (const float*)(F.ws + WS_ADA) + (size_t)l * NB * 6 * D;
        p_norm(F, l == 0 ? a.in[I_X] : a.out, a.in[I_NMIXW] + l * D, ada + 0 * D, ada + 1 * D, (bf16_t*)(F.ws + WS_U));
    }
    if (IN(2)) p_inproj(F, l);
    if (IN(3)) p_mixers_seq(a, F, l);
    if (IN(4)) p_gates(F, l);
    if (IN(5)) p_y(F, l);
    if (IN(6)) p_wo(a, F, l);
    if (IN(7)) p_norm2(a, F, l);
    if (IN(8)) p_router(F, l);
    if (IN(9)) p_topk(a, F, l);
    if (IN(10)) p_fill(F, l);
    if (IN(11)) p_gemm1(F, l);
    if (IN(12)) p_gemm2(F, l, 0);
    if (IN(13)) p_combine(a, F, l, 0);
    if (IN(14)) p_gemm2(F, l, 1);
    if (IN(15)) p_combine(a, F, l, 1);
    if (IN(16)) p_expert_cvt(a, F, 1);
    if (IN(17)) p_final(a, F);
#undef IN
}

__global__ __launch_bounds__(256) void k_cmp_proj(const unsigned char* ws, const float* proj, int rows, int tok0, float* err) {
    const int row = blockIdx.x; const float* pr = proj + (size_t)row * DIN; const size_t t = (size_t)tok0 + row;
    float sd = 0.f, sr = 0.f;
    for (int c = threadIdx.x; c < 6144 + 24; c += 256) {
        float o, r;
        if (c < 6144) { const int buf = c >> 10, cc = c & 1023;
            const int src = buf == 0 ? C_QK + cc : buf == 1 ? C_VM + cc : buf == 2 ? C_OM + cc : buf == 3 ? C_QG + cc : buf == 4 ? C_VG + cc : C_ZG + cc;
            o = bf2f(((const bf16_t*)(ws + WS_PB + (size_t)buf * PB_STRIDE))[t * D + cc]); r = pr[src]; }
        else { const int j = c - 6144; const int src = j < 4 ? C_IM + j : (j < 8 ? C_FM + j - 4 : C_RG + j - 8);
            o = ((const float*)(ws + WS_SMALL))[t * 32 + j]; r = pr[src]; }
        sd += (o - r) * (o - r); sr += r * r;
    }
    sd = wave_sum(sd); sr = wave_sum(sr);
    if ((threadIdx.x & 63) == 0) { atomicAdd(&err[0], sd); atomicAdd(&err[1], sr); }
}
__global__ __launch_bounds__(256) void k_apply_err(float* out, const float* err) {
    const size_t i = (size_t)blockIdx.x * 256 + threadIdx.x;
    const float r = sqrtf(err[0] / fmaxf(err[1], 1e-30f));
    out[i] *= (1.f + r);
}

__global__ __launch_bounds__(256) void k_glue_bf16(const float* src, bf16_t* dst, int rows, int tok0) {
    const size_t i = (size_t)blockIdx.x * 256 + threadIdx.x;
    if (i >= (size_t)rows * D) return;
    dst[(size_t)tok0 * D + i] = (bf16_t)f2bf(src[i]);
}

__global__ __launch_bounds__(256) void k_cmp3(const float* a, const float* b, const float* c, size_t n, float* err) {
    const size_t i = (size_t)blockIdx.x * 256 + threadIdx.x;
    float sd = 0.f, sr = 0.f;
    if (i < n) { sd = (a[i] - b[i]) * (a[i] - b[i]); sr = (b[i] - c[i]) * (b[i] - c[i]); }
    sd = wave_sum(sd); sr = wave_sum(sr);
    if ((threadIdx.x & 63) == 0) { atomicAdd(&err[2], sd); atomicAdd(&err[3], sr); }
}
__global__ __launch_bounds__(256) void k_apply_err2(float* out, const float* err, float amp) {
    const size_t i = (size_t)blockIdx.x * 256 + threadIdx.x;
    const float r = sqrtf(err[2] / fmaxf(err[3], 1e-30f));
    out[i] *= (1.f + amp * r);
}

static void launch_mega(hipStream_t stream, const Args& base, int lo, int hi, int layer) {
    static int grid = 0;
    if (grid == 0) {
        int dev = 0, cus = 0; hipGetDevice(&dev); hipDeviceGetAttribute(&cus, hipDeviceAttributeMultiprocessorCount, dev);
        hipFuncSetAttribute((const void*)mega, hipFuncAttributeMaxDynamicSharedMemorySize, LDS_BYTES);
        grid = cus > 0 ? cus : 256;
    }
    Args a = base; a.ph_lo = lo; a.ph_hi = hi; a.layer = layer; a.pad = 0;
    hipLaunchKernelGGL(mega, dim3(grid), dim3(NTHREADS), LDS_BYTES, stream, a);
}
extern "C" void kernel_launch(void* const* d_in, const int* in_sizes, int n_in, void* d_out, int out_size, void* d_ws, size_t ws_size, hipStream_t stream) {
    if (ws_size < 622 * MiB || n_in != 25) { fprintf(stderr, "kernel_launch: workspace too small or wrong input count\n"); return; }
    Args base{}; for (int i = 0; i < 25; ++i) base.in[i] = (const float*)d_in[i]; base.out = (float*)d_out; base.ws = (unsigned char*)d_ws;
    hipMemsetAsync((char*)d_ws + WS_CTL, 0, CTL_BYTES, stream);
    launch_mega(stream, base, 0, 1, 0);
    for (int l = 0; l < DEPTH; ++l) {
        for (int ph = 1; ph <= 15; ++ph) launch_mega(stream, base, ph, ph + 1, l);
        if (l == 0) launch_mega(stream, base, 16, 17, 0);
    }
    launch_mega(stream, base, 17, 18, 0);
}
```

```cpp
#include <hip/hip_runtime.h>
#include <cstdio>
#include <cstdint>

constexpr int D = 1024, NB = 16, S = 2048, T = NB * S, DEPTH = 2;
constexpr int DIN = 8216;
constexpr int C_QK = 0, C_VM = 1024, C_OM = 2048, C_IM = 3072, C_FM = 3076, C_QG = 3080, C_KG = 3592, C_VG = 4104, C_RG = 5128, C_ZG = 5144, C_GA = 6168, C_GB = 7192;
constexpr int NE = 64, TOPK = 8, DE = 256;
constexpr int NASSIGN = T * TOPK, NROWS = NASSIGN + NE * 256, NBLK = NROWS / 256;
constexpr float EPS = 1e-6f;

__device__ __forceinline__ float sigmoidf_(float x) { return 1.f / (1.f + __expf(-x)); }
__device__ __forceinline__ float siluf_(float x) { return x / (1.f + __expf(-x)); }
__device__ __forceinline__ float logsigmoidf_(float x) { return fminf(x, 0.f) - log1pf(__expf(-fabsf(x))); }
__device__ __forceinline__ float wave_sum(float v) {
#pragma unroll
    for (int o = 1; o < 64; o <<= 1) v += __shfl_xor(v, o);
    return v;
}

#define LAS __attribute__((address_space(3)))
typedef unsigned short bf16_t;
typedef short bf16x8 __attribute__((ext_vector_type(8)));
typedef float f32x4 __attribute__((ext_vector_type(4)));
typedef float f32x2 __attribute__((ext_vector_type(2)));
typedef unsigned u32x4 __attribute__((ext_vector_type(4)));
typedef unsigned u32x2 __attribute__((ext_vector_type(2)));

constexpr size_t MiB = 1u << 20;
constexpr int NWAVES = 8, NTHREADS = 512;
constexpr int LDS_BYTES = 147456;
constexpr int RING_BYTES = 131072, MISC_OFF = RING_BYTES;

constexpr size_t WS_CTL = 0, CTL_BYTES = 1 * MiB;
constexpr size_t WS_ADA = 1 * MiB;
constexpr size_t WS_WSM = 2 * MiB, WSM_STRIDE = 25 * MiB;
constexpr size_t WO_IN = 0, WO_GAB = 12 * MiB + 512 * 1024, WO_PA = WO_GAB + 4 * MiB, WO_PB = WO_PA + 2 * MiB, WO_O = WO_PB + 2 * MiB, WO_S13 = WO_O + 2 * MiB, WO_S2 = WO_S13 + 1 * MiB, WO_R = WO_S2 + 512 * 1024;
constexpr size_t WS_WEXP13 = 52 * MiB, WS_WEXP2 = 116 * MiB;
constexpr size_t WS_SMALL = 148 * MiB;
constexpr size_t WS_LOGITS = 152 * MiB, WS_EIDX = 160 * MiB, WS_WTS = 161 * MiB, WS_POS = 162 * MiB, WS_ROWTOK = 163 * MiB;
constexpr size_t WS_U = 166 * MiB;
constexpr size_t WS_PB = 230 * MiB, PB_STRIDE = 64 * MiB;
constexpr size_t WS_OPT_END = 614 * MiB;
static_assert(WO_R + 512 * 1024 <= WSM_STRIDE, "small weight map");

constexpr int CW_BAR = 4096;
constexpr int CW_CNT = 16384;
constexpr int CW_ERR = 20480;

__device__ __forceinline__ unsigned f2bf(float f) { unsigned u = __builtin_bit_cast(unsigned, f); return (u + 0x7fffu + ((u >> 16) & 1u)) >> 16; }
__device__ __forceinline__ unsigned pk2(float lo, float hi) { return f2bf(lo) | (f2bf(hi) << 16); }
__device__ __forceinline__ float bf2f(unsigned short b) { return __builtin_bit_cast(float, (unsigned)b << 16); }
__device__ __forceinline__ float bflo(unsigned w) { return __builtin_bit_cast(float, w << 16); }
__device__ __forceinline__ float bfhi(unsigned w) { return __builtin_bit_cast(float, w & 0xffff0000u); }
__device__ __forceinline__ unsigned cvt_pk_bf16(float lo, float hi) { unsigned r; asm volatile("v_cvt_pk_bf16_f32 %0, %1, %2" : "=v"(r) : "v"(lo), "v"(hi)); return r; }
#define LDS_WAIT() asm volatile("s_waitcnt lgkmcnt(0)" ::: "memory")
#define VM_WAIT() asm volatile("s_waitcnt vmcnt(0)" ::: "memory")

namespace pg8 {
constexpr int BM = 256, BK = 64, HALF = 128, HTB = HALF * BK * 2, STAGE_BYTES = 8 * HTB, NXCD = 8, WGM = 8;
__host__ __device__ __forceinline__ int lds_byte(int r, int c) { const int st = (r >> 4) * 2 + (c >> 5), rr = r & 15, cc = c & 31, ob = rr * 64 + cc * 2; return st * 1024 + (ob ^ (((ob >> 9) & 1) << 5)); }
__host__ __device__ __forceinline__ void stage_rc(int b, int& R, int& C) { const int st = b / 1024, sb = b % 1024, swz = sb ^ (((sb >> 9) & 1) << 5); R = (st >> 1) * 16 + swz / 64; C = (st & 1) * 32 + (swz % 64) / 2; }
__host__ __device__ __forceinline__ int perm32(int rho) { const int n = rho >> 4, i = rho & 15; return 8 * (i >> 2) + 4 * n + (i & 3); }

struct Unit { int pm, pn, e; };

struct TileOrder {
    int nM, nN, nwg, G, c;
    __device__ void init(int nM_, int nN_, int G_, int c_) { nM = nM_; nN = nN_; nwg = nM * nN; G = G_; c = c_; }
    __device__ bool tile(int i, int& pm, int& pn) const {
        const long L = (long)i * G + c; if (L >= nwg) return false;
        int wgid = (int)L; { const int q = nwg / NXCD, r = nwg % NXCD, xcd = wgid % NXCD, off = wgid / NXCD; wgid = (xcd < r ? xcd * (q + 1) : r * (q + 1) + (xcd - r) * q) + off; }
        const int nig = WGM * nN, gid = wgid / nig, fm = gid * WGM, gsz = (nM - fm) < WGM ? (nM - fm) : WGM;
        pm = fm + ((wgid % nig) % gsz); pn = (wgid % nig) / gsz; return true;
    }
};

template <class Epi, class Sched, bool GATHER>
__device__ __forceinline__ void gemm_phase(LAS unsigned char* lds, const int K, const Sched& S, const Epi& E) {
    int tid_ = threadIdx.x; asm volatile("" : "+v"(tid_));
    const int tid = tid_, wid = __builtin_amdgcn_readfirstlane(tid >> 6), lane = tid & 63, wr = wid >> 2, wc = wid & 3, fr = lane & 15, fq = lane >> 4;
    const int nt = K / BK;
    unsigned rowA[2], colA[2], voffB[2];
#pragma unroll
    for (int i = 0; i < 2; ++i) { int R, C; stage_rc(tid * 16 + i * 8192, R, C); const int Rb = Epi::PERM ? ((R & ~31) + perm32(R & 31)) : R;
        rowA[i] = (unsigned)R; colA[i] = (unsigned)C * 2u; voffB[i] = (unsigned)(Rb * K + C) * 2u; }
    const size_t kstep = (size_t)(BK * 2);
    const size_t hstep = (size_t)HALF * K * 2;
    const unsigned ldsw = (unsigned)wid * 1024u;
    const int aoff = lds_byte(wr * 64 + fr, fq * 8), boff = lds_byte(wc * 32 + fr, fq * 8);
#define PG8_SA(b, h) (((b) * 2 + (h)) * HTB)
#define PG8_SB(b, h) ((4 + (b) * 2 + (h)) * HTB)
#define PG8_STAGE(bufoff, gbase, voff) do { _Pragma("unroll") for (int _i = 0; _i < 2; ++_i) \
        __builtin_amdgcn_global_load_lds((const unsigned*)((const char*)(gbase) + (voff)[_i]), (LAS unsigned*)(lds + (bufoff) + ldsw + _i * 8192), 16, 0, 0); } while (0)
#define PG8_LDA(dst, b, h) do { _Pragma("unroll") for (int m = 0; m < 4; ++m) _Pragma("unroll") for (int k = 0; k < 2; ++k) dst[m][k] = *(const LAS bf16x8*)(lds + PG8_SA(b, h) + aoff + m * 2048 + k * 1024); } while (0)
#define PG8_LDB(dst, b, h) do { _Pragma("unroll") for (int n = 0; n < 2; ++n) _Pragma("unroll") for (int k = 0; k < 2; ++k) dst[n][k] = *(const LAS bf16x8*)(lds + PG8_SB(b, h) + boff + n * 2048 + k * 1024); } while (0)
#define PG8_MMA(ai, bj, At, Bt) do { __builtin_amdgcn_s_setprio(1); _Pragma("unroll") for (int m = 0; m < 4; ++m) _Pragma("unroll") for (int n = 0; n < 2; ++n) _Pragma("unroll") for (int k = 0; k < 2; ++k) \
        acc[ai][bj][m][n] = __builtin_amdgcn_mfma_f32_16x16x32_bf16(Bt[n][k], At[m][k], acc[ai][bj][m][n], 0, 0, 0); __builtin_amdgcn_s_setprio(0); } while (0)
#define PG8_WAIT_V(n) asm volatile("s_waitcnt vmcnt(" #n ")" ::: "memory")
#define PG8_WAIT_L(n) asm volatile("s_waitcnt lgkmcnt(" #n ")" ::: "memory")
#define PG8_BAR __builtin_amdgcn_s_barrier()
#define PG8_SCHED __builtin_amdgcn_sched_barrier(0)
    Unit cur, nxt; int ui = 0;
    if (!S.next(0, cur)) return;
    unsigned offA[2][2], noffA[2][2];
    {
        const int* tk = GATHER ? S.a_rows(cur) : nullptr;
#pragma unroll
        for (int h = 0; h < 2; ++h)
#pragma unroll
            for (int i = 0; i < 2; ++i) offA[h][i] = (GATHER ? (unsigned)tk[h * HALF + rowA[i]] : (unsigned)(h * HALF) + rowA[i]) * (unsigned)(K * 2) + colA[i];
    }
    f32x4 acc[2][2][4][2];
#pragma unroll
    for (int a = 0; a < 2; ++a)
#pragma unroll
        for (int b = 0; b < 2; ++b)
#pragma unroll
            for (int m = 0; m < 4; ++m)
#pragma unroll
                for (int n = 0; n < 2; ++n) acc[a][b][m][n] = (f32x4){0.f, 0.f, 0.f, 0.f};
    bf16x8 At[4][2], B0[2][2], B1[2][2];
    const char* cA = S.a_ptr(cur); const char* cB = S.b_ptr(cur);
    PG8_STAGE(PG8_SB(0, 0), cB, voffB); PG8_STAGE(PG8_SB(0, 1), cB + hstep, voffB); PG8_STAGE(PG8_SA(0, 0), cA, offA[0]); PG8_STAGE(PG8_SA(0, 1), cA, offA[1]);
    if (wr == 1) PG8_BAR;
    PG8_WAIT_V(2); PG8_BAR;
    PG8_STAGE(PG8_SB(1, 0), cB + kstep, voffB); PG8_STAGE(PG8_SA(1, 0), cA + kstep, offA[0]); PG8_STAGE(PG8_SB(1, 1), cB + hstep + kstep, voffB);
    PG8_WAIT_V(6); PG8_BAR;
    for (;;) {
        const bool has_next = S.next(ui + 1, nxt);
        const char* nA = has_next ? S.a_ptr(nxt) : cA; const char* nB = has_next ? S.b_ptr(nxt) : cB;
        {
            const int* tk = (GATHER && has_next) ? S.a_rows(nxt) : nullptr;
#pragma unroll
            for (int h = 0; h < 2; ++h)
#pragma unroll
                for (int i = 0; i < 2; ++i) noffA[h][i] = (GATHER && has_next) ? (unsigned)tk[h * HALF + rowA[i]] * (unsigned)(K * 2) + colA[i] : offA[h][i];
        }
#pragma unroll 1
        for (int t = 0; t < nt; t += 2) {
            const bool last = (t == nt - 2);
            const char* a1 = cA + (size_t)(t + 1) * kstep;
            const char* a2 = last ? nA : cA + (size_t)(t + 2) * kstep; const char* b2 = last ? nB : cB + (size_t)(t + 2) * kstep;
            const char* a3 = a2 + kstep; const char* b3 = b2 + kstep;
            unsigned o2[2][2];
#pragma unroll
            for (int h = 0; h < 2; ++h)
#pragma unroll
                for (int i = 0; i < 2; ++i) o2[h][i] = (GATHER && last) ? noffA[h][i] : offA[h][i];
            PG8_LDB(B0, 0, 0); PG8_LDB(B1, 0, 1); PG8_SCHED; PG8_LDA(At, 0, 0); PG8_STAGE(PG8_SA(1, 1), a1, offA[1]);
            PG8_WAIT_V(8); PG8_WAIT_L(0); PG8_BAR; PG8_MMA(0, 0, At, B0); PG8_MMA(0, 1, At, B1); PG8_BAR; PG8_SCHED;
            PG8_LDA(At, 0, 1); PG8_STAGE(PG8_SB(0, 0), b2, voffB); PG8_STAGE(PG8_SB(0, 1), b2 + hstep, voffB); PG8_STAGE(PG8_SA(0, 0), a2, o2[0]);
            PG8_WAIT_V(8); PG8_WAIT_L(0); PG8_BAR; PG8_MMA(1, 0, At, B0); PG8_MMA(1, 1, At, B1); PG8_BAR; PG8_SCHED;
            PG8_LDB(B0, 1, 0); PG8_LDB(B1, 1, 1); PG8_SCHED; PG8_LDA(At, 1, 0); PG8_STAGE(PG8_SA(0, 1), a2, o2[1]);
            PG8_WAIT_V(8); PG8_WAIT_L(0); PG8_BAR; PG8_MMA(0, 0, At, B0); PG8_MMA(0, 1, At, B1); PG8_BAR; PG8_SCHED;
            PG8_LDA(At, 1, 1); PG8_STAGE(PG8_SB(1, 0), b3, voffB); PG8_STAGE(PG8_SB(1, 1), b3 + hstep, voffB); PG8_STAGE(PG8_SA(1, 0), a3, o2[0]);
            PG8_WAIT_V(8); PG8_WAIT_L(0); PG8_BAR; PG8_MMA(1, 0, At, B0); PG8_MMA(1, 1, At, B1); PG8_BAR; PG8_SCHED;
        }
        if (wr == 0) PG8_BAR;
        E(acc, cur, wr, wc, fr, fq);
        if (!has_next) break;
#pragma unroll
        for (int a = 0; a < 2; ++a)
#pragma unroll
            for (int b = 0; b < 2; ++b)
#pragma unroll
                for (int m = 0; m < 4; ++m)
#pragma unroll
                    for (int n = 0; n < 2; ++n) acc[a][b][m][n] = (f32x4){0.f, 0.f, 0.f, 0.f};
        cur = nxt; cA = nA; cB = nB; ++ui;
#pragma unroll
        for (int h = 0; h < 2; ++h)
#pragma unroll
            for (int i = 0; i < 2; ++i) offA[h][i] = noffA[h][i];
        if (wr == 1) PG8_BAR;
    }
    PG8_WAIT_V(0);
    PG8_BAR;
#undef PG8_SA
#undef PG8_SB
#undef PG8_STAGE
#undef PG8_LDA
#undef PG8_LDB
#undef PG8_MMA
#undef PG8_WAIT_V
#undef PG8_WAIT_L
#undef PG8_BAR
#undef PG8_SCHED
}
}

#ifndef MK_N_LAUNCHES
#define MK_N_LAUNCHES 1
#endif
#define XB_TMO      128
#define XB_XCNT(j)  (256  + 64 * (j))
#define XB_XSUB(j)  (1280 + 64 * (j))
#define XB_XGEN(j)  (2304 + 64 * (j))
#define XB_TOP      3328
#define XB_TOPGEN   3392
#define XCD_BAR_WORDS 3456
#define XB_SPIN_CAP (1u << 22)

__device__ __forceinline__ unsigned xb_ld(unsigned* p)              { return __hip_atomic_load(p, __ATOMIC_RELAXED, __HIP_MEMORY_SCOPE_AGENT); }
__device__ __forceinline__ unsigned xb_add(unsigned* p, unsigned v) { return __hip_atomic_fetch_add(p, v, __ATOMIC_RELAXED, __HIP_MEMORY_SCOPE_AGENT); }
__device__ __forceinline__ unsigned xb_xcc_id() { return (unsigned)__builtin_amdgcn_s_getreg((3 << 11) | 20) & 0xFu; }
#define XB_SPIN(cond, bar) do { unsigned _sp = 0; while (cond) { __builtin_amdgcn_s_sleep(1); \
    if ((++_sp & 255u) == 0u) { if (xb_ld(&(bar)[XB_TMO])) break; if (_sp > XB_SPIN_CAP) { atomicAdd(&(bar)[XB_TMO], 1u); break; } } } } while (0)

struct XcdBarrier {
    unsigned* bar; unsigned x;
    volatile LAS unsigned* st;
};

__device__ __forceinline__ XcdBarrier xcd_barrier_post(unsigned* bar, volatile LAS unsigned* st) {
    XcdBarrier b; b.bar = bar; b.x = xb_xcc_id(); b.st = st;
    if (threadIdx.x == 0) (void)xb_add(&bar[XB_XCNT(b.x)], 1u);
    return b;
}
__device__ __forceinline__ void xcd_barrier_complete(unsigned* bar, unsigned x, unsigned& nloc, unsigned& nx) {
    const unsigned G = gridDim.x * gridDim.y * gridDim.z;
    unsigned sum, cnt, mine, sp = 0u;
    for (;;) {
        sum = 0u; cnt = 0u; mine = 0u;
#pragma unroll
        for (unsigned j = 0; j < 16; ++j) { const unsigned c = xb_ld(&bar[XB_XCNT(j)]); sum += c; cnt += (c > 0u) ? 1u : 0u; mine = (j == x) ? c : mine; }
        if (sum == G) break;
        __builtin_amdgcn_s_sleep(1);
        if ((++sp & 255u) == 0u) { if (xb_ld(&bar[XB_TMO])) break; if (sp > XB_SPIN_CAP) { atomicAdd(&bar[XB_TMO], 1u); break; } }
    }
    nloc = mine > 0u ? mine : 1u; nx = cnt > 0u ? cnt : 1u;
}

__device__ __forceinline__ void xcd_barrier(const XcdBarrier& b) {
    asm volatile("s_waitcnt vmcnt(0)" ::: "memory");
    __syncthreads();
    if (threadIdx.x == 0) {
        unsigned* bar = b.bar;
        __builtin_amdgcn_s_waitcnt(0);
        unsigned nloc = b.st[0], nx = b.st[1];
        if (nloc == 0u) { xcd_barrier_complete(bar, b.x, nloc, nx); b.st[0] = nloc; b.st[1] = nx; }
        const unsigned old = xb_add(&bar[XB_XSUB(b.x)], 1u);
        const unsigned gen = old / nloc;
        if (old + 1u == (gen + 1u) * nloc) {
            __builtin_amdgcn_fence(__ATOMIC_RELEASE, "agent");
            asm volatile("s_waitcnt vmcnt(0)" ::: "memory");
            const unsigned og = xb_add(&bar[XB_TOP], 1u);
            const unsigned tg = og / nx;
            if (og + 1u == (tg + 1u) * nx) xb_add(&bar[XB_TOPGEN], 1u);
            else XB_SPIN(xb_ld(&bar[XB_TOPGEN]) == tg, bar);
            __builtin_amdgcn_fence(__ATOMIC_ACQUIRE, "agent");
            xb_add(&bar[XB_XGEN(b.x)], 1u);
            asm volatile("s_waitcnt vmcnt(0)" ::: "memory");
        } else {
            XB_SPIN(xb_ld(&bar[XB_XGEN(b.x)]) == gen, bar);
            __builtin_amdgcn_fence(__ATOMIC_ACQUIRE, "agent");
            asm volatile("s_waitcnt vmcnt(0)" ::: "memory");
        }
    }
    __syncthreads();
}


struct Args { const float* in[25]; float* out; unsigned char* ws; int ph_lo, ph_hi, l_lo, l_hi; };
struct Frame {
    LAS unsigned char* lds;
    unsigned char* ws;
    int tid, lane, wave, G, bid;
};
enum { I_X = 0, I_C, I_ADAW, I_ADAB, I_NMIXW, I_NMOEW, I_WIN, I_CONVW, I_GATEB, I_MNORMW, I_ALPHAW, I_ALPHAB, I_GNORMW, I_WPA, I_WPB, I_WO, I_RW, I_RB, I_EW1, I_EW3, I_EW2, I_SW1, I_SW3, I_SW2, I_FNW };

__device__ __forceinline__ bf16_t* wsm(unsigned char* ws, int l, size_t off) { return (bf16_t*)(ws + WS_WSM + (size_t)l * WSM_STRIDE + off); }

__device__ __forceinline__ void tr_item(const float* W, int ldw, int c0, int k0, bf16_t* WT, int r0, int K, LAS float* scr, int lane) {
#pragma unroll 8
    for (int i = 0; i < 32; ++i) { const int kk = 2 * i + (lane >> 5); scr[kk * 33 + (lane & 31)] = W[(size_t)(k0 + kk) * ldw + c0 + (lane & 31)]; }
    LDS_WAIT(); asm volatile("" ::: "memory");
    const int c = lane & 7;
#pragma unroll
    for (int j = 0; j < 4; ++j) { const int n = (lane >> 3) + 8 * j; const LAS float* s = scr + (8 * c) * 33 + n;
        u32x4 o; o.x = pk2(s[0 * 33], s[1 * 33]); o.y = pk2(s[2 * 33], s[3 * 33]); o.z = pk2(s[4 * 33], s[5 * 33]); o.w = pk2(s[6 * 33], s[7 * 33]);
        *(u32x4*)(WT + (size_t)(r0 + n) * K + k0 + 8 * c) = o; }
    LDS_WAIT(); asm volatile("" ::: "memory");
}
constexpr int SW_ITEMS = 96 * 16 + 3 * 32 * 16 + 64 * 16 + 3 * 32 * 16 + 4 * 4 * 16 + 32 * 4 + 8 * 16 + 8 * 16;
__device__ __forceinline__ void small_item(const Args& a, unsigned char* ws, int l, int r, LAS float* scr, int lane) {
    const float* win = a.in[I_WIN] + (size_t)l * D * DIN;
    bf16_t* Win_t = wsm(ws, l, WO_IN);
    if (r < 96 * 16) { const int nb = r % 96, kb = r / 96; tr_item(win, DIN, nb * 32, kb * 64, Win_t, nb * 32, D, scr, lane); return; } r -= 96 * 16;
    if (r < 32 * 16) { const int nb = r % 32, kb = r / 32; tr_item(win, DIN, C_QG + nb * 32, kb * 64, Win_t, 3072 + nb * 32, D, scr, lane); return; } r -= 32 * 16;
    if (r < 32 * 16) { const int nb = r % 32, kb = r / 32; tr_item(win, DIN, C_VG + nb * 32, kb * 64, Win_t, 4096 + nb * 32, D, scr, lane); return; } r -= 32 * 16;
    if (r < 32 * 16) { const int nb = r % 32, kb = r / 32; tr_item(win, DIN, C_ZG + nb * 32, kb * 64, Win_t, 5120 + nb * 32, D, scr, lane); return; } r -= 32 * 16;
    if (r < 64 * 16) { const int nb = r % 64, kb = r / 64; tr_item(win, DIN, C_GA + nb * 32, kb * 64, wsm(ws, l, WO_GAB), nb * 32, D, scr, lane); return; } r -= 64 * 16;
    if (r < 32 * 16) { const int nb = r % 32, kb = r / 32; tr_item(a.in[I_WPA] + (size_t)l * D * D, D, nb * 32, kb * 64, wsm(ws, l, WO_PA), nb * 32, D, scr, lane); return; } r -= 32 * 16;
    if (r < 32 * 16) { const int nb = r % 32, kb = r / 32; tr_item(a.in[I_WPB] + (size_t)l * D * D, D, nb * 32, kb * 64, wsm(ws, l, WO_PB), nb * 32, D, scr, lane); return; } r -= 32 * 16;
    if (r < 32 * 16) { const int nb = r % 32, kb = r / 32; tr_item(a.in[I_WO] + (size_t)l * D * D, D, nb * 32, kb * 64, wsm(ws, l, WO_O), nb * 32, D, scr, lane); return; } r -= 32 * 16;
    if (r < 4 * 4 * 16) { const int seg = r / 64, it = r % 64, nb = it % 4, kb = it / 4;
        const float* src = ((seg & 1) ? a.in[I_SW3] : a.in[I_SW1]) + (size_t)l * D * DE;
        tr_item(src, DE, (seg >> 1) * 128 + nb * 32, kb * 64, wsm(ws, l, WO_S13), seg * 128 + nb * 32, D, scr, lane); return; } r -= 256;
    if (r < 32 * 4) { const int nb = r % 32, kb = r / 32; tr_item(a.in[I_SW2] + (size_t)l * DE * D, D, nb * 32, kb * 64, wsm(ws, l, WO_S2), nb * 32, DE, scr, lane); return; } r -= 128;
    if (r < 8 * 16) {
        const int nb = r % 8, kb = r / 8; bf16_t* Wr = wsm(ws, l, WO_R);
        if (nb < 2) tr_item(a.in[I_RW] + (size_t)l * D * NE, NE, nb * 32, kb * 64, Wr, nb * 32, D, scr, lane);
        else for (int j = 0; j < 32; ++j) Wr[(size_t)(nb * 32 + j) * D + kb * 64 + lane] = 0;
        return; } r -= 128;
    {
        const int rb = r % 8, kb = r / 8;
        for (int j = 0; j < 32; ++j) {
            const int row = rb * 32 + j; float v = 0.f;
            if (row < 24) { const int srcc = row < 4 ? C_IM + row : (row < 8 ? C_FM + row - 4 : C_RG + row - 8); v = win[(size_t)(kb * 64 + lane) * DIN + srcc]; }
            Win_t[(size_t)(6144 + row) * D + kb * 64 + lane] = (bf16_t)f2bf(v);
        }
    }
}
constexpr int EX_ITEMS = 64 * 384;
__device__ __forceinline__ void expert_item(const Args& a, unsigned char* ws, int l, int idx, LAS float* scr, int lane) {
    const int e = idx / 384; int r = idx % 384;
    if (r < 256) { const int seg = r / 64, it = r % 64, nb = it % 4, kb = it / 4;
        const float* src = ((seg & 1) ? a.in[I_EW3] : a.in[I_EW1]) + ((size_t)l * NE + e) * D * DE;
        tr_item(src, DE, (seg >> 1) * 128 + nb * 32, kb * 64, (bf16_t*)(ws + WS_WEXP13) + (size_t)e * 512 * D, seg * 128 + nb * 32, D, scr, lane); return; }
    r -= 256; { const int nb = r % 32, kb = r / 32;
        tr_item(a.in[I_EW2] + ((size_t)l * NE + e) * DE * D, D, nb * 32, kb * 64, (bf16_t*)(ws + WS_WEXP2) + (size_t)e * D * DE, nb * 32, DE, scr, lane); }
}
__device__ __forceinline__ void p0a(const Args& a, Frame& F, bool experts0) {
    const int gw = F.bid * NWAVES + F.wave, NGW = F.G * NWAVES;
    LAS float* cond = (LAS float*)F.lds;
    LAS float* scr = (LAS float*)(F.lds + F.wave * 8704);
    if (F.bid * NWAVES < 192) {
        const float* c = a.in[I_C];
        for (int i = F.tid; i < NB * D; i += NTHREADS) cond[i] = siluf_(c[i]);
        __syncthreads();
        if (gw < 192) {
            const int l = gw / 96, j = (gw % 96) * 64 + F.lane;
            const float* w = a.in[I_ADAW] + (size_t)l * D * 6 * D + j;
            float acc[NB];
#pragma unroll
            for (int b = 0; b < NB; ++b) acc[b] = 0.f;
            for (int k = 0; k < D; ++k) { const float wv = w[(size_t)k * 6 * D];
#pragma unroll
                for (int b = 0; b < NB; ++b) acc[b] += cond[b * D + k] * wv; }
            const float bb = a.in[I_ADAB][l * 6 * D + j];
            float* ada = (float*)(F.ws + WS_ADA);
#pragma unroll
            for (int b = 0; b < NB; ++b) ada[((size_t)l * NB + b) * 6 * D + j] = acc[b] + bb;
        }
        __syncthreads();
    }
    const int total = 2 * SW_ITEMS + (experts0 ? EX_ITEMS : 0);
    for (int it = gw; it < total; it += NGW) {
        if (it < 2 * SW_ITEMS) small_item(a, F.ws, it / SW_ITEMS, it % SW_ITEMS, scr, F.lane);
        else expert_item(a, F.ws, 0, it - 2 * SW_ITEMS, scr, F.lane);
    }
}
__device__ __forceinline__ void p_norm(Frame& F, const float* h, const float* w, const float* sh, const float* sc, bf16_t* U) {
    const int gw = F.bid * NWAVES + F.wave, NGW = F.G * NWAVES;
    f32x4 wv[4];
#pragma unroll
    for (int j = 0; j < 4; ++j) wv[j] = ((const f32x4*)w)[F.lane + 64 * j];
    for (int row = gw; row < T; row += NGW) {
        const int b = row / S;
        const f32x4* xr = (const f32x4*)(h + (size_t)row * D) + F.lane;
        f32x4 v[4]; float ss = 0.f;
#pragma unroll
        for (int j = 0; j < 4; ++j) { v[j] = xr[64 * j]; ss += (v[j].x * v[j].x + v[j].y * v[j].y) + (v[j].z * v[j].z + v[j].w * v[j].w); }
        const float r = rsqrtf(wave_sum(ss) * (1.f / D) + EPS);
        u32x2* o = (u32x2*)(U + (size_t)row * D) + F.lane;
#pragma unroll
        for (int j = 0; j < 4; ++j) {
            const f32x4 scv = ((const f32x4*)(sc + (size_t)b * 6 * D))[F.lane + 64 * j], shv = ((const f32x4*)(sh + (size_t)b * 6 * D))[F.lane + 64 * j];
            const f32x4 y = v[j] * r * wv[j] * (scv + 1.f) + shv;
            u32x2 pk; pk.x = pk2(y.x, y.y); pk.y = pk2(y.z, y.w); o[64 * j] = pk;
        }
    }
}
struct SchedDense {
    pg8::TileOrder O; const char* A; const char* B; size_t tstep;
    __device__ bool next(int i, pg8::Unit& u) const { u.e = 0; return O.tile(i, u.pm, u.pn); }
    __device__ const char* a_ptr(const pg8::Unit& u) const { return A + (size_t)u.pm * tstep; }
    __device__ const char* b_ptr(const pg8::Unit& u) const { return B + (size_t)u.pn * tstep; }
    __device__ const int* a_rows(const pg8::Unit&) const { return nullptr; }
};
struct EpiInProj {
    static constexpr bool PERM = true;
    bf16_t* PB; float* small;
    __device__ __forceinline__ void operator()(const f32x4 (&acc)[2][2][4][2], const pg8::Unit& u, int wr, int wc, int fr, int fq) const {
        const int row0 = u.pm * 256 + wr * 64 + fr;
        if (u.pn < 24) {
            bf16_t* base = PB + (size_t)(u.pn >> 2) * (PB_STRIDE / 2) + (u.pn & 3) * 256 + wc * 32 + 8 * fq;
#pragma unroll
            for (int ai = 0; ai < 2; ++ai)
#pragma unroll
                for (int m = 0; m < 4; ++m) { bf16_t* rowp = base + (size_t)(row0 + ai * 128 + m * 16) * D;
#pragma unroll
                    for (int bj = 0; bj < 2; ++bj) { const f32x4 v0 = acc[ai][bj][m][0], v1 = acc[ai][bj][m][1];
                        u32x4 w; w.x = cvt_pk_bf16(v0[0], v0[1]); w.y = cvt_pk_bf16(v0[2], v0[3]); w.z = cvt_pk_bf16(v1[0], v1[1]); w.w = cvt_pk_bf16(v1[2], v1[3]);
                        *(u32x4*)(rowp + bj * 128) = w; } }
        } else if (wc == 0) {
#pragma unroll
            for (int ai = 0; ai < 2; ++ai)
#pragma unroll
                for (int m = 0; m < 4; ++m) { float* rp = small + (size_t)(row0 + ai * 128 + m * 16) * 32 + 8 * fq;
                    *(f32x4*)rp = acc[ai][0][m][0]; *(f32x4*)(rp + 4) = acc[ai][0][m][1]; }
        }
    }
};
__device__ __forceinline__ void p_inproj(Frame& F, int l) {
    SchedDense Sd; Sd.O.init(T / 256, 25, F.G, F.bid); Sd.A = (const char*)(F.ws + WS_U); Sd.B = (const char*)wsm(F.ws, l, WO_IN); Sd.tstep = (size_t)256 * D * 2;
    EpiInProj E{(bf16_t*)(F.ws + WS_PB), (float*)(F.ws + WS_SMALL)};
    pg8::gemm_phase<EpiInProj, SchedDense, false>(F.lds, D, Sd, E);
}


struct EpiSig { static constexpr bool PERM = true;
    bf16_t* PB;
    __device__ __forceinline__ void operator()(const f32x4 (&acc)[2][2][4][2], const pg8::Unit& u, int wr, int wc, int fr, int fq) const {
        const int row0 = u.pm * 256 + wr * 64 + fr;
        bf16_t* base = PB + (size_t)(u.pn >> 2) * (PB_STRIDE / 2) + (u.pn & 3) * 256 + wc * 32 + 8 * fq;
#pragma unroll
        for (int ai = 0; ai < 2; ++ai)
#pragma unroll
            for (int m = 0; m < 4; ++m) { bf16_t* rowp = base + (size_t)(row0 + ai * 128 + m * 16) * D;
#pragma unroll
                for (int bj = 0; bj < 2; ++bj) { const f32x4 v0 = acc[ai][bj][m][0], v1 = acc[ai][bj][m][1];
                    u32x4 w; w.x = cvt_pk_bf16(sigmoidf_(v0[0]), sigmoidf_(v0[1])); w.y = cvt_pk_bf16(sigmoidf_(v0[2]), sigmoidf_(v0[3]));
                    w.z = cvt_pk_bf16(sigmoidf_(v1[0]), sigmoidf_(v1[1])); w.w = cvt_pk_bf16(sigmoidf_(v1[2]), sigmoidf_(v1[3]));
                    *(u32x4*)(rowp + bj * 128) = w; } }
    }
};
__device__ __forceinline__ void p_gates(Frame& F, int l) {
    SchedDense Sd; Sd.O.init(T / 256, 8, F.G, F.bid); Sd.A = (const char*)(F.ws + WS_U); Sd.B = (const char*)wsm(F.ws, l, WO_GAB); Sd.tstep = (size_t)256 * D * 2;
    EpiSig E{(bf16_t*)(F.ws + WS_PB)};
    pg8::gemm_phase<EpiSig, SchedDense, false>(F.lds, D, Sd, E);
}
struct SchedY {
    pg8::TileOrder O; const char* A0; const char* A1; const char* B0; const char* B1; size_t tstep;
    __device__ bool next(int i, pg8::Unit& u) const { u.e = i & 1; return O.tile(i >> 1, u.pm, u.pn); }
    __device__ const char* a_ptr(const pg8::Unit& u) const { return (u.e ? A1 : A0) + (size_t)u.pm * tstep; }
    __device__ const char* b_ptr(const pg8::Unit& u) const { return (u.e ? B1 : B0) + (size_t)u.pn * tstep; }
    __device__ const int* a_rows(const pg8::Unit&) const { return nullptr; }
};
struct EpiY { static constexpr bool PERM = true;
    const bf16_t* SA; const bf16_t* SB; bf16_t* Y;
    __device__ __forceinline__ void operator()(const f32x4 (&acc)[2][2][4][2], const pg8::Unit& u, int wr, int wc, int fr, int fq) const {
        const int row0 = u.pm * 256 + wr * 64 + fr; const size_t colb = (size_t)u.pn * 256 + wc * 32 + 8 * fq;
        const bf16_t* G = u.e ? SB : SA;
#pragma unroll
        for (int ai = 0; ai < 2; ++ai)
#pragma unroll
            for (int m = 0; m < 4; ++m) { const size_t ro = (size_t)(row0 + ai * 128 + m * 16) * D + colb;
#pragma unroll
                for (int bj = 0; bj < 2; ++bj) { const f32x4 v0 = acc[ai][bj][m][0], v1 = acc[ai][bj][m][1];
                    const u32x4 g = *(const u32x4*)(G + ro + bj * 128);
                    float r0 = bflo(g.x) * v0[0], r1 = bfhi(g.x) * v0[1], r2 = bflo(g.y) * v0[2], r3 = bfhi(g.y) * v0[3], r4 = bflo(g.z) * v1[0], r5 = bfhi(g.z) * v1[1], r6 = bflo(g.w) * v1[2], r7 = bfhi(g.w) * v1[3];
                    if (u.e) { const u32x4 y = *(const u32x4*)(Y + ro + bj * 128);
                        r0 += bflo(y.x); r1 += bfhi(y.x); r2 += bflo(y.y); r3 += bfhi(y.y); r4 += bflo(y.z); r5 += bfhi(y.z); r6 += bflo(y.w); r7 += bfhi(y.w); }
                    u32x4 w; w.x = cvt_pk_bf16(r0, r1); w.y = cvt_pk_bf16(r2, r3); w.z = cvt_pk_bf16(r4, r5); w.w = cvt_pk_bf16(r6, r7);
                    *(u32x4*)(Y + ro + bj * 128) = w; } }
    }
};
__device__ __forceinline__ void p_y(Frame& F, int l) {
    SchedY Sy; Sy.O.init(T / 256, 4, F.G, F.bid); Sy.A0 = (const char*)(F.ws + WS_PB + 2 * PB_STRIDE); Sy.A1 = (const char*)(F.ws + WS_PB + 5 * PB_STRIDE);
    Sy.B0 = (const char*)wsm(F.ws, l, WO_PA); Sy.B1 = (const char*)wsm(F.ws, l, WO_PB); Sy.tstep = (size_t)256 * D * 2;
    EpiY E{(const bf16_t*)(F.ws + WS_PB), (const bf16_t*)(F.ws + WS_PB + PB_STRIDE), (bf16_t*)(F.ws + WS_PB + 3 * PB_STRIDE)};
    pg8::gemm_phase<EpiY, SchedY, false>(F.lds, D, Sy, E);
}
struct EpiResid { static constexpr bool PERM = false;
    const float* hin; float* hout; const float* gate;
    __device__ __forceinline__ void operator()(const f32x4 (&acc)[2][2][4][2], const pg8::Unit& u, int wr, int wc, int fr, int fq) const {
        const int row0 = u.pm * 256 + wr * 64 + fr, col0 = u.pn * 256 + wc * 32 + 4 * fq;
        const int b = (u.pm * 256) / S;
        f32x4 gv[2][2];
#pragma unroll
        for (int bj = 0; bj < 2; ++bj)
#pragma unroll
            for (int n = 0; n < 2; ++n) gv[bj][n] = *(const f32x4*)(gate + (size_t)b * 6 * D + col0 + bj * 128 + n * 16);
#pragma unroll
        for (int ai = 0; ai < 2; ++ai)
#pragma unroll
            for (int m = 0; m < 4; ++m) { const size_t ro = (size_t)(row0 + ai * 128 + m * 16) * D + col0;
#pragma unroll
                for (int bj = 0; bj < 2; ++bj)
#pragma unroll
                    for (int n = 0; n < 2; ++n) { const f32x4 hv = *(const f32x4*)(hin + ro + bj * 128 + n * 16);
                        *(f32x4*)(hout + ro + bj * 128 + n * 16) = hv + gv[bj][n] * acc[ai][bj][m][n]; } }
    }
};
__device__ __forceinline__ void p_wo(const Args& a, Frame& F, int l) {
    SchedDense Sd; Sd.O.init(T / 256, 4, F.G, F.bid); Sd.A = (const char*)(F.ws + WS_PB + 3 * PB_STRIDE); Sd.B = (const char*)wsm(F.ws, l, WO_O); Sd.tstep = (size_t)256 * D * 2;
    EpiResid E{l == 0 ? a.in[I_X] : a.out, a.out, (const float*)(F.ws + WS_ADA) + (size_t)l * NB * 6 * D + 2 * D};
    pg8::gemm_phase<EpiResid, SchedDense, false>(F.lds, D, Sd, E);
}


constexpr size_t WS_IDENT = 165 * MiB;
constexpr size_t WS_Y2H = 166 * MiB;
constexpr int VTILES = NBLK + T / 256, VROWS = VTILES * 256;
constexpr size_t WS_HB = WS_Y2H + (size_t)VROWS * 512 * 2;
constexpr size_t WS_MOE_END = WS_HB + (size_t)VROWS * 256 * 2;
static_assert(WS_MOE_END <= 622 * MiB, "moe overlay");

__device__ __forceinline__ void p_norm2(const Args& a, Frame& F, int l) {
    const float* ada = (const float*)(F.ws + WS_ADA) + (size_t)l * NB * 6 * D;
    int* ident = (int*)(F.ws + WS_IDENT); int* row_tok = (int*)(F.ws + WS_ROWTOK);
    for (int i = F.bid * NTHREADS + F.tid; i < NROWS; i += F.G * NTHREADS) { row_tok[i] = 0; if (i < T) ident[i] = i; }
    p_norm(F, a.out, a.in[I_NMOEW] + l * D, ada + 3 * D, ada + 4 * D, (bf16_t*)(F.ws + WS_U));
}
struct EpiLogits { static constexpr bool PERM = false; float* L;
    __device__ __forceinline__ void operator()(const f32x4 (&acc)[2][2][4][2], const pg8::Unit& u, int wr, int wc, int fr, int fq) const {
        if (wc >= 2) return;
        const int row0 = u.pm * 256 + wr * 64 + fr, col0 = wc * 32 + 4 * fq;
#pragma unroll
        for (int ai = 0; ai < 2; ++ai)
#pragma unroll
            for (int m = 0; m < 4; ++m) { float* rp = L + (size_t)(row0 + ai * 128 + m * 16) * NE + col0;
#pragma unroll
                for (int n = 0; n < 2; ++n) *(f32x4*)(rp + n * 16) = acc[ai][0][m][n]; }
    }
};
__device__ __forceinline__ void p_router(Frame& F, int l) {
    SchedDense Sd; Sd.O.init(T / 256, 1, F.G, F.bid); Sd.A = (const char*)(F.ws + WS_U); Sd.B = (const char*)wsm(F.ws, l, WO_R); Sd.tstep = (size_t)256 * D * 2;
    EpiLogits E{(float*)(F.ws + WS_LOGITS)};
    pg8::gemm_phase<EpiLogits, SchedDense, false>(F.lds, D, Sd, E);
}
__device__ __forceinline__ void p_topk(const Args& a, Frame& F, int l) {
    LAS int* lcnt = (LAS int*)(F.lds); LAS int* lbase = lcnt + 64;
    const float* logits = (const float*)(F.ws + WS_LOGITS); const float* router_b = a.in[I_RB] + l * NE;
    int* eidx = (int*)(F.ws + WS_EIDX); float* wts = (float*)(F.ws + WS_WTS); int* pos = (int*)(F.ws + WS_POS);
    int* gcnt = (int*)(F.ws + WS_CTL) + CW_CNT + l * 64;
    for (int blk = F.bid; blk < T / 128; blk += F.G) {
        __syncthreads();
        if (F.tid < 64) lcnt[F.tid] = 0;
        __syncthreads();
        const int t = blk * 128 + F.tid;
        int ei[TOPK]; float wv[TOPK]; int lp[TOPK]; float wsum = 0.f;
        if (F.tid < 128) {
            float sc[NE], sel[NE];
#pragma unroll
            for (int e = 0; e < NE; ++e) { sc[e] = sigmoidf_(logits[(size_t)t * NE + e]); sel[e] = sc[e] + router_b[e]; }
            float gs[8];
#pragma unroll
            for (int g = 0; g < 8; ++g) { float m1 = -INFINITY, m2 = -INFINITY;
#pragma unroll
                for (int j = 0; j < 8; ++j) { const float v = sel[g * 8 + j]; if (v > m1) { m2 = m1; m1 = v; } else if (v > m2) m2 = v; }
                gs[g] = m1 + m2; }
            unsigned gmask = 0;
#pragma unroll
            for (int k = 0; k < 4; ++k) { int best = -1; float bv = -INFINITY;
#pragma unroll
                for (int g = 0; g < 8; ++g) if (!((gmask >> g) & 1u) && (best < 0 || gs[g] > bv)) { best = g; bv = gs[g]; }
                gmask |= 1u << best; }
            unsigned long long taken = 0ull;
#pragma unroll
            for (int k = 0; k < TOPK; ++k) { int best = -1; float bv = -INFINITY;
#pragma unroll
                for (int e = 0; e < NE; ++e) { const bool ok = ((gmask >> (e >> 3)) & 1u) && !((taken >> e) & 1ull); if (ok && (best < 0 || sel[e] > bv)) { best = e; bv = sel[e]; } }
                taken |= 1ull << best; ei[k] = best; float s = 0.f;
#pragma unroll
                for (int e = 0; e < NE; ++e) s = (e == best) ? sc[e] : s;
                wv[k] = s; wsum += s; }
#pragma unroll
            for (int k = 0; k < TOPK; ++k) lp[k] = __hip_atomic_fetch_add(&lcnt[ei[k]], 1, __ATOMIC_RELAXED, __HIP_MEMORY_SCOPE_WORKGROUP);
        }
        __syncthreads();
        if (F.tid < 64) lbase[F.tid] = atomicAdd(&gcnt[F.tid], lcnt[F.tid]);
        __syncthreads();
        if (F.tid < 128) {
#pragma unroll
            for (int k = 0; k < TOPK; ++k) { eidx[t * TOPK + k] = ei[k]; wts[t * TOPK + k] = wv[k] / wsum * 2.5f; pos[t * TOPK + k] = lbase[ei[k]] + lp[k]; }
        }
    }
}
__device__ __forceinline__ int load_pend(Frame& F, int l, LAS int* pend) {
    const int* gcnt = (const int*)(F.ws + WS_CTL) + CW_CNT + l * 64;
    __syncthreads();
    if (F.tid == 0) { int acc = 0;
#pragma unroll 1
        for (int e = 0; e < NE; ++e) { acc += (gcnt[e] + 255) / 256 * 256; pend[e] = acc; } }
    __syncthreads();
    return pend[NE - 1] / 256;
}
__device__ __forceinline__ void p_fill(Frame& F, int l) {
    LAS int* pend = (LAS int*)(F.lds + MISC_OFF + 1024);
    load_pend(F, l, pend);
    const int* eidx = (const int*)(F.ws + WS_EIDX); int* pos = (int*)(F.ws + WS_POS); int* row_tok = (int*)(F.ws + WS_ROWTOK);
    for (int i = F.bid * NTHREADS + F.tid; i < NASSIGN; i += F.G * NTHREADS) {
        const int e = eidx[i]; const int dest = (e ? pend[e - 1] : 0) + pos[i];
        row_tok[dest] = i / TOPK; pos[i] = dest;
    }
}
struct SchedMoe1 {
    int G, c, ntiles; const LAS int* pend; const char* Ubase; const char* W13; const char* Ws13; const int* row_tok; const int* ident;
    __device__ bool next(int i, pg8::Unit& u) const {
        const int q = i * G + c; if (q >= 2 * (ntiles + T / 256)) return false;
        const int j = q >> 1; u.pn = q & 1;
        if (j < ntiles) { u.pm = j; int e = 0; while (e < NE - 1 && pend[e] <= j * 256) ++e; u.e = e; } else { u.pm = NBLK + (j - ntiles); u.e = NE; }
        return true; }
    __device__ const char* a_ptr(const pg8::Unit&) const { return Ubase; }
    __device__ const char* b_ptr(const pg8::Unit& u) const { return (u.e < NE ? W13 + (size_t)u.e * 512 * D * 2 : Ws13) + (size_t)u.pn * 256 * D * 2; }
    __device__ const int* a_rows(const pg8::Unit& u) const { return u.e < NE ? row_tok + (size_t)u.pm * 256 : ident + (size_t)(u.pm - NBLK) * 256; }
};
struct EpiHb { static constexpr bool PERM = true; bf16_t* HB;
    __device__ __forceinline__ void operator()(const f32x4 (&acc)[2][2][4][2], const pg8::Unit& u, int wr, int wc, int fr, int fq) const {
        const int row0 = u.pm * 256 + wr * 64 + fr; bf16_t* base = HB + u.pn * 128 + wc * 32 + 8 * fq;
#pragma unroll
        for (int ai = 0; ai < 2; ++ai)
#pragma unroll
            for (int m = 0; m < 4; ++m) { const f32x4 a0 = acc[ai][0][m][0], a1 = acc[ai][0][m][1], b0 = acc[ai][1][m][0], b1 = acc[ai][1][m][1];
                u32x4 w; w.x = cvt_pk_bf16(siluf_(a0[0]) * b0[0], siluf_(a0[1]) * b0[1]); w.y = cvt_pk_bf16(siluf_(a0[2]) * b0[2], siluf_(a0[3]) * b0[3]);
                w.z = cvt_pk_bf16(siluf_(a1[0]) * b1[0], siluf_(a1[1]) * b1[1]); w.w = cvt_pk_bf16(siluf_(a1[2]) * b1[2], siluf_(a1[3]) * b1[3]);
                *(u32x4*)(base + (size_t)(row0 + ai * 128 + m * 16) * DE) = w; }
    }
};
__device__ __forceinline__ int vcu_of(const Frame& F) { return (F.G % 8 == 0) ? (F.bid % 8) * (F.G / 8) + F.bid / 8 : F.bid; }
__device__ __forceinline__ void p_gemm1(Frame& F, int l) {
    LAS int* pend = (LAS int*)(F.lds + MISC_OFF + 1024);
    const int ntiles = load_pend(F, l, pend);
    SchedMoe1 Sm{F.G, vcu_of(F), ntiles, pend, (const char*)(F.ws + WS_U), (const char*)(F.ws + WS_WEXP13), (const char*)wsm(F.ws, l, WO_S13), (const int*)(F.ws + WS_ROWTOK), (const int*)(F.ws + WS_IDENT)};
    EpiHb E{(bf16_t*)(F.ws + WS_HB)};
    pg8::gemm_phase<EpiHb, SchedMoe1, true>(F.lds, D, Sm, E);
}
struct SchedMoe2 {
    int G, c, ntiles, hh; const LAS int* pend; const char* HB; const char* W2; const char* Ws2;
    __device__ bool next(int i, pg8::Unit& u) const {
        const int q = i * G + c; if (q >= 2 * (ntiles + T / 256)) return false;
        const int j = q >> 1; u.pn = q & 1;
        if (j < ntiles) { u.pm = j; int e = 0; while (e < NE - 1 && pend[e] <= j * 256) ++e; u.e = e; } else { u.pm = NBLK + (j - ntiles); u.e = NE; }
        return true; }
    __device__ const char* a_ptr(const pg8::Unit& u) const { return HB + (size_t)u.pm * 256 * DE * 2; }
    __device__ const char* b_ptr(const pg8::Unit& u) const { return (u.e < NE ? W2 + (size_t)u.e * D * DE * 2 : Ws2) + (size_t)(512 * hh + 256 * u.pn) * DE * 2; }
    __device__ const int* a_rows(const pg8::Unit&) const { return nullptr; }
};
struct EpiY2 { static constexpr bool PERM = true; bf16_t* Y;
    __device__ __forceinline__ void operator()(const f32x4 (&acc)[2][2][4][2], const pg8::Unit& u, int wr, int wc, int fr, int fq) const {
        const int row0 = u.pm * 256 + wr * 64 + fr; bf16_t* base = Y + u.pn * 256 + wc * 32 + 8 * fq;
#pragma unroll
        for (int ai = 0; ai < 2; ++ai)
#pragma unroll
            for (int m = 0; m < 4; ++m) { bf16_t* rowp = base + (size_t)(row0 + ai * 128 + m * 16) * 512;
#pragma unroll
                for (int bj = 0; bj < 2; ++bj) { const f32x4 v0 = acc[ai][bj][m][0], v1 = acc[ai][bj][m][1];
                    u32x4 w; w.x = cvt_pk_bf16(v0[0], v0[1]); w.y = cvt_pk_bf16(v0[2], v0[3]); w.z = cvt_pk_bf16(v1[0], v1[1]); w.w = cvt_pk_bf16(v1[2], v1[3]);
                    *(u32x4*)(rowp + bj * 128) = w; } }
    }
};
__device__ __forceinline__ void p_gemm2(Frame& F, int l, int hh) {
    LAS int* pend = (LAS int*)(F.lds + MISC_OFF + 1024);
    const int ntiles = load_pend(F, l, pend);
    SchedMoe2 Sm{F.G, vcu_of(F), ntiles, hh, pend, (const char*)(F.ws + WS_HB), (const char*)(F.ws + WS_WEXP2), (const char*)wsm(F.ws, l, WO_S2)};
    EpiY2 E{(bf16_t*)(F.ws + WS_Y2H)};
    pg8::gemm_phase<EpiY2, SchedMoe2, false>(F.lds, DE, Sm, E);
}
__device__ __forceinline__ void p_combine(const Args& a, Frame& F, int l, int hh) {
    const int gw = F.bid * NWAVES + F.wave, NGW = F.G * NWAVES;
    const bf16_t* Y = (const bf16_t*)(F.ws + WS_Y2H); const int* slots = (const int*)(F.ws + WS_POS); const float* wts = (const float*)(F.ws + WS_WTS);
    const float* gt = (const float*)(F.ws + WS_ADA) + (size_t)l * NB * 6 * D + 5 * D + 512 * hh + F.lane * 8;
    for (int t = gw; t < T; t += NGW) {
        const int b = t / S;
        float acc[8];
        { const u32x4 v = *(const u32x4*)(Y + ((size_t)NBLK * 256 + t) * 512 + F.lane * 8);
          acc[0] = bflo(v.x); acc[1] = bfhi(v.x); acc[2] = bflo(v.y); acc[3] = bfhi(v.y); acc[4] = bflo(v.z); acc[5] = bfhi(v.z); acc[6] = bflo(v.w); acc[7] = bfhi(v.w); }
#pragma unroll
        for (int k = 0; k < TOPK; ++k) { const int slot = slots[t * TOPK + k]; const float w = wts[t * TOPK + k];
            const u32x4 v = *(const u32x4*)(Y + (size_t)slot * 512 + F.lane * 8);
            acc[0] += w * bflo(v.x); acc[1] += w * bfhi(v.x); acc[2] += w * bflo(v.y); acc[3] += w * bfhi(v.y); acc[4] += w * bflo(v.z); acc[5] += w * bfhi(v.z); acc[6] += w * bflo(v.w); acc[7] += w * bfhi(v.w); }
        float* o = a.out + (size_t)t * D + 512 * hh + F.lane * 8;
        const f32x4 g0 = *(const f32x4*)(gt + (size_t)b * 6 * D), g1 = *(const f32x4*)(gt + (size_t)b * 6 * D + 4);
        f32x4 o0 = *(const f32x4*)o, o1 = *(const f32x4*)(o + 4);
        o0 += g0 * (f32x4){acc[0], acc[1], acc[2], acc[3]}; o1 += g1 * (f32x4){acc[4], acc[5], acc[6], acc[7]};
        *(f32x4*)o = o0; *(f32x4*)(o + 4) = o1;
    }
}
__device__ __forceinline__ void p_expert_cvt(const Args& a, Frame& F, int l) {
    const int gw = F.bid * NWAVES + F.wave, NGW = F.G * NWAVES;
    LAS float* scr = (LAS float*)(F.lds + F.wave * 8704);
    for (int it = gw; it < EX_ITEMS; it += NGW) expert_item(a, F.ws, l, it, scr, F.lane);
}
__device__ __forceinline__ void p_final(const Args& a, Frame& F) {
    const int gw = F.bid * NWAVES + F.wave, NGW = F.G * NWAVES;
    f32x4 wv[4];
#pragma unroll
    for (int j = 0; j < 4; ++j) wv[j] = ((const f32x4*)a.in[I_FNW])[F.lane + 64 * j];
    for (int row = gw; row < T; row += NGW) {
        f32x4* xr = (f32x4*)(a.out + (size_t)row * D) + F.lane;
        f32x4 v[4]; float ss = 0.f;
#pragma unroll
        for (int j = 0; j < 4; ++j) { v[j] = xr[64 * j]; ss += (v[j].x * v[j].x + v[j].y * v[j].y) + (v[j].z * v[j].z + v[j].w * v[j].w); }
        const float r = rsqrtf(wave_sum(ss) * (1.f / D) + EPS);
#pragma unroll
        for (int j = 0; j < 4; ++j) xr[64 * j] = v[j] * r * wv[j];
    }
}

__device__ __forceinline__ void mlstm_seq(const Args& a, Frame& F, int l, int b, int hd) {
    LAS float* qs = (LAS float*)F.lds; LAS float* ks = qs + 128; LAS float* ns = ks + 128; LAS float* sc = ns + 128; LAS float* pn = sc + 8; LAS float* pd = pn + 512; LAS float* red = pd + 512;
    const int tid = F.tid, e = tid & 255, dh = tid >> 8;
    const bf16_t* QK = (const bf16_t*)(F.ws + WS_PB) + (size_t)b * S * D; const bf16_t* VM = (const bf16_t*)(F.ws + WS_PB + PB_STRIDE) + (size_t)b * S * D;
    bf16_t* OM = (bf16_t*)(F.ws + WS_PB + 2 * PB_STRIDE) + (size_t)b * S * D; const float* SM = (const float*)(F.ws + WS_SMALL) + (size_t)b * S * 32;
    const float* conv_w = a.in[I_CONVW] + (size_t)l * 4 * 1024; const float* gate_b = a.in[I_GATEB] + l * 8;
    float Cst[64];
#pragma unroll
    for (int d = 0; d < 64; ++d) Cst[d] = 0.f;
    if (tid < 128) ns[tid] = 0.f;
    float m_run = 0.f;
    const int col = (tid < 128) ? (512 + hd * 128 + tid) : (hd * 128 + ((tid - 128) & 127));
    const float w0 = conv_w[0 * 1024 + col], w1 = conv_w[1 * 1024 + col], w2 = conv_w[2 * 1024 + col], w3 = conv_w[3 * 1024 + col];
    const float gbi = gate_b[hd], gbf = gate_b[4 + hd], mnw = a.in[I_MNORMW][l * D + hd * 256 + e];
    float x0 = 0.f, x1 = 0.f, x2 = 0.f;
    for (int t = 0; t < S; ++t) {
        float cv = 0.f;
        if (tid < 256) { const float x3 = bf2f(QK[(size_t)t * D + col]); cv = siluf_(w0 * x0 + w1 * x1 + w2 * x2 + w3 * x3); x0 = x1; x1 = x2; x2 = x3; }
        __syncthreads();
        if (tid < 128) ks[tid] = cv; else if (tid < 256) qs[tid - 128] = cv * 0.08838834764831845f;
        if (tid == 256) {
            const float li = 15.f * tanhf((SM[t * 32 + hd] + gbi) * (1.f / 15.f));
            const float lf = logsigmoidf_(15.f * tanhf((SM[t * 32 + 4 + hd] + gbf) * (1.f / 15.f)));
            const float m_new = fmaxf(lf + m_run, li);
            sc[0] = __expf(lf + m_run - m_new); sc[1] = __expf(li - m_new); sc[2] = __expf(-m_new); m_run = m_new;
        }
        __syncthreads();
        const float fd = sc[0], id = sc[1], lowb = sc[2];
        if (tid < 128) ns[tid] = fd * ns[tid] + id * ks[tid];
        __syncthreads();
        const float v = bf2f(VM[(size_t)t * D + hd * 256 + e]) * id;
        float num = 0.f, den = 0.f;
#pragma unroll
        for (int d = 0; d < 64; ++d) { const int dd = dh * 64 + d; Cst[d] = fd * Cst[d] + ks[dd] * v; num += qs[dd] * Cst[d]; den += qs[dd] * ns[dd]; }
        pn[dh * 256 + e] = num; pd[dh * 256 + e] = den;
        __syncthreads();
        float h = 0.f;
        if (dh == 0) { num = pn[e] + pn[256 + e]; den = pd[e] + pd[256 + e]; h = num / fmaxf(fabsf(den), lowb); const float ss = wave_sum(h * h); if (F.lane == 0) red[F.wave] = ss; }
        __syncthreads();
        if (dh == 0) { const float r = rsqrtf((red[0] + red[1] + red[2] + red[3]) * (1.f / 256.f) + EPS); const size_t idx = (size_t)t * D + hd * 256 + e;
            OM[idx] = (bf16_t)f2bf(h * r * mnw * sigmoidf_(bf2f(OM[idx]))); }
    }
}
__device__ __forceinline__ void gla_seq(const Args& a, Frame& F, int l, int b, int hd) {
    LAS float* qs = (LAS float*)F.lds; LAS float* ks = qs + 128; LAS float* as = ks + 128; LAS float* pn = as + 128 + 8; LAS float* red = pn + 512;
    const int tid = F.tid, e = tid & 255, dh = tid >> 8;
    const bf16_t* QKG = (const bf16_t*)(F.ws + WS_PB + 3 * PB_STRIDE) + (size_t)b * S * D; const bf16_t* VG = (const bf16_t*)(F.ws + WS_PB + 4 * PB_STRIDE) + (size_t)b * S * D;
    bf16_t* ZG = (bf16_t*)(F.ws + WS_PB + 5 * PB_STRIDE) + (size_t)b * S * D; const float* SM = (const float*)(F.ws + WS_SMALL) + (size_t)b * S * 32;
    const float* alpha_w = a.in[I_ALPHAW] + (size_t)l * 16 * 512; const float* alpha_b = a.in[I_ALPHAB] + l * 512;
    float Sst[64];
#pragma unroll
    for (int d = 0; d < 64; ++d) Sst[d] = 0.f;
    float aw[16]; float ab = 0.f;
#pragma unroll
    for (int r = 0; r < 16; ++r) aw[r] = alpha_w[r * 512 + hd * 128 + (tid & 127)];
    ab = alpha_b[hd * 128 + (tid & 127)];
    const float gnw = a.in[I_GNORMW][l * D + hd * 256 + e];
    for (int t = 0; t < S; ++t) {
        __syncthreads();
        if (tid < 128) {
            float x = ab;
#pragma unroll
            for (int r = 0; r < 16; ++r) x += SM[t * 32 + 8 + r] * aw[r];
            as[tid] = __expf(logsigmoidf_(x) * (1.f / 16.f));
            ks[tid] = bf2f(QKG[(size_t)t * D + 512 + hd * 128 + tid]);
        } else if (tid < 256) qs[tid - 128] = bf2f(QKG[(size_t)t * D + hd * 128 + tid - 128]) * 0.08838834764831845f;
        __syncthreads();
        const float v = bf2f(VG[(size_t)t * D + hd * 256 + e]);
        float o = 0.f;
#pragma unroll
        for (int d = 0; d < 64; ++d) { const int dd = dh * 64 + d; Sst[d] = as[dd] * Sst[d] + ks[dd] * v; o += qs[dd] * Sst[d]; }
        pn[dh * 256 + e] = o;
        __syncthreads();
        float h = 0.f;
        if (dh == 0) { h = pn[e] + pn[256 + e]; const float ss = wave_sum(h * h); if (F.lane == 0) red[F.wave] = ss; }
        __syncthreads();
        if (dh == 0) { const float r = rsqrtf((red[0] + red[1] + red[2] + red[3]) * (1.f / 256.f) + EPS); const size_t idx = (size_t)t * D + hd * 256 + e;
            ZG[idx] = (bf16_t)f2bf(h * r * gnw * siluf_(bf2f(ZG[idx]))); }
    }
}
__device__ __forceinline__ void p_mixers_seq(const Args& a, Frame& F, int l) {
    for (int s = F.bid; s < 128; s += F.G) {
        __syncthreads();
        if (s < 64) mlstm_seq(a, F, l, s >> 2, s & 3); else gla_seq(a, F, l, (s - 64) >> 2, s & 3);
    }
}
__global__ void __launch_bounds__(NTHREADS, 2) mega(Args a) {
    extern __shared__ __attribute__((aligned(16))) unsigned char lds_raw[];
    Frame F; F.lds = (LAS unsigned char*)lds_raw; F.ws = a.ws; F.tid = threadIdx.x; F.lane = F.tid & 63; F.wave = __builtin_amdgcn_readfirstlane(F.tid >> 6); F.G = gridDim.x; F.bid = blockIdx.x;
    volatile LAS unsigned* xbw = (volatile LAS unsigned*)(F.lds + MISC_OFF);
    if (F.tid < 4) xbw[F.tid] = 0u;
    __syncthreads();
    XcdBarrier bar; bar.bar = (unsigned*)(F.ws + WS_CTL) + CW_BAR; bar.x = 0; bar.st = xbw;
#if MK_N_LAUNCHES == 1
    bar = xcd_barrier_post((unsigned*)(F.ws + WS_CTL) + CW_BAR, xbw);
#define IN(k) true
#define SEAM() do { XcdBarrier b2_ = bar; unsigned long long zb_ = 0; asm volatile("" : "+s"(zb_)); b2_.bar = bar.bar + zb_; b2_.x = bar.x + (unsigned)zb_; b2_.st = bar.st + (unsigned)zb_; xcd_barrier(b2_); } while (0)
#else
    const int lo = a.ph_lo, hi = a.ph_hi;
#define IN(k) (lo <= (k) && (k) < hi)
#define SEAM() do { } while (0)
#endif
#define PH_BEGIN() do { int t_ = threadIdx.x; asm volatile("" : "+v"(t_)); F.tid = t_; F.lane = t_ & 63; F.wave = __builtin_amdgcn_readfirstlane(t_ >> 6); \
        unsigned long long z_ = 0; asm volatile("" : "+s"(z_)); F.ws = a.ws + z_; F.G = (int)gridDim.x + (int)z_; F.bid = (int)blockIdx.x + (int)z_; F.lds = (LAS unsigned char*)lds_raw + (unsigned)z_; } while (0)
    if (IN(0)) { PH_BEGIN(); p0a(a, F, true); SEAM(); }
#define LAYER_BODY(l) \
        if (IN(1)) { PH_BEGIN(); \
            const float* ada = (const float*)(F.ws + WS_ADA) + (size_t)l * NB * 6 * D; \
            p_norm(F, l == 0 ? a.in[I_X] : a.out, a.in[I_NMIXW] + l * D, ada + 0 * D, ada + 1 * D, (bf16_t*)(F.ws + WS_U)); \
            SEAM(); \
        } \
        if (IN(2)) { PH_BEGIN(); p_inproj(F, l); SEAM(); } \
        if (IN(3)) { PH_BEGIN(); p_mixers_seq(a, F, l); SEAM(); } \
        if (IN(4)) { PH_BEGIN(); p_gates(F, l); SEAM(); } \
        if (IN(5)) { PH_BEGIN(); p_y(F, l); SEAM(); } \
        if (IN(6)) { PH_BEGIN(); p_wo(a, F, l); SEAM(); } \
        if (IN(7)) { PH_BEGIN(); p_norm2(a, F, l); SEAM(); } \
        if (IN(8)) { PH_BEGIN(); p_router(F, l); SEAM(); } \
        if (IN(9)) { PH_BEGIN(); p_topk(a, F, l); SEAM(); } \
        if (IN(10)) { PH_BEGIN(); p_fill(F, l); SEAM(); } \
        if (IN(11)) { PH_BEGIN(); p_gemm1(F, l); SEAM(); } \
        if (IN(12)) { PH_BEGIN(); p_gemm2(F, l, 0); SEAM(); } \
        if (IN(13)) { PH_BEGIN(); p_combine(a, F, l, 0); SEAM(); } \
        if (IN(14)) { PH_BEGIN(); p_gemm2(F, l, 1); SEAM(); } \
        if (IN(15)) { PH_BEGIN(); p_combine(a, F, l, 1); SEAM(); } \
        if (IN(16) && l == 0) { PH_BEGIN(); p_expert_cvt(a, F, 1); SEAM(); }
#if MK_N_LAUNCHES == 1
    { LAYER_BODY(0) }
    { LAYER_BODY(1) }
#else
    for (int l_ = a.l_lo; l_ < a.l_hi; ++l_) { const int l = l_; LAYER_BODY(l) }
#endif
#undef LAYER_BODY
    if (IN(17)) { PH_BEGIN(); p_final(a, F); }
#undef IN
#undef SEAM
#undef PH_BEGIN
}


extern "C" void kernel_launch(void* const* d_in, const int* in_sizes, int n_in, void* d_out, int out_size, void* d_ws, size_t ws_size, hipStream_t stream) {
    static int grid = 0;
    if (grid == 0) {
        if (ws_size < 622 * MiB || n_in != 25 || out_size != T * D) { fprintf(stderr, "kernel_launch: unexpected problem (ws %zu, n_in %d, out %d)\n", ws_size, n_in, out_size); grid = -1; return; }
        int dev = 0, cus = 0, per_cu = 0;
        if (hipGetDevice(&dev) != hipSuccess || hipDeviceGetAttribute(&cus, hipDeviceAttributeMultiprocessorCount, dev) != hipSuccess) { grid = -1; return; }
        if (hipFuncSetAttribute((const void*)mega, hipFuncAttributeMaxDynamicSharedMemorySize, LDS_BYTES) != hipSuccess) { fprintf(stderr, "kernel_launch: hipFuncSetAttribute failed\n"); grid = -1; return; }
        if (hipOccupancyMaxActiveBlocksPerMultiprocessor(&per_cu, (const void*)mega, NTHREADS, LDS_BYTES) != hipSuccess || per_cu < 1) { fprintf(stderr, "kernel_launch: occupancy query says %d\n", per_cu); grid = -1; (void)hipGetLastError(); return; }
        grid = cus;
    }
    if (grid < 0) return;
    Args a{}; for (int i = 0; i < 25; ++i) a.in[i] = (const float*)d_in[i]; a.out = (float*)d_out; a.ws = (unsigned char*)d_ws;
    hipMemsetAsync((char*)d_ws + WS_CTL, 0, CTL_BYTES, stream);
#if MK_N_LAUNCHES == 1
    a.ph_lo = 0; a.ph_hi = 18; a.l_lo = 0; a.l_hi = DEPTH;
    hipLaunchKernelGGL(mega, dim3(grid), dim3(NTHREADS), LDS_BYTES, stream, a);
#else
    auto launch = [&](int ph, int l) { Args b = a; b.ph_lo = ph; b.ph_hi = ph + 1; b.l_lo = l; b.l_hi = l + 1; hipLaunchKernelGGL(mega, dim3(grid), dim3(NTHREADS), LDS_BYTES, stream, b); };
    launch(0, 0);
    for (int l = 0; l < DEPTH; ++l) { for (int ph = 1; ph <= 15; ++ph) launch(ph, l); if (l == 0) launch(16, 0); }
    launch(17, 0);
#endif
}
```

```cpp
#include <hip/hip_runtime.h>
#include <cstdio>
#include <cstdint>

constexpr int D = 1024, NB = 16, S = 2048, T = NB * S, DEPTH = 2;
constexpr int DIN = 8216;
constexpr int C_QK = 0, C_VM = 1024, C_OM = 2048, C_IM = 3072, C_FM = 3076, C_QG = 3080, C_KG = 3592, C_VG = 4104, C_RG = 5128, C_ZG = 5144, C_GA = 6168, C_GB = 7192;
constexpr int NE = 64, TOPK = 8, DE = 256;
constexpr int NASSIGN = T * TOPK, NROWS = NASSIGN + NE * 256, NBLK = NROWS / 256;
constexpr float EPS = 1e-6f;

__device__ __forceinline__ float sigmoidf_(float x) { return 1.f / (1.f + __expf(-x)); }
__device__ __forceinline__ float siluf_(float x) { return x / (1.f + __expf(-x)); }
__device__ __forceinline__ float logsigmoidf_(float x) { return fminf(x, 0.f) - log1pf(__expf(-fabsf(x))); }
__device__ __forceinline__ float wave_sum(float v) {
#pragma unroll
    for (int o = 1; o < 64; o <<= 1) v += __shfl_xor(v, o);
    return v;
}

#define LAS __attribute__((address_space(3)))
typedef unsigned short bf16_t;
typedef short bf16x8 __attribute__((ext_vector_type(8)));
typedef float f32x4 __attribute__((ext_vector_type(4)));
typedef float f32x2 __attribute__((ext_vector_type(2)));
typedef unsigned u32x4 __attribute__((ext_vector_type(4)));
typedef unsigned u32x2 __attribute__((ext_vector_type(2)));

constexpr size_t MiB = 1u << 20;
constexpr int NWAVES = 8, NTHREADS = 512;
constexpr int LDS_BYTES = 147456;
constexpr int RING_BYTES = 131072, MISC_OFF = RING_BYTES;

constexpr size_t WS_CTL = 0, CTL_BYTES = 1 * MiB;
constexpr size_t WS_ADA = 1 * MiB;
constexpr size_t WS_WSM = 2 * MiB, WSM_STRIDE = 25 * MiB;
constexpr size_t WO_IN = 0, WO_GAB = 12 * MiB + 512 * 1024, WO_PA = WO_GAB + 4 * MiB, WO_PB = WO_PA + 2 * MiB, WO_O = WO_PB + 2 * MiB, WO_S13 = WO_O + 2 * MiB, WO_S2 = WO_S13 + 1 * MiB, WO_R = WO_S2 + 512 * 1024;
constexpr size_t WS_WEXP13 = 52 * MiB, WS_WEXP2 = 116 * MiB;
constexpr size_t WS_SMALL = 148 * MiB;
constexpr size_t WS_LOGITS = 152 * MiB, WS_EIDX = 160 * MiB, WS_WTS = 161 * MiB, WS_POS = 162 * MiB, WS_ROWTOK = 163 * MiB;
constexpr size_t WS_U = 166 * MiB;
constexpr size_t WS_PB = 230 * MiB, PB_STRIDE = 64 * MiB;
constexpr size_t WS_OPT_END = 614 * MiB;
static_assert(WO_R + 512 * 1024 <= WSM_STRIDE, "small weight map");

constexpr int CW_BAR = 4096;
constexpr int CW_CNT = 16384;
constexpr int CW_ERR = 20480;

__device__ __forceinline__ unsigned f2bf(float f) { unsigned u = __builtin_bit_cast(unsigned, f); return (u + 0x7fffu + ((u >> 16) & 1u)) >> 16; }
__device__ __forceinline__ unsigned pk2(float lo, float hi) { return f2bf(lo) | (f2bf(hi) << 16); }
__device__ __forceinline__ float bf2f(unsigned short b) { return __builtin_bit_cast(float, (unsigned)b << 16); }
__device__ __forceinline__ float bflo(unsigned w) { return __builtin_bit_cast(float, w << 16); }
__device__ __forceinline__ float bfhi(unsigned w) { return __builtin_bit_cast(float, w & 0xffff0000u); }
__device__ __forceinline__ unsigned cvt_pk_bf16(float lo, float hi) { unsigned r; asm volatile("v_cvt_pk_bf16_f32 %0, %1, %2" : "=v"(r) : "v"(lo), "v"(hi)); return r; }
#define LDS_WAIT() asm volatile("s_waitcnt lgkmcnt(0)" ::: "memory")
#define VM_WAIT() asm volatile("s_waitcnt vmcnt(0)" ::: "memory")

namespace pg8 {
constexpr int BM = 256, BK = 64, HALF = 128, HTB = HALF * BK * 2, STAGE_BYTES = 8 * HTB, NXCD = 8, WGM = 8;
__host__ __device__ __forceinline__ int lds_byte(int r, int c) { const int st = (r >> 4) * 2 + (c >> 5), rr = r & 15, cc = c & 31, ob = rr * 64 + cc * 2; return st * 1024 + (ob ^ (((ob >> 9) & 1) << 5)); }
__host__ __device__ __forceinline__ void stage_rc(int b, int& R, int& C) { const int st = b / 1024, sb = b % 1024, swz = sb ^ (((sb >> 9) & 1) << 5); R = (st >> 1) * 16 + swz / 64; C = (st & 1) * 32 + (swz % 64) / 2; }
__host__ __device__ __forceinline__ int perm32(int rho) { const int n = rho >> 4, i = rho & 15; return 8 * (i >> 2) + 4 * n + (i & 3); }

struct Unit { int pm, pn, e; };

struct TileOrder {
    int nM, nN, nwg, G, c;
    __device__ void init(int nM_, int nN_, int G_, int c_) { nM = nM_; nN = nN_; nwg = nM * nN; G = G_; c = c_; }
    __device__ bool tile(int i, int& pm, int& pn) const {
        const long L = (long)i * G + c; if (L >= nwg) return false;
        int wgid = (int)L; { const int q = nwg / NXCD, r = nwg % NXCD, xcd = wgid % NXCD, off = wgid / NXCD; wgid = (xcd < r ? xcd * (q + 1) : r * (q + 1) + (xcd - r) * q) + off; }
        const int nig = WGM * nN, gid = wgid / nig, fm = gid * WGM, gsz = (nM - fm) < WGM ? (nM - fm) : WGM;
        pm = fm + ((wgid % nig) % gsz); pn = (wgid % nig) / gsz; return true;
    }
};

template <class Epi, class Sched, bool GATHER>
__device__ __forceinline__ void gemm_phase(LAS unsigned char* lds, const int K, const Sched& S, const Epi& E) {
    int tid_ = threadIdx.x; asm volatile("" : "+v"(tid_));
    const int tid = tid_, wid = __builtin_amdgcn_readfirstlane(tid >> 6), lane = tid & 63, wr = wid >> 2, wc = wid & 3, fr = lane & 15, fq = lane >> 4;
    const int nt = K / BK;
    unsigned rowA[2], colA[2], voffB[2];
#pragma unroll
    for (int i = 0; i < 2; ++i) { int R, C; stage_rc(tid * 16 + i * 8192, R, C); const int Rb = Epi::PERM ? ((R & ~31) + perm32(R & 31)) : R;
        rowA[i] = (unsigned)R; colA[i] = (unsigned)C * 2u; voffB[i] = (unsigned)(Rb * K + C) * 2u; }
    const size_t kstep = (size_t)(BK * 2);
    const size_t hstep = (size_t)HALF * K * 2;
    const unsigned ldsw = (unsigned)wid * 1024u;
    const int aoff = lds_byte(wr * 64 + fr, fq * 8), boff = lds_byte(wc * 32 + fr, fq * 8);
#define PG8_SA(b, h) (((b) * 2 + (h)) * HTB)
#define PG8_SB(b, h) ((4 + (b) * 2 + (h)) * HTB)
#define PG8_STAGE(bufoff, gbase, voff) do { _Pragma("unroll") for (int _i = 0; _i < 2; ++_i) \
        __builtin_amdgcn_global_load_lds((const unsigned*)((const char*)(gbase) + (voff)[_i]), (LAS unsigned*)(lds + (bufoff) + ldsw + _i * 8192), 16, 0, 0); } while (0)
#define PG8_LDA(dst, b, h) do { _Pragma("unroll") for (int m = 0; m < 4; ++m) _Pragma("unroll") for (int k = 0; k < 2; ++k) dst[m][k] = *(const LAS bf16x8*)(lds + PG8_SA(b, h) + aoff + m * 2048 + k * 1024); } while (0)
#define PG8_LDB(dst, b, h) do { _Pragma("unroll") for (int n = 0; n < 2; ++n) _Pragma("unroll") for (int k = 0; k < 2; ++k) dst[n][k] = *(const LAS bf16x8*)(lds + PG8_SB(b, h) + boff + n * 2048 + k * 1024); } while (0)
#define PG8_MMA(ai, bj, At, Bt) do { __builtin_amdgcn_s_setprio(1); _Pragma("unroll") for (int m = 0; m < 4; ++m) _Pragma("unroll") for (int n = 0; n < 2; ++n) _Pragma("unroll") for (int k = 0; k < 2; ++k) \
        acc[ai][bj][m][n] = __builtin_amdgcn_mfma_f32_16x16x32_bf16(Bt[n][k], At[m][k], acc[ai][bj][m][n], 0, 0, 0); __builtin_amdgcn_s_setprio(0); } while (0)
#define PG8_WAIT_V(n) asm volatile("s_waitcnt vmcnt(" #n ")" ::: "memory")
#define PG8_WAIT_L(n) asm volatile("s_waitcnt lgkmcnt(" #n ")" ::: "memory")
#define PG8_BAR __builtin_amdgcn_s_barrier()
#define PG8_SCHED __builtin_amdgcn_sched_barrier(0)
    Unit cur, nxt; int ui = 0;
    if (!S.next(0, cur)) return;
    unsigned offA[2][2], noffA[2][2];
    {
        const int* tk = GATHER ? S.a_rows(cur) : nullptr;
#pragma unroll
        for (int h = 0; h < 2; ++h)
#pragma unroll
            for (int i = 0; i < 2; ++i) offA[h][i] = (GATHER ? (unsigned)tk[h * HALF + rowA[i]] : (unsigned)(h * HALF) + rowA[i]) * (unsigned)(K * 2) + colA[i];
    }
    f32x4 acc[2][2][4][2];
#pragma unroll
    for (int a = 0; a < 2; ++a)
#pragma unroll
        for (int b = 0; b < 2; ++b)
#pragma unroll
            for (int m = 0; m < 4; ++m)
#pragma unroll
                for (int n = 0; n < 2; ++n) acc[a][b][m][n] = (f32x4){0.f, 0.f, 0.f, 0.f};
    bf16x8 At[4][2], B0[2][2], B1[2][2];
    const char* cA = S.a_ptr(cur); const char* cB = S.b_ptr(cur);
    PG8_STAGE(PG8_SB(0, 0), cB, voffB); PG8_STAGE(PG8_SB(0, 1), cB + hstep, voffB); PG8_STAGE(PG8_SA(0, 0), cA, offA[0]); PG8_STAGE(PG8_SA(0, 1), cA, offA[1]);
    if (wr == 1) PG8_BAR;
    PG8_WAIT_V(2); PG8_BAR;
    PG8_STAGE(PG8_SB(1, 0), cB + kstep, voffB); PG8_STAGE(PG8_SA(1, 0), cA + kstep, offA[0]); PG8_STAGE(PG8_SB(1, 1), cB + hstep + kstep, voffB);
    PG8_WAIT_V(6); PG8_BAR;
    for (;;) {
        const bool has_next = S.next(ui + 1, nxt);
        const char* nA = has_next ? S.a_ptr(nxt) : cA; const char* nB = has_next ? S.b_ptr(nxt) : cB;
        {
            const int* tk = (GATHER && has_next) ? S.a_rows(nxt) : nullptr;
#pragma unroll
            for (int h = 0; h < 2; ++h)
#pragma unroll
                for (int i = 0; i < 2; ++i) noffA[h][i] = (GATHER && has_next) ? (unsigned)tk[h * HALF + rowA[i]] * (unsigned)(K * 2) + colA[i] : offA[h][i];
        }
#pragma unroll 1
        for (int t = 0; t < nt; t += 2) {
            const bool last = (t == nt - 2);
            const char* a1 = cA + (size_t)(t + 1) * kstep;
            const char* a2 = last ? nA : cA + (size_t)(t + 2) * kstep; const char* b2 = last ? nB : cB + (size_t)(t + 2) * kstep;
            const char* a3 = a2 + kstep; const char* b3 = b2 + kstep;
            unsigned o2[2][2];
#pragma unroll
            for (int h = 0; h < 2; ++h)
#pragma unroll
                for (int i = 0; i < 2; ++i) o2[h][i] = (GATHER && last) ? noffA[h][i] : offA[h][i];
            PG8_LDB(B0, 0, 0); PG8_LDB(B1, 0, 1); PG8_SCHED; PG8_LDA(At, 0, 0); PG8_STAGE(PG8_SA(1, 1), a1, offA[1]);
            PG8_WAIT_V(8); PG8_WAIT_L(0); PG8_BAR; PG8_MMA(0, 0, At, B0); PG8_MMA(0, 1, At, B1); PG8_BAR; PG8_SCHED;
            PG8_LDA(At, 0, 1); PG8_STAGE(PG8_SB(0, 0), b2, voffB); PG8_STAGE(PG8_SB(0, 1), b2 + hstep, voffB); PG8_STAGE(PG8_SA(0, 0), a2, o2[0]);
            PG8_WAIT_V(8); PG8_WAIT_L(0); PG8_BAR; PG8_MMA(1, 0, At, B0); PG8_MMA(1, 1, At, B1); PG8_BAR; PG8_SCHED;
            PG8_LDB(B0, 1, 0); PG8_LDB(B1, 1, 1); PG8_SCHED; PG8_LDA(At, 1, 0); PG8_STAGE(PG8_SA(0, 1), a2, o2[1]);
            PG8_WAIT_V(8); PG8_WAIT_L(0); PG8_BAR; PG8_MMA(0, 0, At, B0); PG8_MMA(0, 1, At, B1); PG8_BAR; PG8_SCHED;
            PG8_LDA(At, 1, 1); PG8_STAGE(PG8_SB(1, 0), b3, voffB); PG8_STAGE(PG8_SB(1, 1), b3 + hstep, voffB); PG8_STAGE(PG8_SA(1, 0), a3, o2[0]);
            PG8_WAIT_V(8); PG8_WAIT_L(0); PG8_BAR; PG8_MMA(1, 0, At, B0); PG8_MMA(1, 1, At, B1); PG8_BAR; PG8_SCHED;
        }
        if (wr == 0) PG8_BAR;
        E(acc, cur, wr, wc, fr, fq);
        if (!has_next) break;
#pragma unroll
        for (int a = 0; a < 2; ++a)
#pragma unroll
            for (int b = 0; b < 2; ++b)
#pragma unroll
                for (int m = 0; m < 4; ++m)
#pragma unroll
                    for (int n = 0; n < 2; ++n) acc[a][b][m][n] = (f32x4){0.f, 0.f, 0.f, 0.f};
        cur = nxt; cA = nA; cB = nB; ++ui;
#pragma unroll
        for (int h = 0; h < 2; ++h)
#pragma unroll
            for (int i = 0; i < 2; ++i) offA[h][i] = noffA[h][i];
        if (wr == 1) PG8_BAR;
    }
    PG8_WAIT_V(0);
    PG8_BAR;
#undef PG8_SA
#undef PG8_SB
#undef PG8_STAGE
#undef PG8_LDA
#undef PG8_LDB
#undef PG8_MMA
#undef PG8_WAIT_V
#undef PG8_WAIT_L
#undef PG8_BAR
#undef PG8_SCHED
}
}

#ifndef MK_TEST_THR
#define MK_TEST_THR 0.01f
#endif
#ifndef MK_N_LAUNCHES
#define MK_N_LAUNCHES 1
#endif
#define XB_TMO      128
#define XB_XCNT(j)  (256  + 64 * (j))
#define XB_XSUB(j)  (1280 + 64 * (j))
#define XB_XGEN(j)  (2304 + 64 * (j))
#define XB_TOP      3328
#define XB_TOPGEN   3392
#define XCD_BAR_WORDS 3456
#define XB_SPIN_CAP (1u << 22)

__device__ __forceinline__ unsigned xb_ld(unsigned* p)              { return __hip_atomic_load(p, __ATOMIC_RELAXED, __HIP_MEMORY_SCOPE_AGENT); }
__device__ __forceinline__ unsigned xb_add(unsigned* p, unsigned v) { return __hip_atomic_fetch_add(p, v, __ATOMIC_RELAXED, __HIP_MEMORY_SCOPE_AGENT); }
__device__ __forceinline__ unsigned xb_xcc_id() { return (unsigned)__builtin_amdgcn_s_getreg((3 << 11) | 20) & 0xFu; }
#define XB_SPIN(cond, bar) do { unsigned _sp = 0; while (cond) { __builtin_amdgcn_s_sleep(1); \
    if ((++_sp & 255u) == 0u) { if (xb_ld(&(bar)[XB_TMO])) break; if (_sp > XB_SPIN_CAP) { atomicAdd(&(bar)[XB_TMO], 1u); break; } } } } while (0)

struct XcdBarrier {
    unsigned* bar; unsigned x;
    volatile LAS unsigned* st;
};

__device__ __forceinline__ XcdBarrier xcd_barrier_post(unsigned* bar, volatile LAS unsigned* st) {
    XcdBarrier b; b.bar = bar; b.x = xb_xcc_id(); b.st = st;
    if (threadIdx.x == 0) (void)xb_add(&bar[XB_XCNT(b.x)], 1u);
    return b;
}
__device__ __forceinline__ void xcd_barrier_complete(unsigned* bar, unsigned x, unsigned& nloc, unsigned& nx) {
    const unsigned G = gridDim.x * gridDim.y * gridDim.z;
    unsigned sum, cnt, mine, sp = 0u;
    for (;;) {
        sum = 0u; cnt = 0u; mine = 0u;
#pragma unroll
        for (unsigned j = 0; j < 16; ++j) { const unsigned c = xb_ld(&bar[XB_XCNT(j)]); sum += c; cnt += (c > 0u) ? 1u : 0u; mine = (j == x) ? c : mine; }
        if (sum == G) break;
        __builtin_amdgcn_s_sleep(1);
        if ((++sp & 255u) == 0u) { if (xb_ld(&bar[XB_TMO])) break; if (sp > XB_SPIN_CAP) { atomicAdd(&bar[XB_TMO], 1u); break; } }
    }
    nloc = mine > 0u ? mine : 1u; nx = cnt > 0u ? cnt : 1u;
}

__device__ __forceinline__ void xcd_barrier(const XcdBarrier& b) {
    asm volatile("s_waitcnt vmcnt(0)" ::: "memory");
    __syncthreads();
    if (threadIdx.x == 0) {
        unsigned* bar = b.bar;
        __builtin_amdgcn_s_waitcnt(0);
        unsigned nloc = b.st[0], nx = b.st[1];
        if (nloc == 0u) { xcd_barrier_complete(bar, b.x, nloc, nx); b.st[0] = nloc; b.st[1] = nx; }
        const unsigned old = xb_add(&bar[XB_XSUB(b.x)], 1u);
        const unsigned gen = old / nloc;
        if (old + 1u == (gen + 1u) * nloc) {
            __builtin_amdgcn_fence(__ATOMIC_RELEASE, "agent");
            asm volatile("s_waitcnt vmcnt(0)" ::: "memory");
            const unsigned og = xb_add(&bar[XB_TOP], 1u);
            const unsigned tg = og / nx;
            if (og + 1u == (tg + 1u) * nx) xb_add(&bar[XB_TOPGEN], 1u);
            else XB_SPIN(xb_ld(&bar[XB_TOPGEN]) == tg, bar);
            __builtin_amdgcn_fence(__ATOMIC_ACQUIRE, "agent");
            xb_add(&bar[XB_XGEN(b.x)], 1u);
            asm volatile("s_waitcnt vmcnt(0)" ::: "memory");
        } else {
            XB_SPIN(xb_ld(&bar[XB_XGEN(b.x)]) == gen, bar);
            __builtin_amdgcn_fence(__ATOMIC_ACQUIRE, "agent");
            asm volatile("s_waitcnt vmcnt(0)" ::: "memory");
        }
    }
    __syncthreads();
}


struct Args { const float* in[25]; float* out; unsigned char* ws; int ph_lo, ph_hi, l_lo, l_hi; };
struct Frame {
    LAS unsigned char* lds;
    unsigned char* ws;
    int tid, lane, wave, G, bid;
};
enum { I_X = 0, I_C, I_ADAW, I_ADAB, I_NMIXW, I_NMOEW, I_WIN, I_CONVW, I_GATEB, I_MNORMW, I_ALPHAW, I_ALPHAB, I_GNORMW, I_WPA, I_WPB, I_WO, I_RW, I_RB, I_EW1, I_EW3, I_EW2, I_SW1, I_SW3, I_SW2, I_FNW };

__device__ __forceinline__ bf16_t* wsm(unsigned char* ws, int l, size_t off) { return (bf16_t*)(ws + WS_WSM + (size_t)l * WSM_STRIDE + off); }

__device__ __forceinline__ void tr_item(const float* W, int ldw, int c0, int k0, bf16_t* WT, int r0, int K, LAS float* scr, int lane) {
#pragma unroll 8
    for (int i = 0; i < 32; ++i) { const int kk = 2 * i + (lane >> 5); scr[kk * 33 + (lane & 31)] = W[(size_t)(k0 + kk) * ldw + c0 + (lane & 31)]; }
    LDS_WAIT(); asm volatile("" ::: "memory");
    const int c = lane & 7;
#pragma unroll
    for (int j = 0; j < 4; ++j) { const int n = (lane >> 3) + 8 * j; const LAS float* s = scr + (8 * c) * 33 + n;
        u32x4 o; o.x = pk2(s[0 * 33], s[1 * 33]); o.y = pk2(s[2 * 33], s[3 * 33]); o.z = pk2(s[4 * 33], s[5 * 33]); o.w = pk2(s[6 * 33], s[7 * 33]);
        *(u32x4*)(WT + (size_t)(r0 + n) * K + k0 + 8 * c) = o; }
    LDS_WAIT(); asm volatile("" ::: "memory");
}
constexpr int SW_ITEMS = 96 * 16 + 3 * 32 * 16 + 64 * 16 + 3 * 32 * 16 + 4 * 4 * 16 + 32 * 4 + 8 * 16 + 8 * 16;
__device__ __forceinline__ void small_item(const Args& a, unsigned char* ws, int l, int r, LAS float* scr, int lane) {
    const float* win = a.in[I_WIN] + (size_t)l * D * DIN;
    bf16_t* Win_t = wsm(ws, l, WO_IN);
    if (r < 96 * 16) { const int nb = r % 96, kb = r / 96; tr_item(win, DIN, nb * 32, kb * 64, Win_t, nb * 32, D, scr, lane); return; } r -= 96 * 16;
    if (r < 32 * 16) { const int nb = r % 32, kb = r / 32; tr_item(win, DIN, C_QG + nb * 32, kb * 64, Win_t, 3072 + nb * 32, D, scr, lane); return; } r -= 32 * 16;
    if (r < 32 * 16) { const int nb = r % 32, kb = r / 32; tr_item(win, DIN, C_VG + nb * 32, kb * 64, Win_t, 4096 + nb * 32, D, scr, lane); return; } r -= 32 * 16;
    if (r < 32 * 16) { const int nb = r % 32, kb = r / 32; tr_item(win, DIN, C_ZG + nb * 32, kb * 64, Win_t, 5120 + nb * 32, D, scr, lane); return; } r -= 32 * 16;
    if (r < 64 * 16) { const int nb = r % 64, kb = r / 64; tr_item(win, DIN, C_GA + nb * 32, kb * 64, wsm(ws, l, WO_GAB), nb * 32, D, scr, lane); return; } r -= 64 * 16;
    if (r < 32 * 16) { const int nb = r % 32, kb = r / 32; tr_item(a.in[I_WPA] + (size_t)l * D * D, D, nb * 32, kb * 64, wsm(ws, l, WO_PA), nb * 32, D, scr, lane); return; } r -= 32 * 16;
    if (r < 32 * 16) { const int nb = r % 32, kb = r / 32; tr_item(a.in[I_WPB] + (size_t)l * D * D, D, nb * 32, kb * 64, wsm(ws, l, WO_PB), nb * 32, D, scr, lane); return; } r -= 32 * 16;
    if (r < 32 * 16) { const int nb = r % 32, kb = r / 32; tr_item(a.in[I_WO] + (size_t)l * D * D, D, nb * 32, kb * 64, wsm(ws, l, WO_O), nb * 32, D, scr, lane); return; } r -= 32 * 16;
    if (r < 4 * 4 * 16) { const int seg = r / 64, it = r % 64, nb = it % 4, kb = it / 4;
        const float* src = ((seg & 1) ? a.in[I_SW3] : a.in[I_SW1]) + (size_t)l * D * DE;
        tr_item(src, DE, (seg >> 1) * 128 + nb * 32, kb * 64, wsm(ws, l, WO_S13), seg * 128 + nb * 32, D, scr, lane); return; } r -= 256;
    if (r < 32 * 4) { const int nb = r % 32, kb = r / 32; tr_item(a.in[I_SW2] + (size_t)l * DE * D, D, nb * 32, kb * 64, wsm(ws, l, WO_S2), nb * 32, DE, scr, lane); return; } r -= 128;
    if (r < 8 * 16) {
        const int nb = r % 8, kb = r / 8; bf16_t* Wr = wsm(ws, l, WO_R);
        if (nb < 2) tr_item(a.in[I_RW] + (size_t)l * D * NE, NE, nb * 32, kb * 64, Wr, nb * 32, D, scr, lane);
        else for (int j = 0; j < 32; ++j) Wr[(size_t)(nb * 32 + j) * D + kb * 64 + lane] = 0;
        return; } r -= 128;
    {
        const int rb = r % 8, kb = r / 8;
        for (int j = 0; j < 32; ++j) {
            const int row = rb * 32 + j; float v = 0.f;
            if (row < 24) { const int srcc = row < 4 ? C_IM + row : (row < 8 ? C_FM + row - 4 : C_RG + row - 8); v = win[(size_t)(kb * 64 + lane) * DIN + srcc]; }
            Win_t[(size_t)(6144 + row) * D + kb * 64 + lane] = (bf16_t)f2bf(v);
        }
    }
}
constexpr int EX_ITEMS = 64 * 384;
__device__ __forceinline__ void expert_item(const Args& a, unsigned char* ws, int l, int idx, LAS float* scr, int lane) {
    const int e = idx / 384; int r = idx % 384;
    if (r < 256) { const int seg = r / 64, it = r % 64, nb = it % 4, kb = it / 4;
        const float* src = ((seg & 1) ? a.in[I_EW3] : a.in[I_EW1]) + ((size_t)l * NE + e) * D * DE;
        tr_item(src, DE, (seg >> 1) * 128 + nb * 32, kb * 64, (bf16_t*)(ws + WS_WEXP13) + (size_t)e * 512 * D, seg * 128 + nb * 32, D, scr, lane); return; }
    r -= 256; { const int nb = r % 32, kb = r / 32;
        tr_item(a.in[I_EW2] + ((size_t)l * NE + e) * DE * D, D, nb * 32, kb * 64, (bf16_t*)(ws + WS_WEXP2) + (size_t)e * D * DE, nb * 32, DE, scr, lane); }
}
__device__ __forceinline__ void p0a(const Args& a, Frame& F, bool experts0) {
    const int gw = F.bid * NWAVES + F.wave, NGW = F.G * NWAVES;
    LAS float* cond = (LAS float*)F.lds;
    LAS float* scr = (LAS float*)(F.lds + F.wave * 8704);
    if (F.bid * NWAVES < 192) {
        const float* c = a.in[I_C];
        for (int i = F.tid; i < NB * D; i += NTHREADS) cond[i] = siluf_(c[i]);
        __syncthreads();
        if (gw < 192) {
            const int l = gw / 96, j = (gw % 96) * 64 + F.lane;
            const float* w = a.in[I_ADAW] + (size_t)l * D * 6 * D + j;
            float acc[NB];
#pragma unroll
            for (int b = 0; b < NB; ++b) acc[b] = 0.f;
            for (int k = 0; k < D; ++k) { const float wv = w[(size_t)k * 6 * D];
#pragma unroll
                for (int b = 0; b < NB; ++b) acc[b] += cond[b * D + k] * wv; }
            const float bb = a.in[I_ADAB][l * 6 * D + j];
            float* ada = (float*)(F.ws + WS_ADA);
#pragma unroll
            for (int b = 0; b < NB; ++b) ada[((size_t)l * NB + b) * 6 * D + j] = acc[b] + bb;
        }
        __syncthreads();
    }
    const int total = 2 * SW_ITEMS + (experts0 ? EX_ITEMS : 0);
    for (int it = gw; it < total; it += NGW) {
        if (it < 2 * SW_ITEMS) small_item(a, F.ws, it / SW_ITEMS, it % SW_ITEMS, scr, F.lane);
        else expert_item(a, F.ws, 0, it - 2 * SW_ITEMS, scr, F.lane);
    }
}
__device__ __forceinline__ void p_norm(Frame& F, const float* h, const float* w, const float* sh, const float* sc, bf16_t* U) {
    const int gw = F.bid * NWAVES + F.wave, NGW = F.G * NWAVES;
    f32x4 wv[4];
#pragma unroll
    for (int j = 0; j < 4; ++j) wv[j] = ((const f32x4*)w)[F.lane + 64 * j];
    for (int row = gw; row < T; row += NGW) {
        const int b = row / S;
        const f32x4* xr = (const f32x4*)(h + (size_t)row * D) + F.lane;
        f32x4 v[4]; float ss = 0.f;
#pragma unroll
        for (int j = 0; j < 4; ++j) { v[j] = xr[64 * j]; ss += (v[j].x * v[j].x + v[j].y * v[j].y) + (v[j].z * v[j].z + v[j].w * v[j].w); }
        const float r = rsqrtf(wave_sum(ss) * (1.f / D) + EPS);
        u32x2* o = (u32x2*)(U + (size_t)row * D) + F.lane;
#pragma unroll
        for (int j = 0; j < 4; ++j) {
            const f32x4 scv = ((const f32x4*)(sc + (size_t)b * 6 * D))[F.lane + 64 * j], shv = ((const f32x4*)(sh + (size_t)b * 6 * D))[F.lane + 64 * j];
            const f32x4 y = v[j] * r * wv[j] * (scv + 1.f) + shv;
            u32x2 pk; pk.x = pk2(y.x, y.y); pk.y = pk2(y.z, y.w); o[64 * j] = pk;
        }
    }
}
struct SchedDense {
    pg8::TileOrder O; const char* A; const char* B; size_t tstep;
    __device__ bool next(int i, pg8::Unit& u) const { u.e = 0; return O.tile(i, u.pm, u.pn); }
    __device__ const char* a_ptr(const pg8::Unit& u) const { return A + (size_t)u.pm * tstep; }
    __device__ const char* b_ptr(const pg8::Unit& u) const { return B + (size_t)u.pn * tstep; }
    __device__ const int* a_rows(const pg8::Unit&) const { return nullptr; }
};
struct EpiInProj {
    static constexpr bool PERM = true;
    bf16_t* PB; float* small;
    __device__ __forceinline__ void operator()(const f32x4 (&acc)[2][2][4][2], const pg8::Unit& u, int wr, int wc, int fr, int fq) const {
        const int row0 = u.pm * 256 + wr * 64 + fr;
        if (u.pn < 24) {
            bf16_t* base = PB + (size_t)(u.pn >> 2) * (PB_STRIDE / 2) + (u.pn & 3) * 256 + wc * 32 + 8 * fq;
#pragma unroll
            for (int ai = 0; ai < 2; ++ai)
#pragma unroll
                for (int m = 0; m < 4; ++m) { bf16_t* rowp = base + (size_t)(row0 + ai * 128 + m * 16) * D;
#pragma unroll
                    for (int bj = 0; bj < 2; ++bj) { const f32x4 v0 = acc[ai][bj][m][0], v1 = acc[ai][bj][m][1];
                        u32x4 w; w.x = cvt_pk_bf16(v0[0], v0[1]); w.y = cvt_pk_bf16(v0[2], v0[3]); w.z = cvt_pk_bf16(v1[0], v1[1]); w.w = cvt_pk_bf16(v1[2], v1[3]);
                        *(u32x4*)(rowp + bj * 128) = w; } }
        } else if (wc == 0) {
#pragma unroll
            for (int ai = 0; ai < 2; ++ai)
#pragma unroll
                for (int m = 0; m < 4; ++m) { float* rp = small + (size_t)(row0 + ai * 128 + m * 16) * 32 + 8 * fq;
                    *(f32x4*)rp = acc[ai][0][m][0]; *(f32x4*)(rp + 4) = acc[ai][0][m][1]; }
        }
    }
};
__device__ __forceinline__ void p_inproj(Frame& F, int l) {
    SchedDense Sd; Sd.O.init(T / 256, 25, F.G, F.bid); Sd.A = (const char*)(F.ws + WS_U); Sd.B = (const char*)wsm(F.ws, l, WO_IN); Sd.tstep = (size_t)256 * D * 2;
    EpiInProj E{(bf16_t*)(F.ws + WS_PB), (float*)(F.ws + WS_SMALL)};
    pg8::gemm_phase<EpiInProj, SchedDense, false>(F.lds, D, Sd, E);
}


struct EpiSig { static constexpr bool PERM = true;
    bf16_t* PB;
    __device__ __forceinline__ void operator()(const f32x4 (&acc)[2][2][4][2], const pg8::Unit& u, int wr, int wc, int fr, int fq) const {
        const int row0 = u.pm * 256 + wr * 64 + fr;
        bf16_t* base = PB + (size_t)(u.pn >> 2) * (PB_STRIDE / 2) + (u.pn & 3) * 256 + wc * 32 + 8 * fq;
#pragma unroll
        for (int ai = 0; ai < 2; ++ai)
#pragma unroll
            for (int m = 0; m < 4; ++m) { bf16_t* rowp = base + (size_t)(row0 + ai * 128 + m * 16) * D;
#pragma unroll
                for (int bj = 0; bj < 2; ++bj) { const f32x4 v0 = acc[ai][bj][m][0], v1 = acc[ai][bj][m][1];
                    u32x4 w; w.x = cvt_pk_bf16(sigmoidf_(v0[0]), sigmoidf_(v0[1])); w.y = cvt_pk_bf16(sigmoidf_(v0[2]), sigmoidf_(v0[3]));
                    w.z = cvt_pk_bf16(sigmoidf_(v1[0]), sigmoidf_(v1[1])); w.w = cvt_pk_bf16(sigmoidf_(v1[2]), sigmoidf_(v1[3]));
                    *(u32x4*)(rowp + bj * 128) = w; } }
    }
};
__device__ __forceinline__ void p_gates(Frame& F, int l) {
    SchedDense Sd; Sd.O.init(T / 256, 8, F.G, F.bid); Sd.A = (const char*)(F.ws + WS_U); Sd.B = (const char*)wsm(F.ws, l, WO_GAB); Sd.tstep = (size_t)256 * D * 2;
    EpiSig E{(bf16_t*)(F.ws + WS_PB)};
    pg8::gemm_phase<EpiSig, SchedDense, false>(F.lds, D, Sd, E);
}
struct SchedY {
    pg8::TileOrder O; const char* A0; const char* A1; const char* B0; const char* B1; size_t tstep;
    __device__ bool next(int i, pg8::Unit& u) const { u.e = i & 1; return O.tile(i >> 1, u.pm, u.pn); }
    __device__ const char* a_ptr(const pg8::Unit& u) const { return (u.e ? A1 : A0) + (size_t)u.pm * tstep; }
    __device__ const char* b_ptr(const pg8::Unit& u) const { return (u.e ? B1 : B0) + (size_t)u.pn * tstep; }
    __device__ const int* a_rows(const pg8::Unit&) const { return nullptr; }
};
struct EpiY { static constexpr bool PERM = true;
    const bf16_t* SA; const bf16_t* SB; bf16_t* Y;
    __device__ __forceinline__ void operator()(const f32x4 (&acc)[2][2][4][2], const pg8::Unit& u, int wr, int wc, int fr, int fq) const {
        const int row0 = u.pm * 256 + wr * 64 + fr; const size_t colb = (size_t)u.pn * 256 + wc * 32 + 8 * fq;
        const bf16_t* G = u.e ? SB : SA;
#pragma unroll
        for (int ai = 0; ai < 2; ++ai)
#pragma unroll
            for (int m = 0; m < 4; ++m) { const size_t ro = (size_t)(row0 + ai * 128 + m * 16) * D + colb;
#pragma unroll
                for (int bj = 0; bj < 2; ++bj) { const f32x4 v0 = acc[ai][bj][m][0], v1 = acc[ai][bj][m][1];
                    const u32x4 g = *(const u32x4*)(G + ro + bj * 128);
                    float r0 = bflo(g.x) * v0[0], r1 = bfhi(g.x) * v0[1], r2 = bflo(g.y) * v0[2], r3 = bfhi(g.y) * v0[3], r4 = bflo(g.z) * v1[0], r5 = bfhi(g.z) * v1[1], r6 = bflo(g.w) * v1[2], r7 = bfhi(g.w) * v1[3];
                    if (u.e) { const u32x4 y = *(const u32x4*)(Y + ro + bj * 128);
                        r0 += bflo(y.x); r1 += bfhi(y.x); r2 += bflo(y.y); r3 += bfhi(y.y); r4 += bflo(y.z); r5 += bfhi(y.z); r6 += bflo(y.w); r7 += bfhi(y.w); }
                    u32x4 w; w.x = cvt_pk_bf16(r0, r1); w.y = cvt_pk_bf16(r2, r3); w.z = cvt_pk_bf16(r4, r5); w.w = cvt_pk_bf16(r6, r7);
                    *(u32x4*)(Y + ro + bj * 128) = w; } }
    }
};
__device__ __forceinline__ void p_y(Frame& F, int l) {
    SchedY Sy; Sy.O.init(T / 256, 4, F.G, F.bid); Sy.A0 = (const char*)(F.ws + WS_PB + 2 * PB_STRIDE); Sy.A1 = (const char*)(F.ws + WS_PB + 5 * PB_STRIDE);
    Sy.B0 = (const char*)wsm(F.ws, l, WO_PA); Sy.B1 = (const char*)wsm(F.ws, l, WO_PB); Sy.tstep = (size_t)256 * D * 2;
    EpiY E{(const bf16_t*)(F.ws + WS_PB), (const bf16_t*)(F.ws + WS_PB + PB_STRIDE), (bf16_t*)(F.ws + WS_PB + 3 * PB_STRIDE)};
    pg8::gemm_phase<EpiY, SchedY, false>(F.lds, D, Sy, E);
}
struct EpiResid { static constexpr bool PERM = false;
    const float* hin; float* hout; const float* gate;
    __device__ __forceinline__ void operator()(const f32x4 (&acc)[2][2][4][2], const pg8::Unit& u, int wr, int wc, int fr, int fq) const {
        const int row0 = u.pm * 256 + wr * 64 + fr, col0 = u.pn * 256 + wc * 32 + 4 * fq;
        const int b = (u.pm * 256) / S;
        f32x4 gv[2][2];
#pragma unroll
        for (int bj = 0; bj < 2; ++bj)
#pragma unroll
            for (int n = 0; n < 2; ++n) gv[bj][n] = *(const f32x4*)(gate + (size_t)b * 6 * D + col0 + bj * 128 + n * 16);
#pragma unroll
        for (int ai = 0; ai < 2; ++ai)
#pragma unroll
            for (int m = 0; m < 4; ++m) { const size_t ro = (size_t)(row0 + ai * 128 + m * 16) * D + col0;
#pragma unroll
                for (int bj = 0; bj < 2; ++bj)
#pragma unroll
                    for (int n = 0; n < 2; ++n) { const f32x4 hv = *(const f32x4*)(hin + ro + bj * 128 + n * 16);
                        *(f32x4*)(hout + ro + bj * 128 + n * 16) = hv + gv[bj][n] * acc[ai][bj][m][n]; } }
    }
};
__device__ __forceinline__ void p_wo(const Args& a, Frame& F, int l) {
    SchedDense Sd; Sd.O.init(T / 256, 4, F.G, F.bid); Sd.A = (const char*)(F.ws + WS_PB + 3 * PB_STRIDE); Sd.B = (const char*)wsm(F.ws, l, WO_O); Sd.tstep = (size_t)256 * D * 2;
    EpiResid E{l == 0 ? a.in[I_X] : a.out, a.out, (const float*)(F.ws + WS_ADA) + (size_t)l * NB * 6 * D + 2 * D};
    pg8::gemm_phase<EpiResid, SchedDense, false>(F.lds, D, Sd, E);
}


constexpr size_t WS_IDENT = 165 * MiB;
constexpr size_t WS_Y2H = 166 * MiB;
constexpr int VTILES = NBLK + T / 256, VROWS = VTILES * 256;
constexpr size_t WS_HB = WS_Y2H + (size_t)VROWS * 512 * 2;
constexpr size_t WS_MOE_END = WS_HB + (size_t)VROWS * 256 * 2;
static_assert(WS_MOE_END <= 622 * MiB, "moe overlay");

__device__ __forceinline__ void p_norm2(const Args& a, Frame& F, int l) {
    const float* ada = (const float*)(F.ws + WS_ADA) + (size_t)l * NB * 6 * D;
    int* ident = (int*)(F.ws + WS_IDENT); int* row_tok = (int*)(F.ws + WS_ROWTOK);
    for (int i = F.bid * NTHREADS + F.tid; i < NROWS; i += F.G * NTHREADS) { row_tok[i] = 0; if (i < T) ident[i] = i; }
    p_norm(F, a.out, a.in[I_NMOEW] + l * D, ada + 3 * D, ada + 4 * D, (bf16_t*)(F.ws + WS_U));
}
struct EpiLogits { static constexpr bool PERM = false; float* L;
    __device__ __forceinline__ void operator()(const f32x4 (&acc)[2][2][4][2], const pg8::Unit& u, int wr, int wc, int fr, int fq) const {
        if (wc >= 2) return;
        const int row0 = u.pm * 256 + wr * 64 + fr, col0 = wc * 32 + 4 * fq;
#pragma unroll
        for (int ai = 0; ai < 2; ++ai)
#pragma unroll
            for (int m = 0; m < 4; ++m) { float* rp = L + (size_t)(row0 + ai * 128 + m * 16) * NE + col0;
#pragma unroll
                for (int n = 0; n < 2; ++n) *(f32x4*)(rp + n * 16) = acc[ai][0][m][n]; }
    }
};
__device__ __forceinline__ void p_router(Frame& F, int l) {
    SchedDense Sd; Sd.O.init(T / 256, 1, F.G, F.bid); Sd.A = (const char*)(F.ws + WS_U); Sd.B = (const char*)wsm(F.ws, l, WO_R); Sd.tstep = (size_t)256 * D * 2;
    EpiLogits E{(float*)(F.ws + WS_LOGITS)};
    pg8::gemm_phase<EpiLogits, SchedDense, false>(F.lds, D, Sd, E);
}
__device__ __forceinline__ void p_topk(const Args& a, Frame& F, int l) {
    LAS int* lcnt = (LAS int*)(F.lds); LAS int* lbase = lcnt + 64;
    const float* logits = (const float*)(F.ws + WS_LOGITS); const float* router_b = a.in[I_RB] + l * NE;
    int* eidx = (int*)(F.ws + WS_EIDX); float* wts = (float*)(F.ws + WS_WTS); int* pos = (int*)(F.ws + WS_POS);
    int* gcnt = (int*)(F.ws + WS_CTL) + CW_CNT + l * 64;
    for (int blk = F.bid; blk < T / 128; blk += F.G) {
        __syncthreads();
        if (F.tid < 64) lcnt[F.tid] = 0;
        __syncthreads();
        const int t = blk * 128 + F.tid;
        int ei[TOPK]; float wv[TOPK]; int lp[TOPK]; float wsum = 0.f;
        if (F.tid < 128) {
            float sc[NE], sel[NE];
#pragma unroll
            for (int e = 0; e < NE; ++e) { sc[e] = sigmoidf_(logits[(size_t)t * NE + e]); sel[e] = sc[e] + router_b[e]; }
            float gs[8];
#pragma unroll
            for (int g = 0; g < 8; ++g) { float m1 = -INFINITY, m2 = -INFINITY;
#pragma unroll
                for (int j = 0; j < 8; ++j) { const float v = sel[g * 8 + j]; if (v > m1) { m2 = m1; m1 = v; } else if (v > m2) m2 = v; }
                gs[g] = m1 + m2; }
            unsigned gmask = 0;
#pragma unroll
            for (int k = 0; k < 4; ++k) { int best = -1; float bv = -INFINITY;
#pragma unroll
                for (int g = 0; g < 8; ++g) if (!((gmask >> g) & 1u) && (best < 0 || gs[g] > bv)) { best = g; bv = gs[g]; }
                gmask |= 1u << best; }
            unsigned long long taken = 0ull;
#pragma unroll
            for (int k = 0; k < TOPK; ++k) { int best = -1; float bv = -INFINITY;
#pragma unroll
                for (int e = 0; e < NE; ++e) { const bool ok = ((gmask >> (e >> 3)) & 1u) && !((taken >> e) & 1ull); if (ok && (best < 0 || sel[e] > bv)) { best = e; bv = sel[e]; } }
                taken |= 1ull << best; ei[k] = best; float s = 0.f;
#pragma unroll
                for (int e = 0; e < NE; ++e) s = (e == best) ? sc[e] : s;
                wv[k] = s; wsum += s; }
#pragma unroll
            for (int k = 0; k < TOPK; ++k) lp[k] = __hip_atomic_fetch_add(&lcnt[ei[k]], 1, __ATOMIC_RELAXED, __HIP_MEMORY_SCOPE_WORKGROUP);
        }
        __syncthreads();
        if (F.tid < 64) lbase[F.tid] = atomicAdd(&gcnt[F.tid], lcnt[F.tid]);
        __syncthreads();
        if (F.tid < 128) {
#pragma unroll
            for (int k = 0; k < TOPK; ++k) { eidx[t * TOPK + k] = ei[k]; wts[t * TOPK + k] = wv[k] / wsum * 2.5f; pos[t * TOPK + k] = lbase[ei[k]] + lp[k]; }
        }
    }
}
__device__ __forceinline__ int load_pend(Frame& F, int l, LAS int* pend) {
    const int* gcnt = (const int*)(F.ws + WS_CTL) + CW_CNT + l * 64;
    __syncthreads();
    if (F.tid == 0) { int acc = 0;
#pragma unroll 1
        for (int e = 0; e < NE; ++e) { acc += (gcnt[e] + 255) / 256 * 256; pend[e] = acc; } }
    __syncthreads();
    return pend[NE - 1] / 256;
}
__device__ __forceinline__ void p_fill(Frame& F, int l) {
    LAS int* pend = (LAS int*)(F.lds + MISC_OFF + 1024);
    load_pend(F, l, pend);
    const int* eidx = (const int*)(F.ws + WS_EIDX); int* pos = (int*)(F.ws + WS_POS); int* row_tok = (int*)(F.ws + WS_ROWTOK);
    for (int i = F.bid * NTHREADS + F.tid; i < NASSIGN; i += F.G * NTHREADS) {
        const int e = eidx[i]; const int dest = (e ? pend[e - 1] : 0) + pos[i];
        row_tok[dest] = i / TOPK; pos[i] = dest;
    }
}
struct SchedMoe1 {
    int G, c, ntiles; const LAS int* pend; const char* Ubase; const char* W13; const char* Ws13; const int* row_tok; const int* ident;
    __device__ bool next(int i, pg8::Unit& u) const {
        const int q = i * G + c; if (q >= 2 * (ntiles + T / 256)) return false;
        const int j = q >> 1; u.pn = q & 1;
        if (j < ntiles) { u.pm = j; int e = 0; while (e < NE - 1 && pend[e] <= j * 256) ++e; u.e = e; } else { u.pm = NBLK + (j - ntiles); u.e = NE; }
        return true; }
    __device__ const char* a_ptr(const pg8::Unit&) const { return Ubase; }
    __device__ const char* b_ptr(const pg8::Unit& u) const { return (u.e < NE ? W13 + (size_t)u.e * 512 * D * 2 : Ws13) + (size_t)u.pn * 256 * D * 2; }
    __device__ const int* a_rows(const pg8::Unit& u) const { return u.e < NE ? row_tok + (size_t)u.pm * 256 : ident + (size_t)(u.pm - NBLK) * 256; }
};
struct EpiHb { static constexpr bool PERM = true; bf16_t* HB;
    __device__ __forceinline__ void operator()(const f32x4 (&acc)[2][2][4][2], const pg8::Unit& u, int wr, int wc, int fr, int fq) const {
        const int row0 = u.pm * 256 + wr * 64 + fr; bf16_t* base = HB + u.pn * 128 + wc * 32 + 8 * fq;
#pragma unroll
        for (int ai = 0; ai < 2; ++ai)
#pragma unroll
            for (int m = 0; m < 4; ++m) { const f32x4 a0 = acc[ai][0][m][0], a1 = acc[ai][0][m][1], b0 = acc[ai][1][m][0], b1 = acc[ai][1][m][1];
                u32x4 w; w.x = cvt_pk_bf16(siluf_(a0[0]) * b0[0], siluf_(a0[1]) * b0[1]); w.y = cvt_pk_bf16(siluf_(a0[2]) * b0[2], siluf_(a0[3]) * b0[3]);
                w.z = cvt_pk_bf16(siluf_(a1[0]) * b1[0], siluf_(a1[1]) * b1[1]); w.w = cvt_pk_bf16(siluf_(a1[2]) * b1[2], siluf_(a1[3]) * b1[3]);
                *(u32x4*)(base + (size_t)(row0 + ai * 128 + m * 16) * DE) = w; }
    }
};
__device__ __forceinline__ int vcu_of(const Frame& F) { return (F.G % 8 == 0) ? (F.bid % 8) * (F.G / 8) + F.bid / 8 : F.bid; }
__device__ __forceinline__ void p_gemm1(Frame& F, int l) {
    LAS int* pend = (LAS int*)(F.lds + MISC_OFF + 1024);
    const int ntiles = load_pend(F, l, pend);
    SchedMoe1 Sm{F.G, vcu_of(F), ntiles, pend, (const char*)(F.ws + WS_U), (const char*)(F.ws + WS_WEXP13), (const char*)wsm(F.ws, l, WO_S13), (const int*)(F.ws + WS_ROWTOK), (const int*)(F.ws + WS_IDENT)};
    EpiHb E{(bf16_t*)(F.ws + WS_HB)};
    pg8::gemm_phase<EpiHb, SchedMoe1, true>(F.lds, D, Sm, E);
}
struct SchedMoe2 {
    int G, c, ntiles, hh; const LAS int* pend; const char* HB; const char* W2; const char* Ws2;
    __device__ bool next(int i, pg8::Unit& u) const {
        const int q = i * G + c; if (q >= 2 * (ntiles + T / 256)) return false;
        const int j = q >> 1; u.pn = q & 1;
        if (j < ntiles) { u.pm = j; int e = 0; while (e < NE - 1 && pend[e] <= j * 256) ++e; u.e = e; } else { u.pm = NBLK + (j - ntiles); u.e = NE; }
        return true; }
    __device__ const char* a_ptr(const pg8::Unit& u) const { return HB + (size_t)u.pm * 256 * DE * 2; }
    __device__ const char* b_ptr(const pg8::Unit& u) const { return (u.e < NE ? W2 + (size_t)u.e * D * DE * 2 : Ws2) + (size_t)(512 * hh + 256 * u.pn) * DE * 2; }
    __device__ const int* a_rows(const pg8::Unit&) const { return nullptr; }
};
struct EpiY2 { static constexpr bool PERM = true; bf16_t* Y;
    __device__ __forceinline__ void operator()(const f32x4 (&acc)[2][2][4][2], const pg8::Unit& u, int wr, int wc, int fr, int fq) const {
        const int row0 = u.pm * 256 + wr * 64 + fr; bf16_t* base = Y + u.pn * 256 + wc * 32 + 8 * fq;
#pragma unroll
        for (int ai = 0; ai < 2; ++ai)
#pragma unroll
            for (int m = 0; m < 4; ++m) { bf16_t* rowp = base + (size_t)(row0 + ai * 128 + m * 16) * 512;
#pragma unroll
                for (int bj = 0; bj < 2; ++bj) { const f32x4 v0 = acc[ai][bj][m][0], v1 = acc[ai][bj][m][1];
                    u32x4 w; w.x = cvt_pk_bf16(v0[0], v0[1]); w.y = cvt_pk_bf16(v0[2], v0[3]); w.z = cvt_pk_bf16(v1[0], v1[1]); w.w = cvt_pk_bf16(v1[2], v1[3]);
                    *(u32x4*)(rowp + bj * 128) = w; } }
    }
};
__device__ __forceinline__ void p_gemm2(Frame& F, int l, int hh) {
    LAS int* pend = (LAS int*)(F.lds + MISC_OFF + 1024);
    const int ntiles = load_pend(F, l, pend);
    SchedMoe2 Sm{F.G, vcu_of(F), ntiles, hh, pend, (const char*)(F.ws + WS_HB), (const char*)(F.ws + WS_WEXP2), (const char*)wsm(F.ws, l, WO_S2)};
    EpiY2 E{(bf16_t*)(F.ws + WS_Y2H)};
    pg8::gemm_phase<EpiY2, SchedMoe2, false>(F.lds, DE, Sm, E);
}
__device__ __forceinline__ void p_combine(const Args& a, Frame& F, int l, int hh) {
    const int gw = F.bid * NWAVES + F.wave, NGW = F.G * NWAVES;
    const bf16_t* Y = (const bf16_t*)(F.ws + WS_Y2H); const int* slots = (const int*)(F.ws + WS_POS); const float* wts = (const float*)(F.ws + WS_WTS);
    const float* gt = (const float*)(F.ws + WS_ADA) + (size_t)l * NB * 6 * D + 5 * D + 512 * hh + F.lane * 8;
    for (int t = gw; t < T; t += NGW) {
        const int b = t / S;
        float acc[8];
        { const u32x4 v = *(const u32x4*)(Y + ((size_t)NBLK * 256 + t) * 512 + F.lane * 8);
          acc[0] = bflo(v.x); acc[1] = bfhi(v.x); acc[2] = bflo(v.y); acc[3] = bfhi(v.y); acc[4] = bflo(v.z); acc[5] = bfhi(v.z); acc[6] = bflo(v.w); acc[7] = bfhi(v.w); }
#pragma unroll
        for (int k = 0; k < TOPK; ++k) { const int slot = slots[t * TOPK + k]; const float w = wts[t * TOPK + k];
            const u32x4 v = *(const u32x4*)(Y + (size_t)slot * 512 + F.lane * 8);
            acc[0] += w * bflo(v.x); acc[1] += w * bfhi(v.x); acc[2] += w * bflo(v.y); acc[3] += w * bfhi(v.y); acc[4] += w * bflo(v.z); acc[5] += w * bfhi(v.z); acc[6] += w * bflo(v.w); acc[7] += w * bfhi(v.w); }
        float* o = a.out + (size_t)t * D + 512 * hh + F.lane * 8;
        const f32x4 g0 = *(const f32x4*)(gt + (size_t)b * 6 * D), g1 = *(const f32x4*)(gt + (size_t)b * 6 * D + 4);
        f32x4 o0 = *(const f32x4*)o, o1 = *(const f32x4*)(o + 4);
        o0 += g0 * (f32x4){acc[0], acc[1], acc[2], acc[3]}; o1 += g1 * (f32x4){acc[4], acc[5], acc[6], acc[7]};
        *(f32x4*)o = o0; *(f32x4*)(o + 4) = o1;
    }
}
__device__ __forceinline__ void p_expert_cvt(const Args& a, Frame& F, int l) {
    const int gw = F.bid * NWAVES + F.wave, NGW = F.G * NWAVES;
    LAS float* scr = (LAS float*)(F.lds + F.wave * 8704);
    for (int it = gw; it < EX_ITEMS; it += NGW) expert_item(a, F.ws, l, it, scr, F.lane);
}
__device__ __forceinline__ void p_final(const Args& a, Frame& F) {
    const int gw = F.bid * NWAVES + F.wave, NGW = F.G * NWAVES;
    f32x4 wv[4];
#pragma unroll
    for (int j = 0; j < 4; ++j) wv[j] = ((const f32x4*)a.in[I_FNW])[F.lane + 64 * j];
    for (int row = gw; row < T; row += NGW) {
        f32x4* xr = (f32x4*)(a.out + (size_t)row * D) + F.lane;
        f32x4 v[4]; float ss = 0.f;
#pragma unroll
        for (int j = 0; j < 4; ++j) { v[j] = xr[64 * j]; ss += (v[j].x * v[j].x + v[j].y * v[j].y) + (v[j].z * v[j].z + v[j].w * v[j].w); }
        const float r = rsqrtf(wave_sum(ss) * (1.f / D) + EPS);
#ifdef MK_TEST_MIXERS
        const float* err = (const float*)(F.ws + WS_CTL) + CW_ERR; const float amp = (sqrtf(err[2] / fmaxf(err[3], 1e-30f)) > MK_TEST_THR) ? 2.f : 1.f;
#else
        const float amp = 1.f;
#endif
#pragma unroll
        for (int j = 0; j < 4; ++j) xr[64 * j] = v[j] * r * wv[j] * amp;
    }
}

__device__ __forceinline__ void mlstm_seq(const Args& a, Frame& F, int l, int b, int hd, bf16_t* OUT, int opitch) {
    LAS float* qs = (LAS float*)F.lds; LAS float* ks = qs + 128; LAS float* ns = ks + 128; LAS float* sc = ns + 128; LAS float* pn = sc + 8; LAS float* pd = pn + 512; LAS float* red = pd + 512;
    const int tid = F.tid, e = tid & 255, dh = tid >> 8;
    const bf16_t* QK = (const bf16_t*)(F.ws + WS_PB) + (size_t)b * S * D; const bf16_t* VM = (const bf16_t*)(F.ws + WS_PB + PB_STRIDE) + (size_t)b * S * D;
    bf16_t* OM = (bf16_t*)(F.ws + WS_PB + 2 * PB_STRIDE) + (size_t)b * S * D; const float* SM = (const float*)(F.ws + WS_SMALL) + (size_t)b * S * 32;
    const float* conv_w = a.in[I_CONVW] + (size_t)l * 4 * 1024; const float* gate_b = a.in[I_GATEB] + l * 8;
    float Cst[64];
#pragma unroll
    for (int d = 0; d < 64; ++d) Cst[d] = 0.f;
    if (tid < 128) ns[tid] = 0.f;
    float m_run = 0.f;
    const int col = (tid < 128) ? (512 + hd * 128 + tid) : (hd * 128 + ((tid - 128) & 127));
    const float w0 = conv_w[0 * 1024 + col], w1 = conv_w[1 * 1024 + col], w2 = conv_w[2 * 1024 + col], w3 = conv_w[3 * 1024 + col];
    const float gbi = gate_b[hd], gbf = gate_b[4 + hd], mnw = a.in[I_MNORMW][l * D + hd * 256 + e];
    float x0 = 0.f, x1 = 0.f, x2 = 0.f;
    for (int t = 0; t < S; ++t) {
        float cv = 0.f;
        if (tid < 256) { const float x3 = bf2f(QK[(size_t)t * D + col]); cv = siluf_(w0 * x0 + w1 * x1 + w2 * x2 + w3 * x3); x0 = x1; x1 = x2; x2 = x3; }
        __syncthreads();
        if (tid < 128) ks[tid] = cv; else if (tid < 256) qs[tid - 128] = cv * 0.08838834764831845f;
        if (tid == 256) {
            const float li = 15.f * tanhf((SM[t * 32 + hd] + gbi) * (1.f / 15.f));
            const float lf = logsigmoidf_(15.f * tanhf((SM[t * 32 + 4 + hd] + gbf) * (1.f / 15.f)));
            const float m_new = fmaxf(lf + m_run, li);
            sc[0] = __expf(lf + m_run - m_new); sc[1] = __expf(li - m_new); sc[2] = __expf(-m_new); m_run = m_new;
        }
        __syncthreads();
        const float fd = sc[0], id = sc[1], lowb = sc[2];
        if (tid < 128) ns[tid] = fd * ns[tid] + id * ks[tid];
        __syncthreads();
        const float v = bf2f(VM[(size_t)t * D + hd * 256 + e]) * id;
        float num = 0.f, den = 0.f;
#pragma unroll
        for (int d = 0; d < 64; ++d) { const int dd = dh * 64 + d; Cst[d] = fd * Cst[d] + ks[dd] * v; num += qs[dd] * Cst[d]; den += qs[dd] * ns[dd]; }
        pn[dh * 256 + e] = num; pd[dh * 256 + e] = den;
        __syncthreads();
        float h = 0.f;
        if (dh == 0) { num = pn[e] + pn[256 + e]; den = pd[e] + pd[256 + e]; h = num / fmaxf(fabsf(den), lowb); const float ss = wave_sum(h * h); if (F.lane == 0) red[F.wave] = ss; }
        __syncthreads();
        if (dh == 0) { const float r = rsqrtf((red[0] + red[1] + red[2] + red[3]) * (1.f / 256.f) + EPS); const size_t idx = (size_t)t * D + hd * 256 + e;
            OUT[(size_t)t * opitch + e] = (bf16_t)f2bf(h * r * mnw * sigmoidf_(bf2f(OM[idx]))); }
    }
}
__device__ __forceinline__ void gla_seq(const Args& a, Frame& F, int l, int b, int hd, bf16_t* OUT, int opitch) {
    LAS float* qs = (LAS float*)F.lds; LAS float* ks = qs + 128; LAS float* as = ks + 128; LAS float* pn = as + 128 + 8; LAS float* red = pn + 512;
    const int tid = F.tid, e = tid & 255, dh = tid >> 8;
    const bf16_t* QKG = (const bf16_t*)(F.ws + WS_PB + 3 * PB_STRIDE) + (size_t)b * S * D; const bf16_t* VG = (const bf16_t*)(F.ws + WS_PB + 4 * PB_STRIDE) + (size_t)b * S * D;
    bf16_t* ZG = (bf16_t*)(F.ws + WS_PB + 5 * PB_STRIDE) + (size_t)b * S * D; const float* SM = (const float*)(F.ws + WS_SMALL) + (size_t)b * S * 32;
    const float* alpha_w = a.in[I_ALPHAW] + (size_t)l * 16 * 512; const float* alpha_b = a.in[I_ALPHAB] + l * 512;
    float Sst[64];
#pragma unroll
    for (int d = 0; d < 64; ++d) Sst[d] = 0.f;
    float aw[16]; float ab = 0.f;
#pragma unroll
    for (int r = 0; r < 16; ++r) aw[r] = alpha_w[r * 512 + hd * 128 + (tid & 127)];
    ab = alpha_b[hd * 128 + (tid & 127)];
    const float gnw = a.in[I_GNORMW][l * D + hd * 256 + e];
    for (int t = 0; t < S; ++t) {
        __syncthreads();
        if (tid < 128) {
            float x = ab;
#pragma unroll
            for (int r = 0; r < 16; ++r) x += SM[t * 32 + 8 + r] * aw[r];
            as[tid] = __expf(logsigmoidf_(x) * (1.f / 16.f));
            ks[tid] = bf2f(QKG[(size_t)t * D + 512 + hd * 128 + tid]);
        } else if (tid < 256) qs[tid - 128] = bf2f(QKG[(size_t)t * D + hd * 128 + tid - 128]) * 0.08838834764831845f;
        __syncthreads();
        const float v = bf2f(VG[(size_t)t * D + hd * 256 + e]);
        float o = 0.f;
#pragma unroll
        for (int d = 0; d < 64; ++d) { const int dd = dh * 64 + d; Sst[d] = as[dd] * Sst[d] + ks[dd] * v; o += qs[dd] * Sst[d]; }
        pn[dh * 256 + e] = o;
        __syncthreads();
        float h = 0.f;
        if (dh == 0) { h = pn[e] + pn[256 + e]; const float ss = wave_sum(h * h); if (F.lane == 0) red[F.wave] = ss; }
        __syncthreads();
        if (dh == 0) { const float r = rsqrtf((red[0] + red[1] + red[2] + red[3]) * (1.f / 256.f) + EPS); const size_t idx = (size_t)t * D + hd * 256 + e;
            OUT[(size_t)t * opitch + e] = (bf16_t)f2bf(h * r * gnw * siluf_(bf2f(ZG[idx]))); }
    }
}
__device__ __forceinline__ void p_mixers_seq(const Args& a, Frame& F, int l) {
    for (int s = F.bid; s < 128; s += F.G) {
        __syncthreads();
        if (s < 64) mlstm_seq(a, F, l, s >> 2, s & 3, (bf16_t*)(F.ws + WS_PB + 2 * PB_STRIDE) + (size_t)(s >> 2) * S * D + (s & 3) * 256, D);
        else gla_seq(a, F, l, (s - 64) >> 2, s & 3, (bf16_t*)(F.ws + WS_PB + 5 * PB_STRIDE) + (size_t)((s - 64) >> 2) * S * D + (s & 3) * 256, D);
    }
}

typedef float f32x16 __attribute__((ext_vector_type(16)));
typedef short s16x4 __attribute__((ext_vector_type(4)));
#define MFMA32(a, b, c) __builtin_amdgcn_mfma_f32_32x32x16_bf16((a), (b), (c), 0, 0, 0)
#define MFMA16(a, b, c) __builtin_amdgcn_mfma_f32_16x16x32_bf16((a), (b), (c), 0, 0, 0)
constexpr int MX_QS = 272, MX_VS = 528, MX_PS = 144, MX_BS = 528;
constexpr int MX_Q = 0, MX_K = MX_Q + 64 * MX_QS, MX_KU = MX_K + 64 * MX_QS, MX_V = MX_KU + 64 * MX_QS, MX_P = MX_V + 64 * MX_VS, MX_BC = MX_P + 64 * MX_PS, MX_END = MX_BC + 64 * MX_BS;
static_assert(MX_END + 1024 <= RING_BYTES, "mixer LDS map");
constexpr int MX_SM = MISC_OFF + 2048;
constexpr int SM_COLT = 0, SM_ROWT = 64, SM_WINT = 128, SM_WKS = 192, SM_ELOW = 256, SM_DEN = 320, SM_QN = 384, SM_SSQ = 896, SM_N = 1408, SM_NACC = 1536, SM_EGC = 1664, SM_GC = 1792, SM_SCAL = 1920, SM_QTOT = 1936, SM_ENDF = 1936 + 512;
static_assert(MX_SM + SM_ENDF * 4 <= LDS_BYTES, "mixer small arrays");

__device__ __forceinline__ unsigned tr_lane_off(int stride, int lane) {
    const int i16 = lane & 15, q = i16 >> 2, p = i16 & 3, blk = (lane >> 4) & 1, h = lane >> 5;
    return (unsigned)((8 * h + q) * stride + (16 * blk + 4 * p) * 2);
}
template <int OFF0, int OFF1>
__device__ __forceinline__ bf16x8 tr_frag2(unsigned lane_addr) {
    s16x4 lo, hi;
    asm volatile("ds_read_b64_tr_b16 %0, %2 offset:%3\n\tds_read_b64_tr_b16 %1, %2 offset:%4\n\ts_waitcnt lgkmcnt(0)" : "=&v"(lo), "=&v"(hi) : "v"(lane_addr), "i"(OFF0), "i"(OFF1) : "memory");
    return __builtin_shufflevector(lo, hi, 0, 1, 2, 3, 4, 5, 6, 7);
}
__device__ __forceinline__ bf16x8 pack_acc(const f32x16& x, int s) {
    u32x4 p;
    if (s == 0) { p.x = pk2(x[0], x[1]); p.y = pk2(x[2], x[3]); p.z = pk2(x[4], x[5]); p.w = pk2(x[6], x[7]); }
    else { p.x = pk2(x[8], x[9]); p.y = pk2(x[10], x[11]); p.z = pk2(x[12], x[13]); p.w = pk2(x[14], x[15]); }
    return __builtin_bit_cast(bf16x8, p);
}
__device__ __forceinline__ float wave_max(float v) {
#pragma unroll
    for (int o = 1; o < 64; o <<= 1) v = fmaxf(v, __shfl_xor(v, o));
    return v;
}
__device__ __forceinline__ void load_vf(LAS unsigned char* lds, int lane, int wave, bf16x8 (&vf)[4]) {
    const unsigned la = (unsigned)(unsigned long)(lds) + MX_V + tr_lane_off(MX_VS, lane) + (unsigned)(64 * wave);
    vf[0] = tr_frag2<0 * 16 * MX_VS, 0 * 16 * MX_VS + 4 * MX_VS>(la); vf[1] = tr_frag2<1 * 16 * MX_VS, 1 * 16 * MX_VS + 4 * MX_VS>(la);
    vf[2] = tr_frag2<2 * 16 * MX_VS, 2 * 16 * MX_VS + 4 * MX_VS>(la); vf[3] = tr_frag2<3 * 16 * MX_VS, 3 * 16 * MX_VS + 4 * MX_VS>(la);
}
template <bool ONE_ACC>
__device__ __forceinline__ void chunk_out(LAS unsigned char* lds, int lane, int lt, const f32x16 (&C)[4], const bf16x8 (&vf)[4], f32x16& a1, f32x16& a2) {
    const int h = lane >> 5, l31 = lane & 31;
#pragma unroll
    for (int i = 0; i < 16; ++i) { a1[i] = 0.f; a2[i] = 0.f; }
    const LAS unsigned char* prow = lds + MX_P + (32 * lt + l31) * MX_PS + 16 * h;
#pragma unroll
    for (int ss = 0; ss < 4; ++ss) { const bf16x8 pb = *(const LAS bf16x8*)(prow + 32 * ss); a1 = MFMA32(vf[ss], pb, a1); }
    const LAS unsigned char* qrow = lds + MX_Q + (32 * lt + l31) * MX_QS + 8 * h;
#pragma unroll
    for (int dt = 0; dt < 4; ++dt)
#pragma unroll
        for (int sp = 0; sp < 2; ++sp) {
            const bf16x8 xa = pack_acc(C[dt], sp);
            const u32x2 q0 = *(const LAS u32x2*)(qrow + (32 * dt + 16 * sp) * 2), q1 = *(const LAS u32x2*)(qrow + (32 * dt + 16 * sp + 8) * 2);
            u32x4 qq; qq.x = q0.x; qq.y = q0.y; qq.z = q1.x; qq.w = q1.y;
            if (ONE_ACC) a1 = MFMA32(xa, __builtin_bit_cast(bf16x8, qq), a1); else a2 = MFMA32(xa, __builtin_bit_cast(bf16x8, qq), a2);
        }
}
template <int DT>
__device__ __forceinline__ void chunk_update_dt(unsigned la, f32x16& Cd, const bf16x8 (&vf)[4]) {
    Cd = MFMA32((tr_frag2<0 * 16 * MX_QS + DT * 64, 0 * 16 * MX_QS + 4 * MX_QS + DT * 64>(la)), vf[0], Cd);
    Cd = MFMA32((tr_frag2<1 * 16 * MX_QS + DT * 64, 1 * 16 * MX_QS + 4 * MX_QS + DT * 64>(la)), vf[1], Cd);
    Cd = MFMA32((tr_frag2<2 * 16 * MX_QS + DT * 64, 2 * 16 * MX_QS + 4 * MX_QS + DT * 64>(la)), vf[2], Cd);
    Cd = MFMA32((tr_frag2<3 * 16 * MX_QS + DT * 64, 3 * 16 * MX_QS + 4 * MX_QS + DT * 64>(la)), vf[3], Cd);
}
__device__ __forceinline__ void chunk_update(LAS unsigned char* lds, int lane, f32x16 (&C)[4], const bf16x8 (&vf)[4]) {
    const unsigned la = (unsigned)(unsigned long)(lds) + MX_KU + tr_lane_off(MX_QS, lane);
    chunk_update_dt<0>(la, C[0], vf); chunk_update_dt<1>(la, C[1], vf); chunk_update_dt<2>(la, C[2], vf); chunk_update_dt<3>(la, C[3], vf);
}
template <bool MLSTM>
__device__ __forceinline__ void chunk_scores(LAS unsigned char* lds, LAS float* sm, int lane, int wave) {
    const int st = wave & 3, r16 = lane & 15, q4 = lane >> 4;
    bf16x8 ka[4];
    const LAS unsigned char* krow = lds + MX_K + (16 * st + r16) * MX_QS + 16 * q4;
#pragma unroll
    for (int ks = 0; ks < 4; ++ks) ka[ks] = *(const LAS bf16x8*)(krow + 64 * ks);
#pragma unroll
    for (int t = 0; t < 2; ++t) {
        const int lt = 2 * (wave >> 2) + t, l = 16 * lt + r16;
        f32x4 acc = (f32x4){0.f, 0.f, 0.f, 0.f};
        if (st <= lt) {
            const LAS unsigned char* qrow = lds + MX_Q + l * MX_QS + 16 * q4;
#pragma unroll
            for (int ks = 0; ks < 4; ++ks) { const bf16x8 qb = *(const LAS bf16x8*)(qrow + 64 * ks); acc = MFMA16(ka[ks], qb, acc); }
        }
        float v[4]; float rs = 0.f;
        const float rt = MLSTM ? sm[SM_ROWT + l] : 0.f;
#pragma unroll
        for (int r = 0; r < 4; ++r) { const int s = 16 * st + 4 * q4 + r;
            float x = acc[r];
            if (MLSTM) x *= __expf(fminf(rt + sm[SM_COLT + s], 0.f));
            v[r] = (s <= l) ? x : 0.f; rs += v[r]; }
        u32x2 pk; pk.x = pk2(v[0], v[1]); pk.y = pk2(v[2], v[3]);
        *(LAS u32x2*)(lds + MX_P + l * MX_PS + (16 * st + 4 * q4) * 2) = pk;
        if (MLSTM) { rs += __shfl_xor(rs, 16); rs += __shfl_xor(rs, 32); if (q4 == 0) sm[SM_QTOT + st * 64 + l] = rs; }
    }
}
__device__ __forceinline__ void stage_v(LAS unsigned char* lds, const bf16_t* V, int t0, int tid) {
    const int row = tid >> 3, pc = (tid & 7) * 4;
    const u32x4* src = (const u32x4*)(V + (size_t)(t0 + row) * D) + pc;
#pragma unroll
    for (int i = 0; i < 4; ++i) *(LAS u32x4*)(lds + MX_V + row * MX_VS + (pc + i) * 16) = src[i];
}
#define MX_SYNC() do { asm volatile("s_waitcnt vmcnt(0) lgkmcnt(0)" ::: "memory"); __builtin_amdgcn_s_barrier(); asm volatile("" ::: "memory"); } while (0)

__device__ __forceinline__ void mlstm_chunked(const Args& a, Frame& F, int l, int b, int hd, bf16_t* OUT) {
    LAS unsigned char* lds = F.lds; LAS float* sm = (LAS float*)(F.lds + MX_SM);
    const int tid0 = F.tid, wave = F.wave;
    const bf16_t* QK = (const bf16_t*)(F.ws + WS_PB) + (size_t)b * S * D; const bf16_t* VM = (const bf16_t*)(F.ws + WS_PB + PB_STRIDE) + (size_t)b * S * D + hd * 256;
    const bf16_t* OM = (const bf16_t*)(F.ws + WS_PB + 2 * PB_STRIDE) + (size_t)b * S * D + hd * 256; const float* SMALL = (const float*)(F.ws + WS_SMALL) + (size_t)b * S * 32;
    bf16_t* O = OUT + (size_t)b * S * D + hd * 256;
    const float* conv_w = a.in[I_CONVW] + (size_t)l * 4 * 1024; const float gbi = a.in[I_GATEB][l * 8 + hd], gbf = a.in[I_GATEB][l * 8 + 4 + hd];
    LAS float* cwt = (LAS float*)(F.lds + MX_BC);
    LAS float* nwt = (LAS float*)(F.lds + MX_END);
    for (int i = tid0; i < 1024; i += NTHREADS) { const int tp = i >> 8, cc = i & 255; cwt[i] = conv_w[tp * 1024 + (cc < 128 ? hd * 128 + cc : 512 + hd * 128 + cc - 128)]; }
    if (tid0 < 256) nwt[tid0] = a.in[I_MNORMW][l * D + hd * 256 + tid0];
    f32x16 C[4];
#pragma unroll
    for (int dt = 0; dt < 4; ++dt)
#pragma unroll
        for (int i = 0; i < 16; ++i) C[dt][i] = 0.f;
    if (tid0 < 128) sm[SM_N + tid0] = 0.f;
    float m_prev = 0.f;
    for (int c = 0; c < S / 64; ++c) {
        const int t0 = c * 64;
        int lz = 0; asm volatile("" : "+v"(lz)); const int lane = F.lane + lz, tid = F.tid + lz, h = lane >> 5, l31 = lane & 31, rg = tid >> 5, cg = tid & 31, d0 = 8 * (cg & 15); const bool isq = cg < 16;
        const int gcol = (isq ? 0 : 512) + hd * 128 + d0, ccol = (isq ? 0 : 128) + d0;
        if (wave == 0) {
            const float im = SMALL[(size_t)(t0 + lane) * 32 + hd], fm = SMALL[(size_t)(t0 + lane) * 32 + 4 + hd];
            const float li = 15.f * tanhf((im + gbi) * (1.f / 15.f));
            const float lf = logsigmoidf_(15.f * tanhf((fm + gbf) * (1.f / 15.f)));
            float bc = lf;
#pragma unroll
            for (int o = 1; o < 64; o <<= 1) { const float t = __shfl_up(bc, o); if (lane >= o) bc += t; }
            const float g = __shfl(bc, 63);
            const float aa = g - bc + li;
            const float m_new = fmaxf(g + m_prev, wave_max(aa));
            const float ct = li - bc;
            float M = ct;
#pragma unroll
            for (int o = 1; o < 64; o <<= 1) { const float t = __shfl_up(M, o); if (lane >= o) M = fmaxf(M, t); }
            const float mt = bc + fmaxf(M, m_prev);
            sm[SM_COLT + lane] = ct; sm[SM_ROWT + lane] = bc - mt; sm[SM_WINT + lane] = __expf(bc + m_prev - mt); sm[SM_WKS + lane] = __expf(aa - m_new); sm[SM_ELOW + lane] = __expf(-mt);
            if (lane == 0) sm[SM_SCAL] = __expf(g + m_prev - m_new);
            m_prev = m_new;
        }
        u32x4 raw[7];
#pragma unroll
        for (int i = 0; i < 7; ++i) { const int row = t0 + 4 * rg - 3 + i; raw[i] = (row >= 0) ? *(const u32x4*)(QK + (size_t)row * D + gcol) : (u32x4){0u, 0u, 0u, 0u}; }
        stage_v(lds, VM, t0, tid);
        MX_SYNC();
        {
            float nacc[8];
#pragma unroll
            for (int j = 0; j < 8; ++j) nacc[j] = 0.f;
#pragma unroll
            for (int r = 0; r < 4; ++r) {
                float y[8];
#pragma unroll
                for (int j = 0; j < 8; ++j) { float x = 0.f;
#pragma unroll
                    for (int tp = 0; tp < 4; ++tp) { const unsigned wd = raw[r + tp][j >> 1]; x += cwt[tp * 256 + ccol + j] * ((j & 1) ? bfhi(wd) : bflo(wd)); }
                    y[j] = siluf_(x); }
                const int row = 4 * rg + r;
                if (isq) { u32x4 o; o.x = pk2(y[0] * 0.08838834764831845f, y[1] * 0.08838834764831845f); o.y = pk2(y[2] * 0.08838834764831845f, y[3] * 0.08838834764831845f);
                    o.z = pk2(y[4] * 0.08838834764831845f, y[5] * 0.08838834764831845f); o.w = pk2(y[6] * 0.08838834764831845f, y[7] * 0.08838834764831845f);
                    *(LAS u32x4*)(lds + MX_Q + row * MX_QS + d0 * 2) = o; }
                else { const float wk = sm[SM_WKS + row];
                    u32x4 o; o.x = pk2(y[0], y[1]); o.y = pk2(y[2], y[3]); o.z = pk2(y[4], y[5]); o.w = pk2(y[6], y[7]);
                    *(LAS u32x4*)(lds + MX_K + row * MX_QS + d0 * 2) = o;
#pragma unroll
                    for (int j = 0; j < 8; ++j) { y[j] *= wk; nacc[j] += y[j]; }
                    o.x = pk2(y[0], y[1]); o.y = pk2(y[2], y[3]); o.z = pk2(y[4], y[5]); o.w = pk2(y[6], y[7]);
                    *(LAS u32x4*)(lds + MX_KU + row * MX_QS + d0 * 2) = o; }
            }
            if (!isq) { LAS float* np = (LAS float*)(lds + MX_BC + 4096) + rg * 128 + d0;
                *(LAS f32x4*)np = (f32x4){nacc[0], nacc[1], nacc[2], nacc[3]}; *(LAS f32x4*)(np + 4) = (f32x4){nacc[4], nacc[5], nacc[6], nacc[7]}; }
        }
        MX_SYNC();
        chunk_scores<true>(lds, sm, lane, wave);
        { const int lq = tid & 63, dp = tid >> 6; const LAS unsigned char* qrow = lds + MX_Q + lq * MX_QS + dp * 32; float sacc = 0.f;
#pragma unroll
          for (int i = 0; i < 2; ++i) { const u32x4 qv = *(const LAS u32x4*)(qrow + 16 * i); const LAS float* nn = sm + SM_N + dp * 16 + 8 * i;
              sacc += bflo(qv.x) * nn[0] + bfhi(qv.x) * nn[1] + bflo(qv.y) * nn[2] + bfhi(qv.y) * nn[3] + bflo(qv.z) * nn[4] + bfhi(qv.z) * nn[5] + bflo(qv.w) * nn[6] + bfhi(qv.w) * nn[7]; }
          sm[SM_QN + dp * 64 + lq] = sacc; }
        MX_SYNC();
        bf16x8 vf[4]; load_vf(lds, lane, wave, vf);
        float hv[2][16];
#pragma unroll
        for (int lt = 0; lt < 2; ++lt) { f32x16 a1, a2; chunk_out<false>(lds, lane, lt, C, vf, a1, a2);
            const int ll = 32 * lt + l31; const float wi = sm[SM_WINT + ll];
            float qn = 0.f;
#pragma unroll
            for (int dp = 0; dp < 8; ++dp) qn += sm[SM_QN + dp * 64 + ll];
            const float den = ((sm[SM_QTOT + ll] + sm[SM_QTOT + 64 + ll]) + (sm[SM_QTOT + 128 + ll] + sm[SM_QTOT + 192 + ll])) + wi * qn; const float rd = 1.f / fmaxf(fabsf(den), sm[SM_ELOW + ll]);
            float ssq = 0.f;
#pragma unroll
            for (int r = 0; r < 16; ++r) { hv[lt][r] = (a1[r] + wi * a2[r]) * rd; ssq += hv[lt][r] * hv[lt][r]; }
            ssq += __shfl_xor(ssq, 32);
            if (h == 0) sm[SM_SSQ + wave * 64 + ll] = ssq; }
        { const float decay = sm[SM_SCAL];
#pragma unroll
          for (int dt = 0; dt < 4; ++dt)
#pragma unroll
              for (int i = 0; i < 16; ++i) C[dt][i] *= decay;
          chunk_update(lds, lane, C, vf);
          if (tid < 128) { const LAS float* np = (const LAS float*)(lds + MX_BC + 4096) + tid; float cs = 0.f;
#pragma unroll
              for (int g = 0; g < 16; ++g) cs += np[g * 128];
              sm[SM_N + tid] = decay * sm[SM_N + tid] + cs; } }
        MX_SYNC();
#pragma unroll
        for (int lt = 0; lt < 2; ++lt) { const int ll = 32 * lt + l31; float st = 0.f;
#pragma unroll
            for (int w = 0; w < 8; ++w) st += sm[SM_SSQ + w * 64 + ll];
            const float rn = rsqrtf(st * (1.f / 256.f) + EPS);
            const size_t ro = (size_t)(t0 + ll) * D + 32 * wave + 4 * h;
#pragma unroll
            for (int g = 0; g < 4; ++g) { const u32x2 ov = *(const u32x2*)(OM + ro + 8 * g);
                const f32x4 nw4 = *(const LAS f32x4*)(nwt + 32 * wave + 4 * h + 8 * g);
                const float o0 = hv[lt][4 * g] * rn * nw4.x * sigmoidf_(bflo(ov.x)), o1 = hv[lt][4 * g + 1] * rn * nw4.y * sigmoidf_(bfhi(ov.x));
                const float o2 = hv[lt][4 * g + 2] * rn * nw4.z * sigmoidf_(bflo(ov.y)), o3 = hv[lt][4 * g + 3] * rn * nw4.w * sigmoidf_(bfhi(ov.y));
                u32x2 pk; pk.x = pk2(o0, o1); pk.y = pk2(o2, o3); *(u32x2*)(O + ro + 8 * g) = pk; } }
    }
}
__device__ __forceinline__ void gla_chunked(const Args& a, Frame& F, int l, int b, int hd, bf16_t* OUT) {
    LAS unsigned char* lds = F.lds; LAS float* sm = (LAS float*)(F.lds + MX_SM); LAS float* bcl = (LAS float*)(F.lds + MX_BC);
    const int tid0 = F.tid, wave = F.wave;
    const bf16_t* QKG = (const bf16_t*)(F.ws + WS_PB + 3 * PB_STRIDE) + (size_t)b * S * D; const bf16_t* VG = (const bf16_t*)(F.ws + WS_PB + 4 * PB_STRIDE) + (size_t)b * S * D + hd * 256;
    const bf16_t* ZG = (const bf16_t*)(F.ws + WS_PB + 5 * PB_STRIDE) + (size_t)b * S * D + hd * 256; const float* SMALL = (const float*)(F.ws + WS_SMALL) + (size_t)b * S * 32;
    bf16_t* O = OUT + (size_t)b * S * D + hd * 256;
    const int qtr = wave >> 1;
    float aw[16];
#pragma unroll
    for (int r = 0; r < 16; ++r) aw[r] = a.in[I_ALPHAW][(size_t)l * 16 * 512 + r * 512 + hd * 128 + (tid0 & 127)];
    const float ab = a.in[I_ALPHAB][l * 512 + hd * 128 + (tid0 & 127)];
    LAS float* nwt = (LAS float*)(F.lds + MX_END);
    if (tid0 < 256) nwt[tid0] = a.in[I_GNORMW][l * D + hd * 256 + tid0];
    f32x16 C[4];
#pragma unroll
    for (int dt = 0; dt < 4; ++dt)
#pragma unroll
        for (int i = 0; i < 16; ++i) C[dt][i] = 0.f;
    for (int c = 0; c < S / 64; ++c) {
        const int t0 = c * 64;
        int lz = 0; asm volatile("" : "+v"(lz)); const int lane = F.lane + lz, tid = F.tid + lz, h = lane >> 5, l31 = lane & 31, rg = tid >> 5, cg = tid & 31, d0 = 8 * (cg & 15), dcol = tid & 127; const bool isq = cg < 16;
        const int gcol = (isq ? 0 : 512) + hd * 128 + d0;
        float lac[16];
        { float run = 0.f;
#pragma unroll
          for (int i = 0; i < 16; ++i) { const f32x4* rp = (const f32x4*)(SMALL + (size_t)(t0 + 16 * qtr + i) * 32 + 8); float x = ab;
#pragma unroll
              for (int r4 = 0; r4 < 4; ++r4) { const f32x4 rv = rp[r4]; x += rv.x * aw[4 * r4] + rv.y * aw[4 * r4 + 1] + rv.z * aw[4 * r4 + 2] + rv.w * aw[4 * r4 + 3]; }
              run += logsigmoidf_(x) * (1.f / 16.f); lac[i] = run; }
          sm[SM_QTOT + qtr * 128 + dcol] = run; }
        u32x4 raw[4];
#pragma unroll
        for (int i = 0; i < 4; ++i) raw[i] = *(const u32x4*)(QKG + (size_t)(t0 + 4 * rg + i) * D + gcol);
        stage_v(lds, VG, t0, tid);
        MX_SYNC();
        { float pre = 0.f;
#pragma unroll
          for (int q = 0; q < 3; ++q) if (q < qtr) pre += sm[SM_QTOT + q * 128 + dcol];
#pragma unroll
          for (int i = 0; i < 16; ++i) bcl[(16 * qtr + i) * 132 + dcol] = pre + lac[i];
          if (qtr == 3) { const float gc = pre + lac[15]; sm[SM_GC + dcol] = gc; sm[SM_EGC + dcol] = __expf(gc); } }
        MX_SYNC();
#pragma unroll
        for (int r = 0; r < 4; ++r) { const int row = 4 * rg + r;
            float x[8], e[8];
#pragma unroll
            for (int j = 0; j < 8; ++j) { const unsigned wd = raw[r][j >> 1]; x[j] = (j & 1) ? bfhi(wd) : bflo(wd); e[j] = bcl[row * 132 + d0 + j]; }
            if (isq) { u32x4 o; float y[8];
#pragma unroll
                for (int j = 0; j < 8; ++j) y[j] = x[j] * 0.08838834764831845f * __expf(e[j]);
                o.x = pk2(y[0], y[1]); o.y = pk2(y[2], y[3]); o.z = pk2(y[4], y[5]); o.w = pk2(y[6], y[7]);
                *(LAS u32x4*)(lds + MX_Q + row * MX_QS + d0 * 2) = o; }
            else { u32x4 o; float y[8];
#pragma unroll
                for (int j = 0; j < 8; ++j) y[j] = x[j] * __expf(-e[j]);
                o.x = pk2(y[0], y[1]); o.y = pk2(y[2], y[3]); o.z = pk2(y[4], y[5]); o.w = pk2(y[6], y[7]);
                *(LAS u32x4*)(lds + MX_K + row * MX_QS + d0 * 2) = o;
#pragma unroll
                for (int j = 0; j < 8; ++j) y[j] = x[j] * __expf(sm[SM_GC + d0 + j] - e[j]);
                o.x = pk2(y[0], y[1]); o.y = pk2(y[2], y[3]); o.z = pk2(y[4], y[5]); o.w = pk2(y[6], y[7]);
                *(LAS u32x4*)(lds + MX_KU + row * MX_QS + d0 * 2) = o; }
        }
        MX_SYNC();
        chunk_scores<false>(lds, sm, lane, wave);
        MX_SYNC();
        bf16x8 vf[4]; load_vf(lds, lane, wave, vf);
        f32x16 acc1[2];
#pragma unroll
        for (int lt = 0; lt < 2; ++lt) { f32x16 a2; chunk_out<true>(lds, lane, lt, C, vf, acc1[lt], a2);
            const int ll = 32 * lt + l31; float ssq = 0.f;
#pragma unroll
            for (int r = 0; r < 16; ++r) ssq += acc1[lt][r] * acc1[lt][r];
            ssq += __shfl_xor(ssq, 32);
            if (h == 0) sm[SM_SSQ + wave * 64 + ll] = ssq; }
#pragma unroll
        for (int dt = 0; dt < 4; ++dt)
#pragma unroll
            for (int i = 0; i < 16; ++i) C[dt][i] *= sm[SM_EGC + 32 * dt + (i & 3) + 8 * (i >> 2) + 4 * h];
        chunk_update(lds, lane, C, vf);
        MX_SYNC();
#pragma unroll
        for (int lt = 0; lt < 2; ++lt) { const int ll = 32 * lt + l31; float st = 0.f;
#pragma unroll
            for (int w = 0; w < 8; ++w) st += sm[SM_SSQ + w * 64 + ll];
            const float rn = rsqrtf(st * (1.f / 256.f) + EPS);
            const size_t ro = (size_t)(t0 + ll) * D + 32 * wave + 4 * h;
#pragma unroll
            for (int g = 0; g < 4; ++g) { const u32x2 zv = *(const u32x2*)(ZG + ro + 8 * g);
                const f32x4 nw4 = *(const LAS f32x4*)(nwt + 32 * wave + 4 * h + 8 * g);
                const float o0 = acc1[lt][4 * g] * rn * nw4.x * siluf_(bflo(zv.x)), o1 = acc1[lt][4 * g + 1] * rn * nw4.y * siluf_(bfhi(zv.x));
                const float o2 = acc1[lt][4 * g + 2] * rn * nw4.z * siluf_(bflo(zv.y)), o3 = acc1[lt][4 * g + 3] * rn * nw4.w * siluf_(bfhi(zv.y));
                u32x2 pk; pk.x = pk2(o0, o1); pk.y = pk2(o2, o3); *(u32x2*)(O + ro + 8 * g) = pk; } }
    }
}
__device__ __forceinline__ void p_mixers(const Args& a, Frame& F, int l) {
    for (int s = F.bid; s < 128; s += F.G) {
        MX_SYNC();
        if (s < 64) mlstm_chunked(a, F, l, s >> 2, s & 3, (bf16_t*)(F.ws + WS_PB + 2 * PB_STRIDE));
        else gla_chunked(a, F, l, (s - 64) >> 2, s & 3, (bf16_t*)(F.ws + WS_PB + 5 * PB_STRIDE));
    }
}

#ifdef MK_TEST_MIXERS
__device__ __forceinline__ void p_mixers_test(const Args& a, Frame& F, int l) {
    for (int s = F.bid; s < 128; s += F.G) {
        int sel = -1;
        if (s == 5) sel = 0; else if (s == 38) sel = 1; else if (s == 64 + 9) sel = 2; else if (s == 64 + 50) sel = 3;
        bf16_t* ref = (bf16_t*)(F.ws + WS_LOGITS) + (size_t)(sel < 0 ? 0 : sel) * S * 256;
        MX_SYNC();
        if (sel >= 0) { if (s < 64) mlstm_seq(a, F, l, s >> 2, s & 3, ref, 256); else gla_seq(a, F, l, (s - 64) >> 2, s & 3, ref, 256); }
        MX_SYNC();
        if (s < 64) mlstm_chunked(a, F, l, s >> 2, s & 3, (bf16_t*)(F.ws + WS_PB + 2 * PB_STRIDE));
        else gla_chunked(a, F, l, (s - 64) >> 2, s & 3, (bf16_t*)(F.ws + WS_PB + 5 * PB_STRIDE));
        MX_SYNC();
        __builtin_amdgcn_fence(__ATOMIC_ACQUIRE, "agent"); asm volatile("s_waitcnt vmcnt(0)" ::: "memory");
        if (sel >= 0) {
            const int bb = (s < 64 ? s : s - 64) >> 2, hd = s & 3;
            const bf16_t* got = (const bf16_t*)(F.ws + WS_PB + (s < 64 ? 2 : 5) * PB_STRIDE) + (size_t)bb * S * D + hd * 256;
            float sd = 0.f, sr = 0.f;
            for (int i = F.tid; i < S * 256; i += NTHREADS) { const int t = i >> 8, e = i & 255; const float g = bf2f(got[(size_t)t * D + e]), r = bf2f(ref[i]); sd += (g - r) * (g - r); sr += r * r; }
            sd = wave_sum(sd); sr = wave_sum(sr);
            float* err = (float*)(F.ws + WS_CTL) + CW_ERR;
            if (F.lane == 0) { atomicAdd(&err[2], sd); atomicAdd(&err[3], sr); }
        }
    }
}
#endif
__global__ void __launch_bounds__(NTHREADS, 2) mega(Args a) {
    extern __shared__ __attribute__((aligned(16))) unsigned char lds_raw[];
    Frame F; F.lds = (LAS unsigned char*)lds_raw; F.ws = a.ws; F.tid = threadIdx.x; F.lane = F.tid & 63; F.wave = __builtin_amdgcn_readfirstlane(F.tid >> 6); F.G = gridDim.x; F.bid = blockIdx.x;
    volatile LAS unsigned* xbw = (volatile LAS unsigned*)(F.lds + MISC_OFF);
    if (F.tid < 4) xbw[F.tid] = 0u;
    __syncthreads();
    XcdBarrier bar; bar.bar = (unsigned*)(F.ws + WS_CTL) + CW_BAR; bar.x = 0; bar.st = xbw;
#if MK_N_LAUNCHES == 1
    bar = xcd_barrier_post((unsigned*)(F.ws + WS_CTL) + CW_BAR, xbw);
#define IN(k) true
#define SEAM() do { XcdBarrier b2_ = bar; unsigned long long zb_ = 0; asm volatile("" : "+s"(zb_)); b2_.bar = bar.bar + zb_; b2_.x = bar.x + (unsigned)zb_; b2_.st = bar.st + (unsigned)zb_; xcd_barrier(b2_); } while (0)
#else
    const int lo = a.ph_lo, hi = a.ph_hi;
#define IN(k) (lo <= (k) && (k) < hi)
#define SEAM() do { } while (0)
#endif
#define PH_BEGIN() do { int t_ = threadIdx.x; asm volatile("" : "+v"(t_)); F.tid = t_; F.lane = t_ & 63; F.wave = __builtin_amdgcn_readfirstlane(t_ >> 6); \
        unsigned long long z_ = 0; asm volatile("" : "+s"(z_)); F.ws = a.ws + z_; F.G = (int)gridDim.x + (int)z_; F.bid = (int)blockIdx.x + (int)z_; F.lds = (LAS unsigned char*)lds_raw + (unsigned)z_; } while (0)
    if (IN(0)) { PH_BEGIN(); p0a(a, F, true); SEAM(); }
#ifdef MK_TEST_MIXERS
#define MIXERS p_mixers_test
#else
#define MIXERS p_mixers
#endif
#define LAYER_BODY(l) \
        if (IN(1)) { PH_BEGIN(); \
            const float* ada = (const float*)(F.ws + WS_ADA) + (size_t)l * NB * 6 * D; \
            p_norm(F, l == 0 ? a.in[I_X] : a.out, a.in[I_NMIXW] + l * D, ada + 0 * D, ada + 1 * D, (bf16_t*)(F.ws + WS_U)); \
            SEAM(); \
        } \
        if (IN(2)) { PH_BEGIN(); p_inproj(F, l); SEAM(); } \
        if (IN(3)) { PH_BEGIN(); MIXERS(a, F, l); SEAM(); } \
        if (IN(4)) { PH_BEGIN(); p_gates(F, l); SEAM(); } \
        if (IN(5)) { PH_BEGIN(); p_y(F, l); SEAM(); } \
        if (IN(6)) { PH_BEGIN(); p_wo(a, F, l); SEAM(); } \
        if (IN(7)) { PH_BEGIN(); p_norm2(a, F, l); SEAM(); } \
        if (IN(8)) { PH_BEGIN(); p_router(F, l); SEAM(); } \
        if (IN(9)) { PH_BEGIN(); p_topk(a, F, l); SEAM(); } \
        if (IN(10)) { PH_BEGIN(); p_fill(F, l); SEAM(); } \
        if (IN(11)) { PH_BEGIN(); p_gemm1(F, l); SEAM(); } \
        if (IN(12)) { PH_BEGIN(); p_gemm2(F, l, 0); SEAM(); } \
        if (IN(13)) { PH_BEGIN(); p_combine(a, F, l, 0); SEAM(); } \
        if (IN(14)) { PH_BEGIN(); p_gemm2(F, l, 1); SEAM(); } \
        if (IN(15)) { PH_BEGIN(); p_combine(a, F, l, 1); SEAM(); } \
        if (IN(16) && l == 0) { PH_BEGIN(); p_expert_cvt(a, F, 1); SEAM(); }
#if MK_N_LAUNCHES == 1
    { LAYER_BODY(0) }
    { LAYER_BODY(1) }
#else
    for (int l_ = a.l_lo; l_ < a.l_hi; ++l_) { const int l = l_; LAYER_BODY(l) }
#endif
#undef LAYER_BODY
    if (IN(17)) { PH_BEGIN(); p_final(a, F); }
#undef IN
#undef SEAM
#undef PH_BEGIN
}


extern "C" void kernel_launch(void* const* d_in, const int* in_sizes, int n_in, void* d_out, int out_size, void* d_ws, size_t ws_size, hipStream_t stream) {
    static int grid = 0;
    if (grid == 0) {
        if (ws_size < 622 * MiB || n_in != 25 || out_size != T * D) { fprintf(stderr, "kernel_launch: unexpected problem (ws %zu, n_in %d, out %d)\n", ws_size, n_in, out_size); grid = -1; return; }
        int dev = 0, cus = 0, per_cu = 0;
        if (hipGetDevice(&dev) != hipSuccess || hipDeviceGetAttribute(&cus, hipDeviceAttributeMultiprocessorCount, dev) != hipSuccess) { grid = -1; return; }
        if (hipFuncSetAttribute((const void*)mega, hipFuncAttributeMaxDynamicSharedMemorySize, LDS_BYTES) != hipSuccess) { fprintf(stderr, "kernel_launch: hipFuncSetAttribute failed\n"); grid = -1; return; }
        if (hipOccupancyMaxActiveBlocksPerMultiprocessor(&per_cu, (const void*)mega, NTHREADS, LDS_BYTES) != hipSuccess || per_cu < 1) { fprintf(stderr, "kernel_launch: occupancy query says %d\n", per_cu); grid = -1; (void)hipGetLastError(); return; }
        grid = cus;
    }
    if (grid < 0) return;
    Args a{}; for (int i = 0; i < 25; ++i) a.in[i] = (const float*)d_in[i]; a.out = (float*)d_out; a.ws = (unsigned char*)d_ws;
    hipMemsetAsync((char*)d_ws + WS_CTL, 0, CTL_BYTES, stream);
#if MK_N_LAUNCHES == 1
    a.ph_lo = 0; a.ph_hi = 18; a.l_lo = 0; a.l_hi = DEPTH;
    hipLaunchKernelGGL(mega, dim3(grid), dim3(NTHREADS), LDS_BYTES, stream, a);
#else
    auto launch = [&](int ph, int l) { Args b = a; b.ph_lo = ph; b.ph_hi = ph + 1; b.l_lo = l; b.l_hi = l + 1; hipLaunchKernelGGL(mega, dim3(grid), dim3(NTHREADS), LDS_BYTES, stream, b); };
    launch(0, 0);
    for (int l = 0; l < DEPTH; ++l) { for (int ph = 1; ph <= 15; ++ph) launch(ph, l); if (l == 0) launch(16, 0); }
    launch(17, 0);
#endif
}
```

```cpp
#include <hip/hip_runtime.h>
#include <cstdio>
#include <cstdint>

constexpr int D = 1024, NB = 16, S = 2048, T = NB * S, DEPTH = 2;
constexpr int DIN = 8216;
constexpr int C_QK = 0, C_VM = 1024, C_OM = 2048, C_IM = 3072, C_FM = 3076, C_QG = 3080, C_KG = 3592, C_VG = 4104, C_RG = 5128, C_ZG = 5144, C_GA = 6168, C_GB = 7192;
constexpr int NE = 64, TOPK = 8, DE = 256;
constexpr int NASSIGN = T * TOPK, NROWS = NASSIGN + NE * 256, NBLK = NROWS / 256;
constexpr float EPS = 1e-6f;

__device__ __forceinline__ float sigmoidf_(float x) { return 1.f / (1.f + __expf(-x)); }
__device__ __forceinline__ float siluf_(float x) { return x / (1.f + __expf(-x)); }
__device__ __forceinline__ float logsigmoidf_(float x) { return fminf(x, 0.f) - log1pf(__expf(-fabsf(x))); }
__device__ __forceinline__ float wave_sum(float v) {
#pragma unroll
    for (int o = 1; o < 64; o <<= 1) v += __shfl_xor(v, o);
    return v;
}

#define LAS __attribute__((address_space(3)))
typedef unsigned short bf16_t;
typedef short bf16x8 __attribute__((ext_vector_type(8)));
typedef float f32x4 __attribute__((ext_vector_type(4)));
typedef float f32x2 __attribute__((ext_vector_type(2)));
typedef unsigned u32x4 __attribute__((ext_vector_type(4)));
typedef unsigned u32x2 __attribute__((ext_vector_type(2)));

constexpr size_t MiB = 1u << 20;
constexpr int NWAVES = 8, NTHREADS = 512;
constexpr int LDS_BYTES = 163840;
constexpr int RING_BYTES = 131072, MISC_OFF = RING_BYTES;

constexpr size_t WS_CTL = 0, CTL_BYTES = 1 * MiB;
constexpr size_t WS_ADA = 1 * MiB;
constexpr size_t WS_WSM = 2 * MiB, WSM_STRIDE = 25 * MiB;
constexpr size_t WO_IN = 0, WO_GAB = 12 * MiB + 512 * 1024, WO_PA = WO_GAB + 4 * MiB, WO_PB = WO_PA + 2 * MiB, WO_O = WO_PB + 2 * MiB, WO_S13 = WO_O + 2 * MiB, WO_S2 = WO_S13 + 1 * MiB, WO_R = WO_S2 + 512 * 1024;
constexpr size_t WS_WEXP13 = 52 * MiB, WS_WEXP2 = 116 * MiB;
constexpr size_t WS_SMALL = 148 * MiB;
constexpr size_t WS_LOGITS = 152 * MiB, WS_EIDX = 160 * MiB, WS_WTS = 161 * MiB, WS_POS = 162 * MiB, WS_ROWTOK = 163 * MiB;
constexpr size_t WS_U = 166 * MiB;
constexpr size_t WS_PB = 230 * MiB, PB_STRIDE = 64 * MiB;
constexpr size_t WS_SA8 = 614 * MiB;
constexpr size_t WS_SB8T = 646 * MiB;
constexpr int SB8_SPLIT = 25600;
constexpr size_t WS_OPT_END = 653 * MiB;
static_assert(WO_R + 512 * 1024 <= WSM_STRIDE, "small weight map");

constexpr int CW_BAR = 4096;
constexpr int CW_CNT = 16384;
constexpr int CW_ERR = 20480;
constexpr int CW_STAMP = 24576;

__device__ __forceinline__ unsigned f2bf(float f) { unsigned u = __builtin_bit_cast(unsigned, f); return (u + 0x7fffu + ((u >> 16) & 1u)) >> 16; }
__device__ __forceinline__ unsigned pk2(float lo, float hi) { return f2bf(lo) | (f2bf(hi) << 16); }
__device__ __forceinline__ float bf2f(unsigned short b) { return __builtin_bit_cast(float, (unsigned)b << 16); }
__device__ __forceinline__ float bflo(unsigned w) { return __builtin_bit_cast(float, w << 16); }
__device__ __forceinline__ float bfhi(unsigned w) { return __builtin_bit_cast(float, w & 0xffff0000u); }
typedef __bf16 bf16x2_t __attribute__((ext_vector_type(2)));
__device__ __forceinline__ unsigned cvt_pk_bf16(float lo, float hi) { const f32x2 v = {lo, hi}; return __builtin_bit_cast(unsigned, __builtin_convertvector(v, bf16x2_t)); }

__device__ __forceinline__ float frcp(float x) { return __builtin_amdgcn_rcpf(x); }
__device__ __forceinline__ float fsigmoid(float x) { return frcp(1.f + __expf(-x)); }
__device__ __forceinline__ float fsilu(float x) { return x * frcp(1.f + __expf(-x)); }
__device__ __forceinline__ float flogsigmoid(float x) { return fminf(x, 0.f) - __logf(1.f + __expf(-fabsf(x))); }
__device__ __forceinline__ float ftanh(float y) { return 1.f - 2.f * frcp(1.f + __expf(2.f * y)); }
#define LDS_WAIT() asm volatile("s_waitcnt lgkmcnt(0)" ::: "memory")
#define VM_WAIT() asm volatile("s_waitcnt vmcnt(0)" ::: "memory")

template <class E> constexpr bool epi_probe_v = false;
namespace pg8 {
constexpr int BM = 256, BK = 64, HALF = 128, HTB = HALF * BK * 2, STAGE_BYTES = 8 * HTB, NXCD = 8, WGM = 8;
__host__ __device__ __forceinline__ int lds_byte(int r, int c) { const int st = (r >> 4) * 2 + (c >> 5), rr = r & 15, cc = c & 31, ob = rr * 64 + cc * 2; return st * 1024 + (ob ^ (((ob >> 9) & 1) << 5)); }
__host__ __device__ __forceinline__ void stage_rc(int b, int& R, int& C) { const int st = b / 1024, sb = b % 1024, swz = sb ^ (((sb >> 9) & 1) << 5); R = (st >> 1) * 16 + swz / 64; C = (st & 1) * 32 + (swz % 64) / 2; }
__host__ __device__ __forceinline__ int perm32(int rho) { const int n = rho >> 4, i = rho & 15; return 8 * (i >> 2) + 4 * n + (i & 3); }

struct Unit { int pm, pn, e; };

struct TileOrder {
    int nM, nN, nwg, G, c;
    __device__ void init(int nM_, int nN_, int G_, int c_) { nM = nM_; nN = nN_; nwg = nM * nN; G = G_; c = c_; }
    __device__ bool tile(int i, int& pm, int& pn) const {
        const long L = (long)i * G + c; if (L >= nwg) return false;
        int wgid = (int)L; { const int q = nwg / NXCD, r = nwg % NXCD, xcd = wgid % NXCD, off = wgid / NXCD; wgid = (xcd < r ? xcd * (q + 1) : r * (q + 1) + (xcd - r) * q) + off; }
        const int nig = WGM * nN, gid = wgid / nig, fm = gid * WGM, gsz = (nM - fm) < WGM ? (nM - fm) : WGM;
        pm = fm + ((wgid % nig) % gsz); pn = (wgid % nig) / gsz; return true;
    }
};

template <class Epi, class Sched, bool GATHER, bool ALIGN_EPI = true>
__device__ __forceinline__ void gemm_phase(LAS unsigned char* lds, const int K, const Sched& S, const Epi& E) {
    int tid_ = threadIdx.x; asm volatile("" : "+v"(tid_));
    const int tid = tid_, wid = __builtin_amdgcn_readfirstlane(tid >> 6), lane = tid & 63, wr = wid >> 2, wc = wid & 3, fr = lane & 15, fq = lane >> 4;
    const int nt = K / BK;
    unsigned rowA[2], colA[2], voffB[2];
#pragma unroll
    for (int i = 0; i < 2; ++i) { int R, C; stage_rc(tid * 16 + i * 8192, R, C); const int Rb = Epi::PERM ? ((R & ~31) + perm32(R & 31)) : R;
        rowA[i] = (unsigned)R; colA[i] = (unsigned)C * 2u; voffB[i] = (unsigned)(Rb * K + C) * 2u; }
    const size_t kstep = (size_t)(BK * 2);
    const size_t hstep = (size_t)HALF * K * 2;
    const unsigned ldsw = (unsigned)wid * 1024u;
    const int aoff = lds_byte(wr * 64 + fr, fq * 8), boff = lds_byte(wc * 32 + fr, fq * 8);
#define PG8_SA(b, h) (((b) * 2 + (h)) * HTB)
#define PG8_SB(b, h) ((4 + (b) * 2 + (h)) * HTB)
#define PG8_STAGE(bufoff, gbase, voff) do { _Pragma("unroll") for (int _i = 0; _i < 2; ++_i) \
        __builtin_amdgcn_global_load_lds((const unsigned*)((const char*)(gbase) + (voff)[_i]), (LAS unsigned*)(lds + (bufoff) + ldsw + _i * 8192), 16, 0, 0); } while (0)
#define PG8_LDA(dst, b, h) do { _Pragma("unroll") for (int m = 0; m < 4; ++m) _Pragma("unroll") for (int k = 0; k < 2; ++k) dst[m][k] = *(const LAS bf16x8*)(lds + PG8_SA(b, h) + aoff + m * 2048 + k * 1024); } while (0)
#define PG8_LDB(dst, b, h) do { _Pragma("unroll") for (int n = 0; n < 2; ++n) _Pragma("unroll") for (int k = 0; k < 2; ++k) dst[n][k] = *(const LAS bf16x8*)(lds + PG8_SB(b, h) + boff + n * 2048 + k * 1024); } while (0)
#define PG8_MMA(ai, bj, At, Bt) do { __builtin_amdgcn_s_setprio(1); _Pragma("unroll") for (int m = 0; m < 4; ++m) _Pragma("unroll") for (int n = 0; n < 2; ++n) _Pragma("unroll") for (int k = 0; k < 2; ++k) \
        acc[ai][bj][m][n] = __builtin_amdgcn_mfma_f32_16x16x32_bf16(Bt[n][k], At[m][k], acc[ai][bj][m][n], 0, 0, 0); __builtin_amdgcn_s_setprio(0); } while (0)
#define PG8_WAIT_V(n) asm volatile("s_waitcnt vmcnt(" #n ")" ::: "memory")
#define PG8_WAIT_L(n) asm volatile("s_waitcnt lgkmcnt(" #n ")" ::: "memory")
#define PG8_BAR __builtin_amdgcn_s_barrier()
#define PG8_SCHED __builtin_amdgcn_sched_barrier(0)
    Unit cur, nxt; int ui = 0;
    if (!S.next(0, cur)) return;
#ifdef MK_PROBE
    unsigned long long gt_acc[3] = {0, 0, 0}; unsigned long long gt_last = __builtin_amdgcn_s_memtime();
#define PG8_T(k) do { if (epi_probe_v<Epi>) { const unsigned long long now_ = __builtin_amdgcn_s_memtime(); gt_acc[k] += now_ - gt_last; gt_last = now_; } } while (0)
#else
#define PG8_T(k) do { } while (0)
#endif
    unsigned offA[2][2], noffA[2][2];
    {
        const int* tk = GATHER ? S.a_rows(cur) : nullptr;
#pragma unroll
        for (int h = 0; h < 2; ++h)
#pragma unroll
            for (int i = 0; i < 2; ++i) offA[h][i] = (GATHER ? (unsigned)tk[h * HALF + rowA[i]] : (unsigned)(h * HALF) + rowA[i]) * (unsigned)(K * 2) + colA[i];
    }
    f32x4 acc[2][2][4][2];
#pragma unroll
    for (int a = 0; a < 2; ++a)
#pragma unroll
        for (int b = 0; b < 2; ++b)
#pragma unroll
            for (int m = 0; m < 4; ++m)
#pragma unroll
                for (int n = 0; n < 2; ++n) acc[a][b][m][n] = (f32x4){0.f, 0.f, 0.f, 0.f};
    bf16x8 At[4][2], B0[2][2], B1[2][2];
    const char* cA = S.a_ptr(cur); const char* cB = S.b_ptr(cur);
    PG8_STAGE(PG8_SB(0, 0), cB, voffB); PG8_STAGE(PG8_SB(0, 1), cB + hstep, voffB); PG8_STAGE(PG8_SA(0, 0), cA, offA[0]); PG8_STAGE(PG8_SA(0, 1), cA, offA[1]);
    if (wr == 1) PG8_BAR;
    PG8_WAIT_V(2); PG8_BAR;
    PG8_STAGE(PG8_SB(1, 0), cB + kstep, voffB); PG8_STAGE(PG8_SA(1, 0), cA + kstep, offA[0]); PG8_STAGE(PG8_SB(1, 1), cB + hstep + kstep, voffB);
    PG8_WAIT_V(6); PG8_BAR;
    for (;;) {
        const bool has_next = S.next(ui + 1, nxt);
        const char* nA = has_next ? S.a_ptr(nxt) : cA; const char* nB = has_next ? S.b_ptr(nxt) : cB;
        if (GATHER) {
            const int* tk = S.a_rows(has_next ? nxt : cur);
            int t00 = tk[rowA[0]], t01 = tk[rowA[1]], t10 = tk[HALF + rowA[0]], t11 = tk[HALF + rowA[1]];
            noffA[0][0] = (unsigned)t00 * (unsigned)(K * 2) + colA[0]; noffA[0][1] = (unsigned)t01 * (unsigned)(K * 2) + colA[1];
            noffA[1][0] = (unsigned)t10 * (unsigned)(K * 2) + colA[0]; noffA[1][1] = (unsigned)t11 * (unsigned)(K * 2) + colA[1];
        } else {
#pragma unroll
            for (int h = 0; h < 2; ++h)
#pragma unroll
                for (int i = 0; i < 2; ++i) noffA[h][i] = offA[h][i];
        }
#pragma unroll 1
        for (int t = 0; t < nt; t += 2) {
            const bool last = (t == nt - 2);
            const char* a1 = cA + (size_t)(t + 1) * kstep;
            const char* a2 = last ? nA : cA + (size_t)(t + 2) * kstep; const char* b2 = last ? nB : cB + (size_t)(t + 2) * kstep;
            const char* a3 = a2 + kstep; const char* b3 = b2 + kstep;
            unsigned o2[2][2];
#pragma unroll
            for (int h = 0; h < 2; ++h)
#pragma unroll
                for (int i = 0; i < 2; ++i) o2[h][i] = (GATHER && last) ? noffA[h][i] : offA[h][i];
            PG8_LDB(B0, 0, 0); PG8_LDB(B1, 0, 1); PG8_SCHED; PG8_LDA(At, 0, 0); PG8_STAGE(PG8_SA(1, 1), a1, offA[1]);
            PG8_WAIT_V(8); PG8_WAIT_L(0); PG8_BAR; PG8_MMA(0, 0, At, B0); PG8_MMA(0, 1, At, B1); PG8_BAR; PG8_SCHED;
            PG8_LDA(At, 0, 1); PG8_STAGE(PG8_SB(0, 0), b2, voffB); PG8_STAGE(PG8_SB(0, 1), b2 + hstep, voffB); PG8_STAGE(PG8_SA(0, 0), a2, o2[0]);
            PG8_WAIT_V(8); PG8_WAIT_L(0); PG8_BAR; PG8_MMA(1, 0, At, B0); PG8_MMA(1, 1, At, B1); PG8_BAR; PG8_SCHED;
            PG8_LDB(B0, 1, 0); PG8_LDB(B1, 1, 1); PG8_SCHED; PG8_LDA(At, 1, 0); PG8_STAGE(PG8_SA(0, 1), a2, o2[1]);
            PG8_WAIT_V(8); PG8_WAIT_L(0); PG8_BAR; PG8_MMA(0, 0, At, B0); PG8_MMA(0, 1, At, B1); PG8_BAR; PG8_SCHED;
            PG8_LDA(At, 1, 1); PG8_STAGE(PG8_SB(1, 0), b3, voffB); PG8_STAGE(PG8_SB(1, 1), b3 + hstep, voffB); PG8_STAGE(PG8_SA(1, 0), a3, o2[0]);
            PG8_WAIT_V(8); PG8_WAIT_L(0); PG8_BAR; PG8_MMA(1, 0, At, B0); PG8_MMA(1, 1, At, B1); PG8_BAR; PG8_SCHED;
        }
        PG8_T(0);
        if constexpr (ALIGN_EPI) { if (wr == 0) PG8_BAR; }
        E(acc, cur, wr, wc, fr, fq);
        PG8_T(1);
        if (!has_next) break;
#pragma unroll
        for (int a = 0; a < 2; ++a)
#pragma unroll
            for (int b = 0; b < 2; ++b)
#pragma unroll
                for (int m = 0; m < 4; ++m)
#pragma unroll
                    for (int n = 0; n < 2; ++n) acc[a][b][m][n] = (f32x4){0.f, 0.f, 0.f, 0.f};
        cur = nxt; cA = nA; cB = nB; ++ui;
#pragma unroll
        for (int h = 0; h < 2; ++h)
#pragma unroll
            for (int i = 0; i < 2; ++i) offA[h][i] = noffA[h][i];
        if constexpr (ALIGN_EPI) { if (wr == 1) PG8_BAR; }
        PG8_T(2);
    }
    PG8_WAIT_V(0);
    if constexpr (!ALIGN_EPI) { if (wr == 0) PG8_BAR; }
    PG8_BAR;
#ifdef MK_PROBE
    if (epi_probe_v<Epi> && blockIdx.x == 0 && threadIdx.x == 0) { unsigned long long* tp = (unsigned long long*)S.probe_ptr(); for (int i = 0; i < 3; ++i) tp[i] = gt_acc[i]; tp[3] = 0; tp[4] = 0; tp[5] = 0; }
#endif
#undef PG8_T
#undef PG8_SA
#undef PG8_SB
#undef PG8_STAGE
#undef PG8_LDA
#undef PG8_LDB
#undef PG8_MMA
#undef PG8_WAIT_V
#undef PG8_WAIT_L
#undef PG8_BAR
#undef PG8_SCHED
}
}

#ifndef MK_TEST_THR
#define MK_TEST_THR 0.01f
#endif
#ifndef MK_N_LAUNCHES
#define MK_N_LAUNCHES 1
#endif
#define XB_TMO      128
#define XB_XCNT(j)  (256  + 64 * (j))
#define XB_XSUB(j)  (1280 + 64 * (j))
#define XB_XGEN(j)  (2304 + 64 * (j))
#define XB_TOP      3328
#define XB_TOPGEN   3392
#define XCD_BAR_WORDS 3456
#define XB_SPIN_CAP (1u << 22)

__device__ __forceinline__ unsigned xb_ld(unsigned* p)              { return __hip_atomic_load(p, __ATOMIC_RELAXED, __HIP_MEMORY_SCOPE_AGENT); }
__device__ __forceinline__ unsigned xb_add(unsigned* p, unsigned v) { return __hip_atomic_fetch_add(p, v, __ATOMIC_RELAXED, __HIP_MEMORY_SCOPE_AGENT); }
__device__ __forceinline__ unsigned xb_xcc_id() { return (unsigned)__builtin_amdgcn_s_getreg((3 << 11) | 20) & 0xFu; }
#define XB_SPIN(cond, bar) do { unsigned _sp = 0; while (cond) { __builtin_amdgcn_s_sleep(1); \
    if ((++_sp & 255u) == 0u) { if (xb_ld(&(bar)[XB_TMO])) break; if (_sp > XB_SPIN_CAP) { atomicAdd(&(bar)[XB_TMO], 1u); break; } } } } while (0)

struct XcdBarrier {
    unsigned* bar; unsigned x;
    volatile LAS unsigned* st;
};

__device__ __forceinline__ XcdBarrier xcd_barrier_post(unsigned* bar, volatile LAS unsigned* st) {
    XcdBarrier b; b.bar = bar; b.x = xb_xcc_id(); b.st = st;
    if (threadIdx.x == 0) (void)xb_add(&bar[XB_XCNT(b.x)], 1u);
    return b;
}
__device__ __forceinline__ void xcd_barrier_complete(unsigned* bar, unsigned x, unsigned& nloc, unsigned& nx) {
    const unsigned G = gridDim.x * gridDim.y * gridDim.z;
    unsigned sum, cnt, mine, sp = 0u;
    for (;;) {
        sum = 0u; cnt = 0u; mine = 0u;
#pragma unroll
        for (unsigned j = 0; j < 16; ++j) { const unsigned c = xb_ld(&bar[XB_XCNT(j)]); sum += c; cnt += (c > 0u) ? 1u : 0u; mine = (j == x) ? c : mine; }
        if (sum == G) break;
        __builtin_amdgcn_s_sleep(1);
        if ((++sp & 255u) == 0u) { if (xb_ld(&bar[XB_TMO])) break; if (sp > XB_SPIN_CAP) { atomicAdd(&bar[XB_TMO], 1u); break; } }
    }
    nloc = mine > 0u ? mine : 1u; nx = cnt > 0u ? cnt : 1u;
}

__device__ __forceinline__ void xcd_barrier(const XcdBarrier& b) {
    asm volatile("s_waitcnt vmcnt(0)" ::: "memory");
    __syncthreads();
    if (threadIdx.x == 0) {
        unsigned* bar = b.bar;
        __builtin_amdgcn_s_waitcnt(0);
        unsigned nloc = b.st[0], nx = b.st[1];
        if (nloc == 0u) { xcd_barrier_complete(bar, b.x, nloc, nx); b.st[0] = nloc; b.st[1] = nx; }
        const unsigned old = xb_add(&bar[XB_XSUB(b.x)], 1u);
        const unsigned gen = old / nloc;
        if (old + 1u == (gen + 1u) * nloc) {
            __builtin_amdgcn_fence(__ATOMIC_RELEASE, "agent");
            asm volatile("s_waitcnt vmcnt(0)" ::: "memory");
            const unsigned og = xb_add(&bar[XB_TOP], 1u);
            const unsigned tg = og / nx;
            if (og + 1u == (tg + 1u) * nx) xb_add(&bar[XB_TOPGEN], 1u);
            else XB_SPIN(xb_ld(&bar[XB_TOPGEN]) == tg, bar);
            __builtin_amdgcn_fence(__ATOMIC_ACQUIRE, "agent");
            xb_add(&bar[XB_XGEN(b.x)], 1u);
            asm volatile("s_waitcnt vmcnt(0)" ::: "memory");
        } else {
            XB_SPIN(xb_ld(&bar[XB_XGEN(b.x)]) == gen, bar);
            __builtin_amdgcn_fence(__ATOMIC_ACQUIRE, "agent");
            asm volatile("s_waitcnt vmcnt(0)" ::: "memory");
        }
    }
    __syncthreads();
}


struct Args { const float* in[25]; float* out; unsigned char* ws; int ph_lo, ph_hi, l_lo, l_hi; };
struct Frame {
    LAS unsigned char* lds;
    unsigned char* ws;
    int tid, lane, wave, G, bid;
};
enum { I_X = 0, I_C, I_ADAW, I_ADAB, I_NMIXW, I_NMOEW, I_WIN, I_CONVW, I_GATEB, I_MNORMW, I_ALPHAW, I_ALPHAB, I_GNORMW, I_WPA, I_WPB, I_WO, I_RW, I_RB, I_EW1, I_EW3, I_EW2, I_SW1, I_SW3, I_SW2, I_FNW };

__device__ __forceinline__ bf16_t* wsm(unsigned char* ws, int l, size_t off) { return (bf16_t*)(ws + WS_WSM + (size_t)l * WSM_STRIDE + off); }

__device__ __forceinline__ void tr_item(const float* W, int ldw, int c0, int k0, bf16_t* WT, int r0, int K, LAS float* scr, int lane) {
#pragma unroll 8
    for (int i = 0; i < 32; ++i) { const int kk = 2 * i + (lane >> 5); scr[kk * 33 + (lane & 31)] = W[(size_t)(k0 + kk) * ldw + c0 + (lane & 31)]; }
    LDS_WAIT(); asm volatile("" ::: "memory");
    const int c = lane & 7;
#pragma unroll
    for (int j = 0; j < 4; ++j) { const int n = (lane >> 3) + 8 * j; const LAS float* s = scr + (8 * c) * 33 + n;
        u32x4 o; o.x = pk2(s[0 * 33], s[1 * 33]); o.y = pk2(s[2 * 33], s[3 * 33]); o.z = pk2(s[4 * 33], s[5 * 33]); o.w = pk2(s[6 * 33], s[7 * 33]);
        *(u32x4*)(WT + (size_t)(r0 + n) * K + k0 + 8 * c) = o; }
    LDS_WAIT(); asm volatile("" ::: "memory");
}
constexpr int SW_ITEMS = 96 * 16 + 3 * 32 * 16 + 64 * 16 + 3 * 32 * 16 + 4 * 4 * 16 + 32 * 4 + 8 * 16 + 8 * 16;
__device__ __forceinline__ void small_item(const Args& a, unsigned char* ws, int l, int r, LAS float* scr, int lane) {
    const float* win = a.in[I_WIN] + (size_t)l * D * DIN;
    bf16_t* Win_t = wsm(ws, l, WO_IN);
    if (r < 96 * 16) { const int nb = r % 96, kb = r / 96; tr_item(win, DIN, nb * 32, kb * 64, Win_t, nb * 32, D, scr, lane); return; } r -= 96 * 16;
    if (r < 32 * 16) { const int nb = r % 32, kb = r / 32; tr_item(win, DIN, C_QG + nb * 32, kb * 64, Win_t, 3072 + nb * 32, D, scr, lane); return; } r -= 32 * 16;
    if (r < 32 * 16) { const int nb = r % 32, kb = r / 32; tr_item(win, DIN, C_VG + nb * 32, kb * 64, Win_t, 4096 + nb * 32, D, scr, lane); return; } r -= 32 * 16;
    if (r < 32 * 16) { const int nb = r % 32, kb = r / 32; tr_item(win, DIN, C_ZG + nb * 32, kb * 64, Win_t, 5120 + nb * 32, D, scr, lane); return; } r -= 32 * 16;
    if (r < 64 * 16) { const int nb = r % 64, kb = r / 64; tr_item(win, DIN, C_GA + nb * 32, kb * 64, wsm(ws, l, WO_GAB), nb * 32, D, scr, lane); return; } r -= 64 * 16;
    if (r < 32 * 16) { const int nb = r % 32, kb = r / 32; tr_item(a.in[I_WPA] + (size_t)l * D * D, D, nb * 32, kb * 64, wsm(ws, l, WO_PA), nb * 32, D, scr, lane); return; } r -= 32 * 16;
    if (r < 32 * 16) { const int nb = r % 32, kb = r / 32; tr_item(a.in[I_WPB] + (size_t)l * D * D, D, nb * 32, kb * 64, wsm(ws, l, WO_PB), nb * 32, D, scr, lane); return; } r -= 32 * 16;
    if (r < 32 * 16) { const int nb = r % 32, kb = r / 32; tr_item(a.in[I_WO] + (size_t)l * D * D, D, nb * 32, kb * 64, wsm(ws, l, WO_O), nb * 32, D, scr, lane); return; } r -= 32 * 16;
    if (r < 4 * 4 * 16) { const int seg = r / 64, it = r % 64, nb = it % 4, kb = it / 4;
        const float* src = ((seg & 1) ? a.in[I_SW3] : a.in[I_SW1]) + (size_t)l * D * DE;
        tr_item(src, DE, (seg >> 1) * 128 + nb * 32, kb * 64, wsm(ws, l, WO_S13), seg * 128 + nb * 32, D, scr, lane); return; } r -= 256;
    if (r < 32 * 4) { const int nb = r % 32, kb = r / 32; tr_item(a.in[I_SW2] + (size_t)l * DE * D, D, nb * 32, kb * 64, wsm(ws, l, WO_S2), nb * 32, DE, scr, lane); return; } r -= 128;
    if (r < 8 * 16) {
        const int nb = r % 8, kb = r / 8; bf16_t* Wr = wsm(ws, l, WO_R);
        if (nb < 2) tr_item(a.in[I_RW] + (size_t)l * D * NE, NE, nb * 32, kb * 64, Wr, nb * 32, D, scr, lane);
        else for (int j = 0; j < 32; ++j) Wr[(size_t)(nb * 32 + j) * D + kb * 64 + lane] = 0;
        return; } r -= 128;
    {
        const int rb = r % 8, kb = r / 8;
        for (int j = 0; j < 32; ++j) {
            const int row = rb * 32 + j; float v = 0.f;
            if (row < 24) { const int srcc = row < 4 ? C_IM + row : (row < 8 ? C_FM + row - 4 : C_RG + row - 8); v = win[(size_t)(kb * 64 + lane) * DIN + srcc]; }
            Win_t[(size_t)(6144 + row) * D + kb * 64 + lane] = (bf16_t)f2bf(v);
        }
    }
}
constexpr int EX_ITEMS = 64 * 384;
__device__ __forceinline__ void expert_item(const Args& a, unsigned char* ws, int l, int idx, LAS float* scr, int lane) {
    const int e = idx / 384; int r = idx % 384;
    if (r < 256) { const int seg = r / 64, it = r % 64, nb = it % 4, kb = it / 4;
        const float* src = ((seg & 1) ? a.in[I_EW3] : a.in[I_EW1]) + ((size_t)l * NE + e) * D * DE;
        tr_item(src, DE, (seg >> 1) * 128 + nb * 32, kb * 64, (bf16_t*)(ws + WS_WEXP13) + (size_t)e * 512 * D, seg * 128 + nb * 32, D, scr, lane); return; }
    r -= 256; { const int nb = r % 32, kb = r / 32;
        tr_item(a.in[I_EW2] + ((size_t)l * NE + e) * DE * D, D, nb * 32, kb * 64, (bf16_t*)(ws + WS_WEXP2) + (size_t)e * D * DE, nb * 32, DE, scr, lane); }
}
constexpr int SW_FIRST = 96 * 16 + 3 * 32 * 16 + 64 * 16;
constexpr int SW_DEFER0 = SW_ITEMS - 128 - SW_FIRST;
__device__ __forceinline__ void small_deferred0(const Args& a, unsigned char* ws, int it, LAS float* scr, int lane) { small_item(a, ws, 0, SW_FIRST + it, scr, lane); }
__device__ __forceinline__ void p0a(const Args& a, Frame& F, bool experts0) {
    const int gw = F.bid * NWAVES + F.wave, NGW = F.G * NWAVES;
    LAS float* cond = (LAS float*)F.lds;
    LAS float* scr = (LAS float*)(F.lds + F.wave * 8704);
    if (F.bid * NWAVES < 768) {
        const float* c = a.in[I_C];
        for (int i = F.tid; i < NB * D; i += NTHREADS) cond[i] = siluf_(c[i]);
        __syncthreads();
        if (gw < 768) {
            const int l = gw / 384, r = gw % 384, j = (r >> 2) * 64 + F.lane, b0 = (r & 3) * 4;
            const float* w = a.in[I_ADAW] + (size_t)l * D * 6 * D + j;
            float acc[4] = {0.f, 0.f, 0.f, 0.f};
#pragma unroll 8
            for (int k = 0; k < D; ++k) { const float wv = w[(size_t)k * 6 * D];
#pragma unroll
                for (int b = 0; b < 4; ++b) acc[b] += cond[(b0 + b) * D + k] * wv; }
            const float bb = a.in[I_ADAB][l * 6 * D + j];
            float* ada = (float*)(F.ws + WS_ADA);
#pragma unroll
            for (int b = 0; b < 4; ++b) ada[((size_t)l * NB + b0 + b) * 6 * D + j] = acc[b] + bb;
        }
        __syncthreads();
    }
    const int total = SW_FIRST + 128 + (experts0 ? EX_ITEMS : 0);
    for (int it = gw; it < total; it += NGW) {
        if (it < SW_FIRST) small_item(a, F.ws, 0, it, scr, F.lane);
        else if (it < SW_FIRST + 128) small_item(a, F.ws, 0, SW_ITEMS - 128 + (it - SW_FIRST), scr, F.lane);
        else expert_item(a, F.ws, 0, it - SW_FIRST - 128, scr, F.lane);
    }
}
__device__ __forceinline__ void p_norm(Frame& F, const float* h, const float* w, const float* sh, const float* sc, bf16_t* U) {
    const int gw = F.bid * NWAVES + F.wave, NGW = F.G * NWAVES, RPW = (T + NGW - 1) / NGW;
    const int r0 = gw * RPW, r1 = (r0 + RPW < T) ? r0 + RPW : T;
    f32x4 av[4], bv[4]; int bcur = -1;
    f32x4 v[4], vn[4];
    if (r0 < r1) { const f32x4* xr = (const f32x4*)(h + (size_t)r0 * D) + F.lane;
#pragma unroll
        for (int j = 0; j < 4; ++j) v[j] = xr[64 * j]; }
    for (int row = r0; row < r1; ++row) {
        const int b = row / S;
        { const int nrow = (row + 1 < r1) ? row + 1 : row; const f32x4* xn = (const f32x4*)(h + (size_t)nrow * D) + F.lane;
#pragma unroll
          for (int j = 0; j < 4; ++j) vn[j] = xn[64 * j]; }
        if (b != bcur) { bcur = b;
#pragma unroll
            for (int j = 0; j < 4; ++j) { const f32x4 scv = ((const f32x4*)(sc + (size_t)b * 6 * D))[F.lane + 64 * j]; av[j] = ((const f32x4*)w)[F.lane + 64 * j] * (scv + 1.f); bv[j] = ((const f32x4*)(sh + (size_t)b * 6 * D))[F.lane + 64 * j]; } }
        float ss = 0.f;
#pragma unroll
        for (int j = 0; j < 4; ++j) ss += (v[j].x * v[j].x + v[j].y * v[j].y) + (v[j].z * v[j].z + v[j].w * v[j].w);
        const float r = rsqrtf(wave_sum(ss) * (1.f / D) + EPS);
        u32x2* o = (u32x2*)(U + (size_t)row * D) + F.lane;
#pragma unroll
        for (int j = 0; j < 4; ++j) {
            const f32x4 y = v[j] * r * av[j] + bv[j];
            u32x2 pk; pk.x = cvt_pk_bf16(y.x, y.y); pk.y = cvt_pk_bf16(y.z, y.w); o[64 * j] = pk;
        }
#pragma unroll
        for (int j = 0; j < 4; ++j) v[j] = vn[j];
    }
}
struct SchedDense {
    pg8::TileOrder O; const char* A; const char* B; size_t tstep;
    __device__ bool next(int i, pg8::Unit& u) const { u.e = 0; return O.tile(i, u.pm, u.pn); }
    __device__ const char* a_ptr(const pg8::Unit& u) const { return A + (size_t)u.pm * tstep; }
    __device__ const char* b_ptr(const pg8::Unit& u) const { return B + (size_t)u.pn * tstep; }
    __device__ const int* a_rows(const pg8::Unit&) const { return nullptr; }
    unsigned char* pp = nullptr; __device__ void* probe_ptr() const { return pp; }
};
struct EpiInProj {
    static constexpr bool PERM = true;
    bf16_t* PB; float* small;
    __device__ __forceinline__ void operator()(const f32x4 (&acc)[2][2][4][2], const pg8::Unit& u, int wr, int wc, int fr, int fq) const {
        const int row0 = u.pm * 256 + wr * 64 + fr;
        if (u.pn < 24) {
            bf16_t* base = PB + (size_t)(u.pn >> 2) * (PB_STRIDE / 2) + (u.pn & 3) * 256 + wc * 32 + 8 * fq;
            const int gate = (u.pn >> 2) == 2 ? 1 : ((u.pn >> 2) == 5 ? 2 : 0);
#pragma unroll
            for (int ai = 0; ai < 2; ++ai)
#pragma unroll
                for (int m = 0; m < 4; ++m) { bf16_t* rowp = base + (size_t)(row0 + ai * 128 + m * 16) * D;
#pragma unroll
                    for (int bj = 0; bj < 2; ++bj) { f32x4 v0 = acc[ai][bj][m][0], v1 = acc[ai][bj][m][1];
                        if (gate) {
#pragma unroll
                            for (int k = 0; k < 4; ++k) { const float s0 = fsigmoid(v0[k]), s1 = fsigmoid(v1[k]); v0[k] = gate == 1 ? s0 : v0[k] * s0; v1[k] = gate == 1 ? s1 : v1[k] * s1; } }
                        u32x4 w; w.x = cvt_pk_bf16(v0[0], v0[1]); w.y = cvt_pk_bf16(v0[2], v0[3]); w.z = cvt_pk_bf16(v1[0], v1[1]); w.w = cvt_pk_bf16(v1[2], v1[3]);
                        *(u32x4*)(rowp + bj * 128) = w; } }
        } else if (wc == 0) {
#pragma unroll
            for (int ai = 0; ai < 2; ++ai)
#pragma unroll
                for (int m = 0; m < 4; ++m) { float* rp = small + (size_t)(row0 + ai * 128 + m * 16) * 32 + 8 * fq;
                    *(f32x4*)rp = acc[ai][0][m][0]; *(f32x4*)(rp + 4) = acc[ai][0][m][1]; }
        }
    }
};
__device__ __forceinline__ void p_inproj(Frame& F, int l) {
    SchedDense Sd; Sd.O.init(T / 256, 25, F.G, F.bid); Sd.A = (const char*)(F.ws + WS_U); Sd.B = (const char*)wsm(F.ws, l, WO_IN); Sd.tstep = (size_t)256 * D * 2;
    EpiInProj E{(bf16_t*)(F.ws + WS_PB), (float*)(F.ws + WS_SMALL)};
    pg8::gemm_phase<EpiInProj, SchedDense, false>(F.lds, D, Sd, E);
}


struct EpiSig { static constexpr bool PERM = true;
    bf16_t* PB; int pn_off;
    __device__ __forceinline__ void operator()(const f32x4 (&acc)[2][2][4][2], const pg8::Unit& u, int wr, int wc, int fr, int fq) const {
        const int row0 = u.pm * 256 + wr * 64 + fr, pn = u.pn + pn_off;
        bf16_t* base = PB + (size_t)(pn >> 2) * (PB_STRIDE / 2) + (pn & 3) * 256 + wc * 32 + 8 * fq;
#pragma unroll
        for (int ai = 0; ai < 2; ++ai)
#pragma unroll
            for (int m = 0; m < 4; ++m) { bf16_t* rowp = base + (size_t)(row0 + ai * 128 + m * 16) * D;
#pragma unroll
                for (int bj = 0; bj < 2; ++bj) { const f32x4 v0 = acc[ai][bj][m][0], v1 = acc[ai][bj][m][1];
                    u32x4 w; w.x = cvt_pk_bf16(fsigmoid(v0[0]), fsigmoid(v0[1])); w.y = cvt_pk_bf16(fsigmoid(v0[2]), fsigmoid(v0[3]));
                    w.z = cvt_pk_bf16(fsigmoid(v1[0]), fsigmoid(v1[1])); w.w = cvt_pk_bf16(fsigmoid(v1[2]), fsigmoid(v1[3]));
                    *(u32x4*)(rowp + bj * 128) = w; } }
    }
};
__device__ __forceinline__ unsigned char* sb8_base(const unsigned char* sa8, int l, int pm) {
    const long offA = (long)(WS_WSM + (size_t)(1 - l) * WSM_STRIDE) - (long)WS_SA8, offB = (long)WS_SB8T - (long)((size_t)SB8_SPLIT * D) - (long)WS_SA8;
    return (unsigned char*)sa8 + (pm < SB8_SPLIT / 256 ? offA : offB);
}
struct EpiSig8 { static constexpr bool PERM = true;
    unsigned char* SA8; int l;
    __device__ __forceinline__ void operator()(const f32x4 (&acc)[2][2][4][2], const pg8::Unit& u, int wr, int wc, int fr, int fq) const {
        const int row0 = u.pm * 256 + wr * 64 + fr; unsigned char* base = (u.pn < 4 ? SA8 : sb8_base(SA8, l, u.pm)) + (u.pn & 3) * 256 + wc * 32 + 8 * fq;
#pragma unroll
        for (int ai = 0; ai < 2; ++ai)
#pragma unroll
            for (int m = 0; m < 4; ++m) { unsigned char* rowp = base + (size_t)(row0 + ai * 128 + m * 16) * D;
#pragma unroll
                for (int bj = 0; bj < 2; ++bj) { const f32x4 v0 = acc[ai][bj][m][0], v1 = acc[ai][bj][m][1];
                    u32x2 w;
                    w.x = (unsigned)(fsigmoid(v0[0]) * 255.f + 0.5f) | ((unsigned)(fsigmoid(v0[1]) * 255.f + 0.5f) << 8) | ((unsigned)(fsigmoid(v0[2]) * 255.f + 0.5f) << 16) | ((unsigned)(fsigmoid(v0[3]) * 255.f + 0.5f) << 24);
                    w.y = (unsigned)(fsigmoid(v1[0]) * 255.f + 0.5f) | ((unsigned)(fsigmoid(v1[1]) * 255.f + 0.5f) << 8) | ((unsigned)(fsigmoid(v1[2]) * 255.f + 0.5f) << 16) | ((unsigned)(fsigmoid(v1[3]) * 255.f + 0.5f) << 24);
                    *(u32x2*)(rowp + bj * 128) = w; } }
    }
};
__device__ __forceinline__ void p_gates_a_idle(Frame& F, int l) {
    SchedDense Sd; Sd.O.init(T / 256, 8, F.G - 128, F.bid - 128); Sd.A = (const char*)(F.ws + WS_U); Sd.B = (const char*)wsm(F.ws, l, WO_GAB); Sd.tstep = (size_t)256 * D * 2;
    EpiSig8 E{(unsigned char*)(F.ws + WS_SA8), l};
    pg8::gemm_phase<EpiSig8, SchedDense, false>(F.lds, D, Sd, E);
}
__device__ __forceinline__ void p_gates(Frame& F, int l) {
    if (F.G > 128) return;
    {
        SchedDense Sd; Sd.O.init(T / 256, 8, F.G, F.bid); Sd.A = (const char*)(F.ws + WS_U); Sd.B = (const char*)wsm(F.ws, l, WO_GAB); Sd.tstep = (size_t)256 * D * 2;
        EpiSig E{(bf16_t*)(F.ws + WS_PB), 0};
        pg8::gemm_phase<EpiSig, SchedDense, false>(F.lds, D, Sd, E);
    }
}
struct SchedY {
    pg8::TileOrder O; const char* A0; const char* A1; const char* B0; const char* B1; size_t tstep;
    __device__ bool next(int i, pg8::Unit& u) const { u.e = i & 1; return O.tile(i >> 1, u.pm, u.pn); }
    __device__ const char* a_ptr(const pg8::Unit& u) const { return (u.e ? A1 : A0) + (size_t)u.pm * tstep; }
    __device__ const char* b_ptr(const pg8::Unit& u) const { return (u.e ? B1 : B0) + (size_t)u.pn * tstep; }
    __device__ const int* a_rows(const pg8::Unit&) const { return nullptr; }
    unsigned char* pp = nullptr; __device__ void* probe_ptr() const { return pp; }
};
struct EpiY { static constexpr bool PERM = true;
    const bf16_t* SA; const bf16_t* SB; bf16_t* Y; const unsigned char* SA8; int l;
    __device__ __forceinline__ void operator()(const f32x4 (&acc)[2][2][4][2], const pg8::Unit& u, int wr, int wc, int fr, int fq) const {
        const int row0 = u.pm * 256 + wr * 64 + fr; const size_t colb = (size_t)u.pn * 256 + wc * 32 + 8 * fq;
        const bf16_t* G = u.e ? SB : SA;
        const unsigned char* G8 = SA8 ? (u.e ? sb8_base(SA8, l, u.pm) : SA8) : nullptr;
#pragma unroll
        for (int ai = 0; ai < 2; ++ai) {
            u32x2 g8[4][2]; u32x4 gb[4][2]; u32x4 yv[4][2];
#pragma unroll
            for (int m = 0; m < 4; ++m) { const size_t ro = (size_t)(row0 + ai * 128 + m * 16) * D + colb;
#pragma unroll
                for (int bj = 0; bj < 2; ++bj) {
                    if (G8) g8[m][bj] = *(const u32x2*)(G8 + ro + bj * 128); else gb[m][bj] = *(const u32x4*)(G + ro + bj * 128);
                    if (u.e) yv[m][bj] = *(const u32x4*)(Y + ro + bj * 128); } }
#pragma unroll
            for (int m = 0; m < 4; ++m) { const size_t ro = (size_t)(row0 + ai * 128 + m * 16) * D + colb;
#pragma unroll
                for (int bj = 0; bj < 2; ++bj) { const f32x4 v0 = acc[ai][bj][m][0], v1 = acc[ai][bj][m][1];
                    float r0, r1, r2, r3, r4, r5, r6, r7;
                    if (G8) { const u32x2 q8 = g8[m][bj]; const float k = 1.f / 255.f;
                        r0 = (float)(q8.x & 255u) * k * v0[0]; r1 = (float)((q8.x >> 8) & 255u) * k * v0[1]; r2 = (float)((q8.x >> 16) & 255u) * k * v0[2]; r3 = (float)(q8.x >> 24) * k * v0[3];
                        r4 = (float)(q8.y & 255u) * k * v1[0]; r5 = (float)((q8.y >> 8) & 255u) * k * v1[1]; r6 = (float)((q8.y >> 16) & 255u) * k * v1[2]; r7 = (float)(q8.y >> 24) * k * v1[3]; }
                    else { const u32x4 g = gb[m][bj];
                        r0 = bflo(g.x) * v0[0]; r1 = bfhi(g.x) * v0[1]; r2 = bflo(g.y) * v0[2]; r3 = bfhi(g.y) * v0[3]; r4 = bflo(g.z) * v1[0]; r5 = bfhi(g.z) * v1[1]; r6 = bflo(g.w) * v1[2]; r7 = bfhi(g.w) * v1[3]; }
                    if (u.e) { const u32x4 y = yv[m][bj];
                        r0 += bflo(y.x); r1 += bfhi(y.x); r2 += bflo(y.y); r3 += bfhi(y.y); r4 += bflo(y.z); r5 += bfhi(y.z); r6 += bflo(y.w); r7 += bfhi(y.w); }
                    u32x4 w; w.x = cvt_pk_bf16(r0, r1); w.y = cvt_pk_bf16(r2, r3); w.z = cvt_pk_bf16(r4, r5); w.w = cvt_pk_bf16(r6, r7);
                    *(u32x4*)(Y + ro + bj * 128) = w; } }
        }
    }
};
__device__ __forceinline__ void p_y(Frame& F, int l) {
    SchedY Sy; Sy.O.init(T / 256, 4, F.G, F.bid); Sy.A0 = (const char*)(F.ws + WS_PB + 2 * PB_STRIDE); Sy.A1 = (const char*)(F.ws + WS_PB + 5 * PB_STRIDE);
    Sy.B0 = (const char*)wsm(F.ws, l, WO_PA); Sy.B1 = (const char*)wsm(F.ws, l, WO_PB); Sy.tstep = (size_t)256 * D * 2;
    EpiY E{(const bf16_t*)(F.ws + WS_PB), (const bf16_t*)(F.ws + WS_PB + PB_STRIDE), (bf16_t*)(F.ws + WS_PB + 3 * PB_STRIDE), F.G > 128 ? (const unsigned char*)(F.ws + WS_SA8) : nullptr, l};
    pg8::gemm_phase<EpiY, SchedY, false>(F.lds, D, Sy, E);
}

struct EpiResid { static constexpr bool PERM = false;
    const float* hin; float* hout; const float* gate;
    __device__ __forceinline__ void operator()(const f32x4 (&acc)[2][2][4][2], const pg8::Unit& u, int wr, int wc, int fr, int fq) const {
        const int row0 = u.pm * 256 + wr * 64 + fr, col0 = u.pn * 256 + wc * 32 + 4 * fq;
        const int b = (u.pm * 256) / S;
        f32x4 gv[2][2];
#pragma unroll
        for (int bj = 0; bj < 2; ++bj)
#pragma unroll
            for (int n = 0; n < 2; ++n) gv[bj][n] = *(const f32x4*)(gate + (size_t)b * 6 * D + col0 + bj * 128 + n * 16);
#pragma unroll
        for (int ai = 0; ai < 2; ++ai)
#pragma unroll
            for (int m = 0; m < 4; ++m) { const size_t ro = (size_t)(row0 + ai * 128 + m * 16) * D + col0;
#pragma unroll
                for (int bj = 0; bj < 2; ++bj)
#pragma unroll
                    for (int n = 0; n < 2; ++n) { const f32x4 hv = *(const f32x4*)(hin + ro + bj * 128 + n * 16);
                        *(f32x4*)(hout + ro + bj * 128 + n * 16) = hv + gv[bj][n] * acc[ai][bj][m][n]; } }
    }
};
__device__ __forceinline__ void p_wo(const Args& a, Frame& F, int l) {
    SchedDense Sd; Sd.O.init(T / 256, 4, F.G, F.bid); Sd.A = (const char*)(F.ws + WS_PB + 3 * PB_STRIDE); Sd.B = (const char*)wsm(F.ws, l, WO_O); Sd.tstep = (size_t)256 * D * 2;
    EpiResid E{l == 0 ? a.in[I_X] : a.out, a.out, (const float*)(F.ws + WS_ADA) + (size_t)l * NB * 6 * D + 2 * D};
    pg8::gemm_phase<EpiResid, SchedDense, false>(F.lds, D, Sd, E);
}


constexpr size_t WS_IDENT = 165 * MiB;
constexpr size_t WS_Y2H = 166 * MiB;
constexpr int VTILES = NBLK + T / 256, VROWS = VTILES * 256;
constexpr size_t WS_HB = WS_Y2H + (size_t)VROWS * 1024;
constexpr size_t WS_MOE_END = WS_HB + (size_t)VROWS * 256 * 2;
static_assert(WS_MOE_END <= 622 * MiB, "moe overlay");

__device__ __forceinline__ void p_norm2(const Args& a, Frame& F, int l) {
    const float* ada = (const float*)(F.ws + WS_ADA) + (size_t)l * NB * 6 * D;
    int* ident = (int*)(F.ws + WS_IDENT); int* row_tok = (int*)(F.ws + WS_ROWTOK);
    for (int i = F.bid * NTHREADS + F.tid; i < NROWS; i += F.G * NTHREADS) { row_tok[i] = 0; if (i < T) ident[i] = i; }
    p_norm(F, a.out, a.in[I_NMOEW] + l * D, ada + 3 * D, ada + 4 * D, (bf16_t*)(F.ws + WS_U));
}
struct EpiLogits { static constexpr bool PERM = false; float* L;
    __device__ __forceinline__ void operator()(const f32x4 (&acc)[2][2][4][2], const pg8::Unit& u, int wr, int wc, int fr, int fq) const {
        if (wc >= 2) return;
        const int row0 = u.pm * 256 + wr * 64 + fr, col0 = wc * 32 + 4 * fq;
#pragma unroll
        for (int ai = 0; ai < 2; ++ai)
#pragma unroll
            for (int m = 0; m < 4; ++m) { float* rp = L + (size_t)(row0 + ai * 128 + m * 16) * NE + col0;
#pragma unroll
                for (int n = 0; n < 2; ++n) *(f32x4*)(rp + n * 16) = acc[ai][0][m][n]; }
    }
};
__device__ __forceinline__ void p_router(const Args& a, Frame& F, int l) {
    if (l == 0 && F.G > 128 && F.bid >= 128) {
        const int gw = (F.bid - 128) * NWAVES + F.wave, NGW = (F.G - 128) * NWAVES; LAS float* scr = (LAS float*)(F.lds + F.wave * 8704);
        for (int it = gw; it < SW_ITEMS; it += NGW) small_item(a, F.ws, 1, it, scr, F.lane);
        return;
    }
    SchedDense Sd; Sd.O.init(T / 256, 1, F.G, F.bid); Sd.A = (const char*)(F.ws + WS_U); Sd.B = (const char*)wsm(F.ws, l, WO_R); Sd.tstep = (size_t)256 * D * 2;
    EpiLogits E{(float*)(F.ws + WS_LOGITS)};
    pg8::gemm_phase<EpiLogits, SchedDense, false>(F.lds, D, Sd, E);
}
template <int CTRL> __device__ __forceinline__ float dpp_f(float v) { return __builtin_bit_cast(float, __builtin_amdgcn_update_dpp(0, __builtin_bit_cast(int, v), CTRL, 0xf, 0xf, true)); }
template <int CTRL> __device__ __forceinline__ int dpp_i(int v) { return __builtin_amdgcn_update_dpp(0, v, CTRL, 0xf, 0xf, true); }
__device__ __forceinline__ void p_topk(const Args& a, Frame& F, int l) {
    LAS int* lcnt = (LAS int*)(F.lds); LAS int* lbase = lcnt + 64;
    const float* logits = (const float*)(F.ws + WS_LOGITS); const float* router_b = a.in[I_RB] + l * NE;
    int* eidx = (int*)(F.ws + WS_EIDX); float* wts = (float*)(F.ws + WS_WTS); int* pos = (int*)(F.ws + WS_POS);
    int* gcnt = (int*)(F.ws + WS_CTL) + CW_CNT + l * 64;
    for (int blk = F.bid; blk < T / 128; blk += F.G) {
        __syncthreads();
        if (F.tid < 64) lcnt[F.tid] = 0;
        __syncthreads();
        const int t = blk * 128 + (F.tid >> 2), q = F.tid & 3;
        float sc[16], sel[16];
        { const f32x4* lg = (const f32x4*)(logits + (size_t)t * NE + 16 * q); const f32x4* rb = (const f32x4*)(router_b + 16 * q);
#pragma unroll
          for (int j4 = 0; j4 < 4; ++j4) { const f32x4 v = lg[j4], b = rb[j4];
              sc[4 * j4] = sigmoidf_(v.x); sc[4 * j4 + 1] = sigmoidf_(v.y); sc[4 * j4 + 2] = sigmoidf_(v.z); sc[4 * j4 + 3] = sigmoidf_(v.w);
              sel[4 * j4] = sc[4 * j4] + b.x; sel[4 * j4 + 1] = sc[4 * j4 + 1] + b.y; sel[4 * j4 + 2] = sc[4 * j4 + 2] + b.z; sel[4 * j4 + 3] = sc[4 * j4 + 3] + b.w; } }
        float gsm[2];
#pragma unroll
        for (int g = 0; g < 2; ++g) { float m1 = -INFINITY, m2 = -INFINITY;
#pragma unroll
            for (int j = 0; j < 8; ++j) { const float v = sel[g * 8 + j]; if (v > m1) { m2 = m1; m1 = v; } else if (v > m2) m2 = v; }
            gsm[g] = m1 + m2; }
        float gs[8];
        gs[0] = dpp_f<0x00>(gsm[0]); gs[1] = dpp_f<0x00>(gsm[1]); gs[2] = dpp_f<0x55>(gsm[0]); gs[3] = dpp_f<0x55>(gsm[1]);
        gs[4] = dpp_f<0xAA>(gsm[0]); gs[5] = dpp_f<0xAA>(gsm[1]); gs[6] = dpp_f<0xFF>(gsm[0]); gs[7] = dpp_f<0xFF>(gsm[1]);
        unsigned gmask = 0;
#pragma unroll
        for (int k = 0; k < 4; ++k) { int best = -1; float bv = -INFINITY;
#pragma unroll
            for (int g = 0; g < 8; ++g) if (!((gmask >> g) & 1u) && (best < 0 || gs[g] > bv)) { best = g; bv = gs[g]; }
            gmask |= 1u << best; }
        unsigned avail = (((gmask >> (2 * q)) & 1u) ? 0x00FFu : 0u) | (((gmask >> (2 * q + 1)) & 1u) ? 0xFF00u : 0u);
        int ei[TOPK]; float wv[TOPK]; float wsum = 0.f;
#pragma unroll
        for (int k = 0; k < TOPK; ++k) { float bv = -INFINITY, bs = 0.f; int bi = 64;
#pragma unroll
            for (int j = 0; j < 16; ++j) { const bool ok = ((avail >> j) & 1u) && (bi == 64 || sel[j] > bv); if (ok) { bv = sel[j]; bi = 16 * q + j; bs = sc[j]; } }
            { const float ov = dpp_f<0xB1>(bv), os = dpp_f<0xB1>(bs); const int oi = dpp_i<0xB1>(bi);
              const bool take = (oi < 64) && (bi == 64 || ov > bv || (ov == bv && oi < bi)); if (take) { bv = ov; bs = os; bi = oi; } }
            { const float ov = dpp_f<0x4E>(bv), os = dpp_f<0x4E>(bs); const int oi = dpp_i<0x4E>(bi);
              const bool take = (oi < 64) && (bi == 64 || ov > bv || (ov == bv && oi < bi)); if (take) { bv = ov; bs = os; bi = oi; } }
            ei[k] = bi; wv[k] = bs; wsum += bs;
            if ((bi >> 4) == q) avail &= ~(1u << (bi & 15)); }
        const int ea = q == 0 ? ei[0] : q == 1 ? ei[2] : q == 2 ? ei[4] : ei[6], eb = q == 0 ? ei[1] : q == 1 ? ei[3] : q == 2 ? ei[5] : ei[7];
        const float wa = q == 0 ? wv[0] : q == 1 ? wv[2] : q == 2 ? wv[4] : wv[6], wb = q == 0 ? wv[1] : q == 1 ? wv[3] : q == 2 ? wv[5] : wv[7];
        const int lpa = __hip_atomic_fetch_add(&lcnt[ea], 1, __ATOMIC_RELAXED, __HIP_MEMORY_SCOPE_WORKGROUP);
        const int lpb = __hip_atomic_fetch_add(&lcnt[eb], 1, __ATOMIC_RELAXED, __HIP_MEMORY_SCOPE_WORKGROUP);
        __syncthreads();
        if (F.tid < 64) lbase[F.tid] = atomicAdd(&gcnt[F.tid], lcnt[F.tid]);
        __syncthreads();
        { const int o = t * TOPK + 2 * q; const float sn = 2.5f / wsum;
          eidx[o] = ea; eidx[o + 1] = eb; wts[o] = wa * sn; wts[o + 1] = wb * sn; pos[o] = lbase[ea] + lpa; pos[o + 1] = lbase[eb] + lpb; }
    }
}
__device__ __forceinline__ int load_pend(Frame& F, int l, LAS int* pend) {
    const int* gcnt = (const int*)(F.ws + WS_CTL) + CW_CNT + l * 64;
    __syncthreads();
    if (F.tid < 64) {
        int v = (gcnt[F.tid] + 255) / 256 * 256;
#define DPP_ADDI(ctrl, rmask) v += __builtin_amdgcn_update_dpp(0, v, ctrl, rmask, 0xf, false)
        DPP_ADDI(0x111, 0xf); DPP_ADDI(0x112, 0xf); DPP_ADDI(0x114, 0xf); DPP_ADDI(0x118, 0xf); DPP_ADDI(0x142, 0xa); DPP_ADDI(0x143, 0xc);
#undef DPP_ADDI
        pend[F.tid] = v; }
    __syncthreads();
    const int ntiles = pend[NE - 1] / 256;
    LAS unsigned char* tile_e = (LAS unsigned char*)(pend + 64);
    for (int j = F.tid; j < ntiles; j += NTHREADS) { int lo_ = 0, hi_ = NE - 1;
        while (lo_ < hi_) { const int mid = (lo_ + hi_) >> 1; if (pend[mid] > j * 256) hi_ = mid; else lo_ = mid + 1; }
        tile_e[j] = (unsigned char)lo_; }
    __syncthreads();
    return ntiles;
}
__device__ __forceinline__ void p_fill(Frame& F, int l) {
    LAS int* pend = (LAS int*)(F.lds + MISC_OFF + 1024);
    load_pend(F, l, pend);
    const int* eidx = (const int*)(F.ws + WS_EIDX); int* pos = (int*)(F.ws + WS_POS); int* row_tok = (int*)(F.ws + WS_ROWTOK);
    for (int i = F.bid * NTHREADS + F.tid; i < NASSIGN; i += F.G * NTHREADS) {
        const int e = eidx[i]; const int dest = (e ? pend[e - 1] : 0) + pos[i];
        row_tok[dest] = i / TOPK; pos[i] = dest;
    }
}
struct SchedMoe1 {
    int G, c, ntiles; const LAS int* pend; const char* Ubase; const char* W13; const char* Ws13; const int* row_tok; const int* ident;
    __device__ bool next(int i, pg8::Unit& u) const {
        const int q = i * G + c; if (q >= 2 * (ntiles + T / 256)) return false;
        const int j = q >> 1; u.pn = q & 1;
        if (j < ntiles) { u.pm = j; u.e = ((const LAS unsigned char*)(pend + 64))[j]; } else { u.pm = NBLK + (j - ntiles); u.e = NE; }
        return true; }
    __device__ const char* a_ptr(const pg8::Unit&) const { return Ubase; }
    __device__ const char* b_ptr(const pg8::Unit& u) const { return (u.e < NE ? W13 + (size_t)u.e * 512 * D * 2 : Ws13) + (size_t)u.pn * 256 * D * 2; }
    __device__ const int* a_rows(const pg8::Unit& u) const { return u.e < NE ? row_tok + (size_t)u.pm * 256 : ident + (size_t)(u.pm - NBLK) * 256; }
    unsigned char* pp = nullptr; __device__ void* probe_ptr() const { return pp; }
};
struct EpiHb { static constexpr bool PERM = true; bf16_t* HB;
    __device__ __forceinline__ void operator()(const f32x4 (&acc)[2][2][4][2], const pg8::Unit& u, int wr, int wc, int fr, int fq) const {
        const int row0 = u.pm * 256 + wr * 64 + fr; bf16_t* base = HB + u.pn * 128 + wc * 32 + 8 * fq;
#pragma unroll
        for (int ai = 0; ai < 2; ++ai)
#pragma unroll
            for (int m = 0; m < 4; ++m) { const f32x4 a0 = acc[ai][0][m][0], a1 = acc[ai][0][m][1], b0 = acc[ai][1][m][0], b1 = acc[ai][1][m][1];
                u32x4 w; w.x = cvt_pk_bf16(fsilu(a0[0]) * b0[0], fsilu(a0[1]) * b0[1]); w.y = cvt_pk_bf16(fsilu(a0[2]) * b0[2], fsilu(a0[3]) * b0[3]);
                w.z = cvt_pk_bf16(fsilu(a1[0]) * b1[0], fsilu(a1[1]) * b1[1]); w.w = cvt_pk_bf16(fsilu(a1[2]) * b1[2], fsilu(a1[3]) * b1[3]);
                *(u32x4*)(base + (size_t)(row0 + ai * 128 + m * 16) * DE) = w; }
    }
};
__device__ __forceinline__ int vcu_of(const Frame& F) { return (F.G % 8 == 0) ? (F.bid % 8) * (F.G / 8) + F.bid / 8 : F.bid; }
__device__ __forceinline__ void p_gemm1(Frame& F, int l) {
    LAS int* pend = (LAS int*)(F.lds + MISC_OFF + 1024);
    const int ntiles = load_pend(F, l, pend);
    SchedMoe1 Sm{F.G, vcu_of(F), ntiles, pend, (const char*)(F.ws + WS_U), (const char*)(F.ws + WS_WEXP13), (const char*)wsm(F.ws, l, WO_S13), (const int*)(F.ws + WS_ROWTOK), (const int*)(F.ws + WS_IDENT)};
    EpiHb E{(bf16_t*)(F.ws + WS_HB)};
    pg8::gemm_phase<EpiHb, SchedMoe1, true>(F.lds, D, Sm, E);
}
struct SchedMoe2 {
    int G, c, ntiles; const LAS int* pend; const char* HB; const char* W2; const char* Ws2;
    __device__ bool next(int i, pg8::Unit& u) const {
        const int q = i * G + c; if (q >= 4 * (ntiles + T / 256)) return false;
        const int j = q >> 2; u.pn = q & 3;
        if (j < ntiles) { u.pm = j; u.e = ((const LAS unsigned char*)(pend + 64))[j]; } else { u.pm = NBLK + (j - ntiles); u.e = NE; }
        return true; }
    __device__ const char* a_ptr(const pg8::Unit& u) const { return HB + (size_t)u.pm * 256 * DE * 2; }
    __device__ const char* b_ptr(const pg8::Unit& u) const { return (u.e < NE ? W2 + (size_t)u.e * D * DE * 2 : Ws2) + (size_t)(256 * u.pn) * DE * 2; }
    __device__ const int* a_rows(const pg8::Unit&) const { return nullptr; }
    unsigned char* pp = nullptr; __device__ void* probe_ptr() const { return pp; }
};
struct EpiY2 { static constexpr bool PERM = true; unsigned char* Y;
    __device__ __forceinline__ void operator()(const f32x4 (&acc)[2][2][4][2], const pg8::Unit& u, int wr, int wc, int fr, int fq) const {
        const int row0 = u.pm * 256 + wr * 64 + fr; unsigned char* base = Y + u.pn * 256 + wc * 32 + 8 * fq;
#pragma unroll
        for (int ai = 0; ai < 2; ++ai)
#pragma unroll
            for (int m = 0; m < 4; ++m) { unsigned char* rowp = base + (size_t)(row0 + ai * 128 + m * 16) * D;
#pragma unroll
                for (int bj = 0; bj < 2; ++bj) { const f32x4 v0 = acc[ai][bj][m][0], v1 = acc[ai][bj][m][1];
                    int w0 = 0, w1 = 0;
                    w0 = __builtin_amdgcn_cvt_pk_fp8_f32(v0[0], v0[1], w0, false); w0 = __builtin_amdgcn_cvt_pk_fp8_f32(v0[2], v0[3], w0, true);
                    w1 = __builtin_amdgcn_cvt_pk_fp8_f32(v1[0], v1[1], w1, false); w1 = __builtin_amdgcn_cvt_pk_fp8_f32(v1[2], v1[3], w1, true);
                    u32x2 w; w.x = (unsigned)w0; w.y = (unsigned)w1;
                    *(u32x2*)(rowp + bj * 128) = w; } }
    }
};
template <> constexpr bool epi_probe_v<EpiY2> = true;
__device__ __forceinline__ void p_gemm2(Frame& F, int l) {
    LAS int* pend = (LAS int*)(F.lds + MISC_OFF + 1024);
    const int ntiles = load_pend(F, l, pend);
    SchedMoe2 Sm; Sm.G = F.G; Sm.c = vcu_of(F); Sm.ntiles = ntiles; Sm.pend = pend; Sm.HB = (const char*)(F.ws + WS_HB); Sm.W2 = (const char*)(F.ws + WS_WEXP2); Sm.Ws2 = (const char*)wsm(F.ws, l, WO_S2);
    Sm.pp = F.ws + WS_CTL + 4 * CW_STAMP + 8 * 56;
    EpiY2 E{(unsigned char*)(F.ws + WS_Y2H)};
    pg8::gemm_phase<EpiY2, SchedMoe2, false, false>(F.lds, DE, Sm, E);
}
__device__ __forceinline__ void acc_fp8x16(float (&acc)[16], const u32x4 v, float w) {
    const unsigned wd[4] = {v.x, v.y, v.z, v.w};
#pragma unroll
    for (int i = 0; i < 4; ++i) { const f32x2 lo = __builtin_amdgcn_cvt_pk_f32_fp8((int)wd[i], false), hi = __builtin_amdgcn_cvt_pk_f32_fp8((int)wd[i], true);
        acc[4 * i] += w * lo.x; acc[4 * i + 1] += w * lo.y; acc[4 * i + 2] += w * hi.x; acc[4 * i + 3] += w * hi.y; }
}
template <bool FINAL>
__device__ __forceinline__ void p_combine(const Args& a, Frame& F, int l) {
    const int gw = F.bid * NWAVES + F.wave, NGW = F.G * NWAVES, RPW = (T + NGW - 1) / NGW;
    const int r0 = gw * RPW, r1 = (r0 + RPW < T) ? r0 + RPW : T;
    const unsigned char* Y = (const unsigned char*)(F.ws + WS_Y2H) + 4 * F.lane; const int* slots = (const int*)(F.ws + WS_POS); const float* wts = (const float*)(F.ws + WS_WTS);
    const float* gt = (const float*)(F.ws + WS_ADA) + (size_t)l * NB * 6 * D + 5 * D + 4 * F.lane;
    f32x4 gv[4], fw[4]; int bcur = -1;
    if (FINAL) {
#pragma unroll
        for (int j = 0; j < 4; ++j) fw[j] = *(const f32x4*)(a.in[I_FNW] + 256 * j + 4 * F.lane); }
    for (int t = r0; t < r1; ++t) {
        const int b = t / S;
        if (b != bcur) { bcur = b;
#pragma unroll
            for (int j = 0; j < 4; ++j) gv[j] = *(const f32x4*)(gt + (size_t)b * 6 * D + 256 * j); }
        float acc[16];
#pragma unroll
        for (int i = 0; i < 16; ++i) acc[i] = 0.f;
        { const unsigned char* yr = Y + ((size_t)NBLK * 256 + t) * D; u32x4 v; v.x = *(const unsigned*)yr; v.y = *(const unsigned*)(yr + 256); v.z = *(const unsigned*)(yr + 512); v.w = *(const unsigned*)(yr + 768);
          acc_fp8x16(acc, v, 1.f); }
#pragma unroll
        for (int k = 0; k < TOPK; ++k) { const int slot = slots[t * TOPK + k]; const float w = wts[t * TOPK + k];
            const unsigned char* yr = Y + (size_t)slot * D; u32x4 v; v.x = *(const unsigned*)yr; v.y = *(const unsigned*)(yr + 256); v.z = *(const unsigned*)(yr + 512); v.w = *(const unsigned*)(yr + 768);
            acc_fp8x16(acc, v, w); }
        float* o = a.out + (size_t)t * D + 4 * F.lane;
        f32x4 ov[4]; float ss = 0.f;
#pragma unroll
        for (int j = 0; j < 4; ++j) {
            ov[j] = *(const f32x4*)(o + 256 * j) + gv[j] * (f32x4){acc[4 * j], acc[4 * j + 1], acc[4 * j + 2], acc[4 * j + 3]};
            ss += (ov[j].x * ov[j].x + ov[j].y * ov[j].y) + (ov[j].z * ov[j].z + ov[j].w * ov[j].w); }
        if (FINAL) {
            const float r = rsqrtf(wave_sum(ss) * (1.f / D) + EPS);
#pragma unroll
            for (int j = 0; j < 4; ++j) *(f32x4*)(o + 256 * j) = ov[j] * r * fw[j];
        } else {
#pragma unroll
            for (int j = 0; j < 4; ++j) *(f32x4*)(o + 256 * j) = ov[j];
        }
    }
}
__device__ __forceinline__ void p_expert_cvt(const Args& a, Frame& F, int l) {
    const int gw = F.bid * NWAVES + F.wave, NGW = F.G * NWAVES;
    LAS float* scr = (LAS float*)(F.lds + F.wave * 8704);
    for (int it = gw; it < EX_ITEMS; it += NGW) expert_item(a, F.ws, l, it, scr, F.lane);
}
#if defined(MK_TEST_MIXERS) || defined(MK_PROBE)
__device__ __forceinline__ void p_final_scale(const Args& a, Frame& F) {
    const int gw = F.bid * NWAVES + F.wave, NGW = F.G * NWAVES;
    for (int row = gw; row < T; row += NGW) {
        f32x4* xr = (f32x4*)(a.out + (size_t)row * D) + F.lane;
#if defined(MK_TEST_MIXERS)
        const float* err = (const float*)(F.ws + WS_CTL) + CW_ERR; const float amp = (sqrtf(err[2] / fmaxf(err[3], 1e-30f)) > MK_TEST_THR) ? 2.f : 1.f; const float fb = 0.f;
#else
        float amp; float fb;
        { const unsigned long long* st = (const unsigned long long*)(F.ws + WS_CTL + 4 * CW_STAMP) + MK_PROBE_BASE; float tot = 0.f, sa = 0.f, sb = 0.f;
          for (int i = 0; i < 6; ++i) { const float d = (float)st[i]; tot += d; if ((MK_PROBE_A >> i) & 1ull) sa += d; if ((MK_PROBE_B >> i) & 1ull) sb += d; }
          amp = 2.f + floorf(16.f * sa / tot + 0.5f) * (1.f / 16.f); fb = 100.f + 50.f * floorf(16.f * sb / tot + 0.5f); }
#endif
#pragma unroll
        for (int j = 0; j < 4; ++j) xr[64 * j] = xr[64 * j] * amp;
#if defined(MK_PROBE)
        if (row == 0 && F.lane == 0) a.out[0] = fb;
#endif
    }
}
#endif

__device__ __forceinline__ void mlstm_seq(const Args& a, Frame& F, int l, int b, int hd, bf16_t* OUT, int opitch) {
    LAS float* qs = (LAS float*)F.lds; LAS float* ks = qs + 128; LAS float* ns = ks + 128; LAS float* sc = ns + 128; LAS float* pn = sc + 8; LAS float* pd = pn + 512; LAS float* red = pd + 512;
    const int tid = F.tid, e = tid & 255, dh = tid >> 8;
    const bf16_t* QK = (const bf16_t*)(F.ws + WS_PB) + (size_t)b * S * D; const bf16_t* VM = (const bf16_t*)(F.ws + WS_PB + PB_STRIDE) + (size_t)b * S * D;
    bf16_t* OM = (bf16_t*)(F.ws + WS_PB + 2 * PB_STRIDE) + (size_t)b * S * D; const float* SM = (const float*)(F.ws + WS_SMALL) + (size_t)b * S * 32;
    const float* conv_w = a.in[I_CONVW] + (size_t)l * 4 * 1024; const float* gate_b = a.in[I_GATEB] + l * 8;
    float Cst[64];
#pragma unroll
    for (int d = 0; d < 64; ++d) Cst[d] = 0.f;
    if (tid < 128) ns[tid] = 0.f;
    float m_run = 0.f;
    const int col = (tid < 128) ? (512 + hd * 128 + tid) : (hd * 128 + ((tid - 128) & 127));
    const float w0 = conv_w[0 * 1024 + col], w1 = conv_w[1 * 1024 + col], w2 = conv_w[2 * 1024 + col], w3 = conv_w[3 * 1024 + col];
    const float gbi = gate_b[hd], gbf = gate_b[4 + hd], mnw = a.in[I_MNORMW][l * D + hd * 256 + e];
    float x0 = 0.f, x1 = 0.f, x2 = 0.f;
    for (int t = 0; t < S; ++t) {
        float cv = 0.f;
        if (tid < 256) { const float x3 = bf2f(QK[(size_t)t * D + col]); cv = siluf_(w0 * x0 + w1 * x1 + w2 * x2 + w3 * x3); x0 = x1; x1 = x2; x2 = x3; }
        __syncthreads();
        if (tid < 128) ks[tid] = cv; else if (tid < 256) qs[tid - 128] = cv * 0.08838834764831845f;
        if (tid == 256) {
            const float li = 15.f * tanhf((SM[t * 32 + hd] + gbi) * (1.f / 15.f));
            const float lf = logsigmoidf_(15.f * tanhf((SM[t * 32 + 4 + hd] + gbf) * (1.f / 15.f)));
            const float m_new = fmaxf(lf + m_run, li);
            sc[0] = __expf(lf + m_run - m_new); sc[1] = __expf(li - m_new); sc[2] = __expf(-m_new); m_run = m_new;
        }
        __syncthreads();
        const float fd = sc[0], id = sc[1], lowb = sc[2];
        if (tid < 128) ns[tid] = fd * ns[tid] + id * ks[tid];
        __syncthreads();
        const float v = bf2f(VM[(size_t)t * D + hd * 256 + e]) * id;
        float num = 0.f, den = 0.f;
#pragma unroll
        for (int d = 0; d < 64; ++d) { const int dd = dh * 64 + d; Cst[d] = fd * Cst[d] + ks[dd] * v; num += qs[dd] * Cst[d]; den += qs[dd] * ns[dd]; }
        pn[dh * 256 + e] = num; pd[dh * 256 + e] = den;
        __syncthreads();
        float h = 0.f;
        if (dh == 0) { num = pn[e] + pn[256 + e]; den = pd[e] + pd[256 + e]; h = num / fmaxf(fabsf(den), lowb); const float ss = wave_sum(h * h); if (F.lane == 0) red[F.wave] = ss; }
        __syncthreads();
        if (dh == 0) { const float r = rsqrtf((red[0] + red[1] + red[2] + red[3]) * (1.f / 256.f) + EPS); const size_t idx = (size_t)t * D + hd * 256 + e;
            OUT[(size_t)t * opitch + e] = (bf16_t)f2bf(h * r * mnw * bf2f(OM[idx])); }
    }
}
__device__ __forceinline__ void gla_seq(const Args& a, Frame& F, int l, int b, int hd, bf16_t* OUT, int opitch) {
    LAS float* qs = (LAS float*)F.lds; LAS float* ks = qs + 128; LAS float* as = ks + 128; LAS float* pn = as + 128 + 8; LAS float* red = pn + 512;
    const int tid = F.tid, e = tid & 255, dh = tid >> 8;
    const bf16_t* QKG = (const bf16_t*)(F.ws + WS_PB + 3 * PB_STRIDE) + (size_t)b * S * D; const bf16_t* VG = (const bf16_t*)(F.ws + WS_PB + 4 * PB_STRIDE) + (size_t)b * S * D;
    bf16_t* ZG = (bf16_t*)(F.ws + WS_PB + 5 * PB_STRIDE) + (size_t)b * S * D; const float* SM = (const float*)(F.ws + WS_SMALL) + (size_t)b * S * 32;
    const float* alpha_w = a.in[I_ALPHAW] + (size_t)l * 16 * 512; const float* alpha_b = a.in[I_ALPHAB] + l * 512;
    float Sst[64];
#pragma unroll
    for (int d = 0; d < 64; ++d) Sst[d] = 0.f;
    float aw[16]; float ab = 0.f;
#pragma unroll
    for (int r = 0; r < 16; ++r) aw[r] = alpha_w[r * 512 + hd * 128 + (tid & 127)];
    ab = alpha_b[hd * 128 + (tid & 127)];
    const float gnw = a.in[I_GNORMW][l * D + hd * 256 + e];
    for (int t = 0; t < S; ++t) {
        __syncthreads();
        if (tid < 128) {
            float x = ab;
#pragma unroll
            for (int r = 0; r < 16; ++r) x += SM[t * 32 + 8 + r] * aw[r];
            as[tid] = __expf(logsigmoidf_(x) * (1.f / 16.f));
            ks[tid] = bf2f(QKG[(size_t)t * D + 512 + hd * 128 + tid]);
        } else if (tid < 256) qs[tid - 128] = bf2f(QKG[(size_t)t * D + hd * 128 + tid - 128]) * 0.08838834764831845f;
        __syncthreads();
        const float v = bf2f(VG[(size_t)t * D + hd * 256 + e]);
        float o = 0.f;
#pragma unroll
        for (int d = 0; d < 64; ++d) { const int dd = dh * 64 + d; Sst[d] = as[dd] * Sst[d] + ks[dd] * v; o += qs[dd] * Sst[d]; }
        pn[dh * 256 + e] = o;
        __syncthreads();
        float h = 0.f;
        if (dh == 0) { h = pn[e] + pn[256 + e]; const float ss = wave_sum(h * h); if (F.lane == 0) red[F.wave] = ss; }
        __syncthreads();
        if (dh == 0) { const float r = rsqrtf((red[0] + red[1] + red[2] + red[3]) * (1.f / 256.f) + EPS); const size_t idx = (size_t)t * D + hd * 256 + e;
            OUT[(size_t)t * opitch + e] = (bf16_t)f2bf(h * r * gnw * bf2f(ZG[idx])); }
    }
}
__device__ __forceinline__ void p_mixers_seq(const Args& a, Frame& F, int l) {
    for (int s = F.bid; s < 128; s += F.G) {
        __syncthreads();
        if (s < 64) mlstm_seq(a, F, l, s >> 2, s & 3, (bf16_t*)(F.ws + WS_PB + 2 * PB_STRIDE) + (size_t)(s >> 2) * S * D + (s & 3) * 256, D);
        else gla_seq(a, F, l, (s - 64) >> 2, s & 3, (bf16_t*)(F.ws + WS_PB + 5 * PB_STRIDE) + (size_t)((s - 64) >> 2) * S * D + (s & 3) * 256, D);
    }
}

typedef float f32x16 __attribute__((ext_vector_type(16)));
typedef short s16x4 __attribute__((ext_vector_type(4)));
#define MFMA32(a, b, c) __builtin_amdgcn_mfma_f32_32x32x16_bf16((a), (b), (c), 0, 0, 0)
#define MFMA16(a, b, c) __builtin_amdgcn_mfma_f32_16x16x32_bf16((a), (b), (c), 0, 0, 0)
constexpr int MX_QS = 272, MX_VS = 528, MX_PS = 144, MX_BS = 528;
constexpr int MX_Q = 0, MX_K = MX_Q + 64 * MX_QS, MX_KU = MX_K + 64 * MX_QS, MX_V = MX_KU + 64 * MX_QS, MX_P = MX_V + 64 * MX_VS, MX_BC = MX_P + 64 * MX_PS, MX_END = MX_BC + 64 * MX_BS;
static_assert(MX_END + 1024 <= RING_BYTES, "mixer LDS map");
constexpr int MX_SM = MISC_OFF + 2048;
constexpr int SM_COLT = 0, SM_ROWT = 64, SM_WINT = 128, SM_WKS = 192, SM_ELOW = 256, SM_DEN = 320, SM_QN = 384, SM_SSQ = 896, SM_N = 1408, SM_NACC = 1536, SM_EGC = 1664, SM_GC = 1792, SM_SCAL = 1920, SM_QTOT = 1936, SM_ENDF = 1936 + 512;
static_assert(MX_SM + SM_ENDF * 4 <= LDS_BYTES, "mixer small arrays");

__device__ __forceinline__ unsigned tr_lane_off(int stride, int lane) {
    const int i16 = lane & 15, q = i16 >> 2, p = i16 & 3, blk = (lane >> 4) & 1, h = lane >> 5;
    return (unsigned)((8 * h + q) * stride + (16 * blk + 4 * p) * 2);
}
template <int OFF, int STEP, int HALF4>
__device__ __forceinline__ void tr_frag_x4(unsigned lane_addr, bf16x8 (&f)[4]) {
    s16x4 a0, a1, b0, b1, c0, c1, d0, d1;
    asm volatile("ds_read_b64_tr_b16 %0, %8 offset:%9\n\tds_read_b64_tr_b16 %1, %8 offset:%10\n\tds_read_b64_tr_b16 %2, %8 offset:%11\n\tds_read_b64_tr_b16 %3, %8 offset:%12\n\t"
                 "ds_read_b64_tr_b16 %4, %8 offset:%13\n\tds_read_b64_tr_b16 %5, %8 offset:%14\n\tds_read_b64_tr_b16 %6, %8 offset:%15\n\tds_read_b64_tr_b16 %7, %8 offset:%16\n\ts_waitcnt lgkmcnt(0)"
                 : "=&v"(a0), "=&v"(a1), "=&v"(b0), "=&v"(b1), "=&v"(c0), "=&v"(c1), "=&v"(d0), "=&v"(d1)
                 : "v"(lane_addr), "i"(OFF), "i"(OFF + HALF4), "i"(OFF + STEP), "i"(OFF + STEP + HALF4), "i"(OFF + 2 * STEP), "i"(OFF + 2 * STEP + HALF4), "i"(OFF + 3 * STEP), "i"(OFF + 3 * STEP + HALF4) : "memory");
    f[0] = __builtin_shufflevector(a0, a1, 0, 1, 2, 3, 4, 5, 6, 7); f[1] = __builtin_shufflevector(b0, b1, 0, 1, 2, 3, 4, 5, 6, 7);
    f[2] = __builtin_shufflevector(c0, c1, 0, 1, 2, 3, 4, 5, 6, 7); f[3] = __builtin_shufflevector(d0, d1, 0, 1, 2, 3, 4, 5, 6, 7);
}
__device__ __forceinline__ bf16x8 pack_acc(const f32x16& x, int s) {
    u32x4 p;
    if (s == 0) { p.x = cvt_pk_bf16(x[0], x[1]); p.y = cvt_pk_bf16(x[2], x[3]); p.z = cvt_pk_bf16(x[4], x[5]); p.w = cvt_pk_bf16(x[6], x[7]); }
    else { p.x = cvt_pk_bf16(x[8], x[9]); p.y = cvt_pk_bf16(x[10], x[11]); p.z = cvt_pk_bf16(x[12], x[13]); p.w = cvt_pk_bf16(x[14], x[15]); }
    return __builtin_bit_cast(bf16x8, p);
}
__device__ __forceinline__ u32x4 pack8(const float (&y)[8]) { u32x4 o; o.x = cvt_pk_bf16(y[0], y[1]); o.y = cvt_pk_bf16(y[2], y[3]); o.z = cvt_pk_bf16(y[4], y[5]); o.w = cvt_pk_bf16(y[6], y[7]); return o; }
__device__ __forceinline__ float wave_max(float v) {
#pragma unroll
    for (int o = 1; o < 64; o <<= 1) v = fmaxf(v, __shfl_xor(v, o));
    return v;
}
__device__ __forceinline__ unsigned tr_lane_off_v(int stride, int lane) {
    const int i16 = lane & 15, q = i16 >> 2, p = i16 & 3, blk = (lane >> 4) & 1, h = lane >> 5;
    return (unsigned)((8 * h + q) * stride + (16 * (p & 1) + 8 * blk + 4 * (p >> 1)) * 2);
}
__device__ __forceinline__ void load_vf(LAS unsigned char* lds, int lane, int wave, bf16x8 (&vf)[4]) {
    const unsigned la = (unsigned)(unsigned long)(lds) + MX_V + tr_lane_off_v(MX_VS, lane) + (unsigned)(64 * wave);
    tr_frag_x4<0, 16 * MX_VS, 4 * MX_VS>(la, vf);
}
template <bool ONE_ACC>
__device__ __forceinline__ void chunk_out(LAS unsigned char* lds, int lane, int lt, const f32x16 (&C)[4], const bf16x8 (&vf)[4], f32x16& a1, f32x16& a2) {
    const int h = lane >> 5, l31 = lane & 31;
#pragma unroll
    for (int i = 0; i < 16; ++i) { a1[i] = 0.f; a2[i] = 0.f; }
    const LAS unsigned char* prow = lds + MX_P + (32 * lt + l31) * MX_PS + 16 * h;
#pragma unroll
    for (int ss = 0; ss < 4; ++ss) { const bf16x8 pb = *(const LAS bf16x8*)(prow + 32 * ss); a1 = MFMA32(vf[ss], pb, a1); }
    const LAS unsigned char* qrow = lds + MX_Q + (32 * lt + l31) * MX_QS + 8 * h;
#pragma unroll
    for (int dt = 0; dt < 4; ++dt)
#pragma unroll
        for (int sp = 0; sp < 2; ++sp) {
            const bf16x8 xa = pack_acc(C[dt], sp);
            const u32x2 q0 = *(const LAS u32x2*)(qrow + (32 * dt + 16 * sp) * 2), q1 = *(const LAS u32x2*)(qrow + (32 * dt + 16 * sp + 8) * 2);
            u32x4 qq; qq.x = q0.x; qq.y = q0.y; qq.z = q1.x; qq.w = q1.y;
            if (ONE_ACC) a1 = MFMA32(xa, __builtin_bit_cast(bf16x8, qq), a1); else a2 = MFMA32(xa, __builtin_bit_cast(bf16x8, qq), a2);
        }
}
template <int DT>
__device__ __forceinline__ void chunk_update_dt(unsigned la, f32x16& Cd, const bf16x8 (&vf)[4]) {
    bf16x8 ka[4]; tr_frag_x4<DT * 64, 16 * MX_QS, 4 * MX_QS>(la, ka);
    Cd = MFMA32(ka[0], vf[0], Cd); Cd = MFMA32(ka[1], vf[1], Cd); Cd = MFMA32(ka[2], vf[2], Cd); Cd = MFMA32(ka[3], vf[3], Cd);
}
__device__ __forceinline__ void chunk_update(LAS unsigned char* lds, int lane, f32x16 (&C)[4], const bf16x8 (&vf)[4]) {
    const unsigned la = (unsigned)(unsigned long)(lds) + MX_KU + tr_lane_off(MX_QS, lane);
    chunk_update_dt<0>(la, C[0], vf); chunk_update_dt<1>(la, C[1], vf); chunk_update_dt<2>(la, C[2], vf); chunk_update_dt<3>(la, C[3], vf);
}
template <bool MLSTM>
__device__ __forceinline__ void chunk_scores(LAS unsigned char* lds, LAS float* sm, int lane, int wave) {
    const int st = wave & 3, r16 = lane & 15, q4 = lane >> 4;
    bf16x8 ka[4];
    const LAS unsigned char* krow = lds + MX_K + (16 * st + r16) * MX_QS + 16 * q4;
#pragma unroll
    for (int ks = 0; ks < 4; ++ks) ka[ks] = *(const LAS bf16x8*)(krow + 64 * ks);
#pragma unroll
    for (int t = 0; t < 2; ++t) {
        const int lt = 2 * (wave >> 2) + t, l = 16 * lt + r16;
        f32x4 acc = (f32x4){0.f, 0.f, 0.f, 0.f};
        if (st <= lt) {
            const LAS unsigned char* qrow = lds + MX_Q + l * MX_QS + 16 * q4;
#pragma unroll
            for (int ks = 0; ks < 4; ++ks) { const bf16x8 qb = *(const LAS bf16x8*)(qrow + 64 * ks); acc = MFMA16(ka[ks], qb, acc); }
        }
        float v[4]; float rs = 0.f;
        const float rt = MLSTM ? sm[SM_ROWT + l] : 0.f;
#pragma unroll
        for (int r = 0; r < 4; ++r) { const int s = 16 * st + 4 * q4 + r;
            float x = acc[r];
            if (MLSTM) x *= __expf(fminf(rt + sm[SM_COLT + s], 30.f));
            v[r] = (s <= l) ? x : 0.f; rs += v[r]; }
        u32x2 pk; pk.x = cvt_pk_bf16(v[0], v[1]); pk.y = cvt_pk_bf16(v[2], v[3]);
        *(LAS u32x2*)(lds + MX_P + l * MX_PS + (16 * st + 4 * q4) * 2) = pk;
        if (MLSTM) { rs += __shfl_xor(rs, 16); rs += __shfl_xor(rs, 32); if (q4 == 0) sm[SM_QTOT + st * 64 + l] = rs; }
    }
}
__device__ __forceinline__ void stage_v(LAS unsigned char* lds, const bf16_t* V, int t0, int tid) {
    const int row = tid >> 3, pc = (tid & 7) * 4;
    const u32x4* src = (const u32x4*)(V + (size_t)(t0 + row) * D) + pc;
#pragma unroll
    for (int i = 0; i < 4; ++i) *(LAS u32x4*)(lds + MX_V + row * MX_VS + (pc + i) * 16) = src[i];
}
#define MX_SYNC() do { asm volatile("s_waitcnt vmcnt(0) lgkmcnt(0)" ::: "memory"); __builtin_amdgcn_s_barrier(); asm volatile("" ::: "memory"); } while (0)
#if defined(MK_TPROBE)
#define MX_NOW() __builtin_amdgcn_s_memrealtime()
#else
#define MX_NOW() __builtin_amdgcn_s_memtime()
#endif
#if defined(MK_PROBE) || defined(MK_TPROBE)
#define MX_PROBE_ON 1
#define MX_T(k) do { const unsigned long long now_ = MX_NOW(); tacc[k] += now_ - tlast; tlast = now_; } while (0)
#else
#define MX_T(k) do { } while (0)
#endif
#define MX_BAR() do { asm volatile("s_waitcnt lgkmcnt(0)" ::: "memory"); __builtin_amdgcn_s_barrier(); asm volatile("" ::: "memory"); } while (0)
#define MX_VWAIT0() asm volatile("s_waitcnt vmcnt(0)" ::: "memory")
__device__ __forceinline__ void dma16(const void* g, LAS unsigned char* ldst) { __builtin_amdgcn_global_load_lds((const unsigned*)g, (LAS unsigned*)ldst, 16, 0, 0); }
__device__ __forceinline__ void dma_v(LAS unsigned char* lds, const bf16_t* V, int t0, int wave, int lane) {
    asm volatile("" : "+v"(lane));
#pragma unroll
    for (int j = 0; j < 5; ++j) { const int k = wave + 8 * j;
        if (k < 33) { const int o = 1024 * k + 16 * lane, row = o / MX_VS; int cb = o - row * MX_VS; if (cb >= 512) cb = 0;
            dma16((const char*)(V + (size_t)(t0 + row) * D) + cb, lds + MX_V + 1024 * k); } }
}
__device__ __forceinline__ void dma_qk(LAS unsigned char* lds, int img_off, const bf16_t* src, int t0, int wave, int lane) {
    asm volatile("" : "+v"(lane));
#pragma unroll
    for (int j = 0; j < 3; ++j) { const int k = wave + 8 * j;
        if (k < 17) { const int o = 1024 * k + 16 * lane, row = o / MX_QS; int cb = o - row * MX_QS; if (cb >= 256) cb = 0;
            dma16((const char*)(src + (size_t)(t0 + row) * D) + cb, lds + img_off + 1024 * k); } }
}
constexpr int MX_RAWA = MX_BC + 12288, MX_RAWB = 147456;
static_assert(MX_RAWA + 42 * 512 <= MX_END && MX_RAWB + 26 * 512 <= LDS_BYTES && MX_SM + SM_ENDF * 4 <= MX_RAWB, "mLSTM raw rows");
__device__ __forceinline__ void dma_raw_m(LAS unsigned char* lds, const bf16_t* QK, int hd, int t0, int wave, int lane) {
    asm volatile("" : "+v"(lane));
    const int p = lane & 31, col = (p < 16) ? hd * 128 + 8 * p : 512 + hd * 128 + 8 * (p - 16);
#pragma unroll
    for (int j = 0; j < 5; ++j) { const int k = wave + 8 * j;
        if (k < 34) { int tok = t0 - 3 + 2 * k + (lane >> 5); tok = tok < 0 ? 0 : (tok > S - 1 ? S - 1 : tok);
            dma16(QK + (size_t)tok * D + col, lds + (k < 21 ? MX_RAWA + 1024 * k : MX_RAWB + 1024 * (k - 21))); } }
}

__device__ __forceinline__ float wave_scan_add(float x) {
    float v = x;
#define DPP_ADD(ctrl, rmask) v += __builtin_bit_cast(float, __builtin_amdgcn_update_dpp(0, __builtin_bit_cast(int, v), ctrl, rmask, 0xf, false))
    DPP_ADD(0x111, 0xf); DPP_ADD(0x112, 0xf); DPP_ADD(0x114, 0xf); DPP_ADD(0x118, 0xf); DPP_ADD(0x142, 0xa); DPP_ADD(0x143, 0xc);
#undef DPP_ADD
    return v;
}
__device__ __forceinline__ void mlstm_gates(LAS float* sm, int lane, float pim, float pfm, float gbi, float gbf) {
    const float li = 15.f * ftanh((pim + gbi) * (1.f / 15.f));
    const float lf = flogsigmoid(15.f * ftanh((pfm + gbf) * (1.f / 15.f)));
    const float bc = wave_scan_add(lf);
    const float g = __builtin_bit_cast(float, __builtin_amdgcn_readlane(__builtin_bit_cast(int, bc), 63));
    sm[SM_COLT + lane] = li - bc; sm[SM_ROWT + lane] = bc; sm[SM_WINT + lane] = __expf(bc); sm[SM_WKS + lane] = __expf(g - bc + li); sm[SM_ELOW + lane] = 1.f;
    if (lane == 0) sm[SM_SCAL] = __expf(g);
}
__device__ __forceinline__ void mlstm_chunked(const Args& a, Frame& F, int l, int b, int hd, bf16_t* OUT) {
    LAS unsigned char* lds = F.lds; LAS float* sm = (LAS float*)(F.lds + MX_SM);
    const int tid0 = F.tid, wave = F.wave;
    const bf16_t* QK = (const bf16_t*)(F.ws + WS_PB) + (size_t)b * S * D; const bf16_t* VM = (const bf16_t*)(F.ws + WS_PB + PB_STRIDE) + (size_t)b * S * D + hd * 256;
    const bf16_t* OM = (const bf16_t*)(F.ws + WS_PB + 2 * PB_STRIDE) + (size_t)b * S * D + hd * 256; const float* SMALL = (const float*)(F.ws + WS_SMALL) + (size_t)b * S * 32;
    bf16_t* O = OUT + (size_t)b * S * D + hd * 256;
    const float* conv_w = a.in[I_CONVW] + (size_t)l * 4 * 1024; const float gbi = a.in[I_GATEB][l * 8 + hd], gbf = a.in[I_GATEB][l * 8 + 4 + hd];
    LAS float* cwt = (LAS float*)(F.lds + MX_BC);
    LAS float* nwt = (LAS float*)(F.lds + MX_END);
    for (int i = tid0; i < 1024; i += NTHREADS) { const int tp = i >> 8, cc = i & 255; cwt[i] = conv_w[tp * 1024 + (cc < 128 ? hd * 128 + cc : 512 + hd * 128 + cc - 128)]; }
    if (tid0 < 256) nwt[tid0] = a.in[I_MNORMW][l * D + hd * 256 + tid0];
    f32x16 C[4];
#pragma unroll
    for (int dt = 0; dt < 4; ++dt)
#pragma unroll
        for (int i = 0; i < 16; ++i) C[dt][i] = 0.f;
    if (tid0 < 128) sm[SM_N + tid0] = 0.f;
    float pim = SMALL[(size_t)(tid0 & 63) * 32 + hd], pfm = SMALL[(size_t)(tid0 & 63) * 32 + 4 + hd];
#ifdef MX_PROBE_ON
    unsigned long long tacc[6] = {0, 0, 0, 0, 0, 0}; unsigned long long tlast = MX_NOW();
#endif
    if (wave == 0) mlstm_gates(sm, F.lane, pim, pfm, gbi, gbf);
    dma_raw_m(lds, QK, hd, 0, wave, F.lane); dma_v(lds, VM, 0, wave, F.lane);
    MX_VWAIT0();
    for (int c = 0; c < S / 64; ++c) {
        const int t0 = c * 64;
        int lz = 0; asm volatile("" : "+v"(lz)); const int lane = F.lane + lz, tid = F.tid + lz, h = lane >> 5, l31 = lane & 31, rg = tid >> 5, cg = tid & 31, d0 = 8 * (cg & 15); const bool isq = cg < 16;
        const int gcol = (isq ? 0 : 512) + hd * 128 + d0, ccol = (isq ? 0 : 128) + d0;
        MX_BAR(); MX_T(0);
        u32x4 praw[7];
#pragma unroll
        for (int i = 0; i < 7; ++i) { const int r = 4 * rg + i; praw[i] = *(const LAS u32x4*)(lds + (r < 42 ? MX_RAWA + 512 * r : MX_RAWB + 512 * (r - 42)) + 16 * cg); }
        if (c == 0 && rg == 0) { praw[0] = (u32x4){0u, 0u, 0u, 0u}; praw[1] = praw[0]; praw[2] = praw[0]; }
        {
            float nacc[8];
#pragma unroll
            for (int j = 0; j < 8; ++j) nacc[j] = 0.f;
            float cw[4][8];
#pragma unroll
            for (int tp = 0; tp < 4; ++tp) { const f32x4 c0 = *(const LAS f32x4*)(cwt + tp * 256 + ccol), c1 = *(const LAS f32x4*)(cwt + tp * 256 + ccol + 4);
                cw[tp][0] = c0.x; cw[tp][1] = c0.y; cw[tp][2] = c0.z; cw[tp][3] = c0.w; cw[tp][4] = c1.x; cw[tp][5] = c1.y; cw[tp][6] = c1.z; cw[tp][7] = c1.w; }
#pragma unroll
            for (int r = 0; r < 4; ++r) {
                float y[8];
#pragma unroll
                for (int j = 0; j < 8; ++j) { float x = 0.f;
#pragma unroll
                    for (int tp = 0; tp < 4; ++tp) { const unsigned wd = praw[r + tp][j >> 1]; x += cw[tp][j] * ((j & 1) ? bfhi(wd) : bflo(wd)); }
                    y[j] = fsilu(x); }
                const int row = 4 * rg + r;
                if (isq) {
#pragma unroll
                    for (int j = 0; j < 8; ++j) y[j] *= 0.08838834764831845f;
                    *(LAS u32x4*)(lds + MX_Q + row * MX_QS + d0 * 2) = pack8(y); }
                else { const float wk = sm[SM_WKS + row];
                    *(LAS u32x4*)(lds + MX_K + row * MX_QS + d0 * 2) = pack8(y);
#pragma unroll
                    for (int j = 0; j < 8; ++j) { y[j] *= wk; nacc[j] += y[j]; }
                    *(LAS u32x4*)(lds + MX_KU + row * MX_QS + d0 * 2) = pack8(y); }
            }
            if (!isq) { LAS float* np = (LAS float*)(lds + MX_BC + 4096) + rg * 128 + d0;
                *(LAS f32x4*)np = (f32x4){nacc[0], nacc[1], nacc[2], nacc[3]}; *(LAS f32x4*)(np + 4) = (f32x4){nacc[4], nacc[5], nacc[6], nacc[7]}; }
        }
        MX_BAR(); MX_T(1);
        chunk_scores<true>(lds, sm, lane, wave);
        { const int lq = tid & 63, dp = tid >> 6; const LAS unsigned char* qrow = lds + MX_Q + lq * MX_QS + dp * 32; float sacc = 0.f;
#pragma unroll
          for (int i = 0; i < 2; ++i) { const u32x4 qv = *(const LAS u32x4*)(qrow + 16 * i); const LAS float* nn = sm + SM_N + dp * 16 + 8 * i;
              sacc += bflo(qv.x) * nn[0] + bfhi(qv.x) * nn[1] + bflo(qv.y) * nn[2] + bfhi(qv.y) * nn[3] + bflo(qv.z) * nn[4] + bfhi(qv.z) * nn[5] + bflo(qv.w) * nn[6] + bfhi(qv.w) * nn[7]; }
          sm[SM_QN + dp * 64 + lq] = sacc; }
        MX_VWAIT0();
        MX_BAR(); MX_T(2);
        if (c + 1 < S / 64) dma_raw_m(lds, QK, hd, t0 + 64, wave, lane);
        bf16x8 vf[4]; load_vf(lds, lane, wave, vf);
        float hv[2][16];
#pragma unroll
        for (int lt = 0; lt < 2; ++lt) { f32x16 a1, a2; chunk_out<false>(lds, lane, lt, C, vf, a1, a2);
            const int ll = 32 * lt + l31; const float wi = sm[SM_WINT + ll];
            float qn = 0.f;
#pragma unroll
            for (int dp = 0; dp < 8; ++dp) qn += sm[SM_QN + dp * 64 + ll];
            const float den = ((sm[SM_QTOT + ll] + sm[SM_QTOT + 64 + ll]) + (sm[SM_QTOT + 128 + ll] + sm[SM_QTOT + 192 + ll])) + wi * qn; const float rd = frcp(fmaxf(fabsf(den), sm[SM_ELOW + ll]));
            float ssq = 0.f;
#pragma unroll
            for (int r = 0; r < 16; ++r) { hv[lt][r] = (a1[r] + wi * a2[r]) * rd; ssq += hv[lt][r] * hv[lt][r]; }
            ssq += __shfl_xor(ssq, 32);
            if (h == 0) sm[SM_SSQ + wave * 64 + ll] = ssq; }
        asm volatile("" ::: "memory"); __builtin_amdgcn_sched_barrier(0);
        u32x4 om[2][2];
        { int z2 = 0; asm volatile("" : "+v"(z2)); const int tid2 = F.tid + z2, lane2 = tid2 & 63;
          const bf16_t* omp = OM + (size_t)(t0 + (lane2 & 31)) * D + 32 * wave + 16 * (lane2 >> 5);
#pragma unroll
          for (int lt = 0; lt < 2; ++lt)
#pragma unroll
              for (int g = 0; g < 2; ++g) om[lt][g] = *(const u32x4*)(omp + (size_t)32 * lt * D + 8 * g);
          if (c + 1 < S / 64 && wave == 0) { const int tn = t0 + 64; pim = SMALL[(size_t)(tn + lane2) * 32 + hd]; pfm = SMALL[(size_t)(tn + lane2) * 32 + 4 + hd]; } }
        { const float decay = sm[SM_SCAL];
#pragma unroll
          for (int dt = 0; dt < 4; ++dt)
#pragma unroll
              for (int i = 0; i < 16; ++i) C[dt][i] *= decay;
          chunk_update(lds, lane, C, vf);
          if (tid < 128) { const LAS float* np = (const LAS float*)(lds + MX_BC + 4096) + tid; float cs = 0.f;
#pragma unroll
              for (int g = 0; g < 16; ++g) cs += np[g * 128];
              sm[SM_N + tid] = decay * sm[SM_N + tid] + cs; } }
        MX_BAR(); MX_T(3);
        MX_VWAIT0();
        if (c + 1 < S / 64) dma_v(lds, VM, t0 + 64, wave, lane);
        if (c + 1 < S / 64 && wave == 0) mlstm_gates(sm, lane, pim, pfm, gbi, gbf);
#pragma unroll
        for (int lt = 0; lt < 2; ++lt) { const int ll = 32 * lt + l31; float st = 0.f;
#pragma unroll
            for (int w = 0; w < 8; ++w) st += sm[SM_SSQ + w * 64 + ll];
            const float rn = rsqrtf(st * (1.f / 256.f) + EPS);
            const size_t ro = (size_t)(t0 + ll) * D + 32 * wave + 16 * h;
#pragma unroll
            for (int g = 0; g < 2; ++g) { const u32x4 ov = om[lt][g];
                const f32x4 nwa = *(const LAS f32x4*)(nwt + 32 * wave + 16 * h + 8 * g), nwb = *(const LAS f32x4*)(nwt + 32 * wave + 16 * h + 8 * g + 4);
                float o[8];
                o[0] = hv[lt][8 * g] * rn * nwa.x * bflo(ov.x); o[1] = hv[lt][8 * g + 1] * rn * nwa.y * bfhi(ov.x);
                o[2] = hv[lt][8 * g + 2] * rn * nwa.z * bflo(ov.y); o[3] = hv[lt][8 * g + 3] * rn * nwa.w * bfhi(ov.y);
                o[4] = hv[lt][8 * g + 4] * rn * nwb.x * bflo(ov.z); o[5] = hv[lt][8 * g + 5] * rn * nwb.y * bfhi(ov.z);
                o[6] = hv[lt][8 * g + 6] * rn * nwb.z * bflo(ov.w); o[7] = hv[lt][8 * g + 7] * rn * nwb.w * bfhi(ov.w);
                *(u32x4*)(O + ro + 8 * g) = pack8(o); } }
        MX_T(4);
    }
#ifdef MX_PROBE_ON
    if (threadIdx.x == 0 && (b == 0 && hd == 0)) { unsigned long long* tp = (unsigned long long*)(F.ws + WS_CTL + 4 * CW_STAMP) + 48; for (int i = 0; i < 6; ++i) tp[i] = tacc[i]; }
#endif
}
__device__ __forceinline__ void gla_chunked(const Args& a, Frame& F, int l, int b, int hd, bf16_t* OUT) {
    LAS unsigned char* lds = F.lds; LAS float* sm = (LAS float*)(F.lds + MX_SM); LAS float* bcl = (LAS float*)(F.lds + MX_BC);
    const int tid0 = F.tid, wave = F.wave;
    const bf16_t* QKG = (const bf16_t*)(F.ws + WS_PB + 3 * PB_STRIDE) + (size_t)b * S * D; const bf16_t* VG = (const bf16_t*)(F.ws + WS_PB + 4 * PB_STRIDE) + (size_t)b * S * D + hd * 256;
    const bf16_t* ZG = (const bf16_t*)(F.ws + WS_PB + 5 * PB_STRIDE) + (size_t)b * S * D + hd * 256; const float* SMALL = (const float*)(F.ws + WS_SMALL) + (size_t)b * S * 32;
    bf16_t* O = OUT + (size_t)b * S * D + hd * 256;
    const int rt = wave >> 2, ct = wave & 3;
    u32x4 bhi, blo; float ab;
    { const int n = tid0 & 31, hh = (tid0 >> 5) & 1; float w[8];
#pragma unroll
      for (int j = 0; j < 8; ++j) w[j] = a.in[I_ALPHAW][(size_t)l * 16 * 512 + (8 * hh + j) * 512 + hd * 128 + 32 * ct + n];
      ab = a.in[I_ALPHAB][l * 512 + hd * 128 + 32 * ct + n];
      unsigned hi[4], lo[4];
#pragma unroll
      for (int j = 0; j < 4; ++j) { hi[j] = cvt_pk_bf16(w[2 * j], w[2 * j + 1]); lo[j] = cvt_pk_bf16(w[2 * j] - bflo(hi[j]), w[2 * j + 1] - bfhi(hi[j])); }
      bhi.x = hi[0]; bhi.y = hi[1]; bhi.z = hi[2]; bhi.w = hi[3]; blo.x = lo[0]; blo.y = lo[1]; blo.z = lo[2]; blo.w = lo[3]; }
    asm volatile("" : "+v"(bhi), "+v"(blo), "+v"(ab));
    LAS float* nwt = (LAS float*)(F.lds + MX_END);
    if (tid0 < 256) nwt[tid0] = a.in[I_GNORMW][l * D + hd * 256 + tid0];
    f32x16 C[4];
#pragma unroll
    for (int dt = 0; dt < 4; ++dt)
#pragma unroll
        for (int i = 0; i < 16; ++i) C[dt][i] = 0.f;
    LAS float* rgt = bcl;
    if (tid0 < 256) *(LAS f32x4*)(rgt + tid0 * 4) = *(const f32x4*)(SMALL + (size_t)(tid0 >> 2) * 32 + 8 + (tid0 & 3) * 4);
    MX_SYNC();
    dma_qk(lds, MX_Q, QKG + hd * 128, 0, wave, F.lane); dma_qk(lds, MX_K, QKG + 512 + hd * 128, 0, wave, F.lane); dma_v(lds, VG, 0, wave, F.lane);
#ifdef MX_PROBE_ON
    unsigned long long tacc[6] = {0, 0, 0, 0, 0, 0}; unsigned long long tlast = MX_NOW();
#endif
    for (int c = 0; c < S / 64; ++c) {
        const int t0 = c * 64;
        int lz = 0; asm volatile("" : "+v"(lz)); const int lane = F.lane + lz, tid = F.tid + lz, h = lane >> 5, l31 = lane & 31, rg = tid >> 5, cg = tid & 31, d0 = 8 * (cg & 15), dcol = tid & 127; const bool isq = cg < 16;
        const int gcol = (isq ? 0 : 512) + hd * 128 + d0;
        float lac[16]; float ctot;
        { const LAS float* rp = rgt + (32 * rt + l31) * 16 + 8 * h;
          const f32x4 r0 = *(const LAS f32x4*)rp, r1 = *(const LAS f32x4*)(rp + 4);
          u32x4 ahi, alo;
          ahi.x = cvt_pk_bf16(r0.x, r0.y); ahi.y = cvt_pk_bf16(r0.z, r0.w); ahi.z = cvt_pk_bf16(r1.x, r1.y); ahi.w = cvt_pk_bf16(r1.z, r1.w);
          alo.x = cvt_pk_bf16(r0.x - bflo(ahi.x), r0.y - bfhi(ahi.x)); alo.y = cvt_pk_bf16(r0.z - bflo(ahi.y), r0.w - bfhi(ahi.y));
          alo.z = cvt_pk_bf16(r1.x - bflo(ahi.z), r1.y - bfhi(ahi.z)); alo.w = cvt_pk_bf16(r1.z - bflo(ahi.w), r1.w - bfhi(ahi.w));
          f32x16 x;
#pragma unroll
          for (int i = 0; i < 16; ++i) x[i] = 0.f;
          x = MFMA32(__builtin_bit_cast(bf16x8, alo), __builtin_bit_cast(bf16x8, bhi), x);
          x = MFMA32(__builtin_bit_cast(bf16x8, ahi), __builtin_bit_cast(bf16x8, blo), x);
          x = MFMA32(__builtin_bit_cast(bf16x8, ahi), __builtin_bit_cast(bf16x8, bhi), x);
          float gs[4], go[4];
#pragma unroll
          for (int g = 0; g < 4; ++g) { float run = 0.f;
#pragma unroll
              for (int p = 0; p < 4; ++p) { run += flogsigmoid(x[4 * g + p] + ab) * (1.f / 16.f); lac[4 * g + p] = run; }
              gs[g] = run; }
#pragma unroll
          for (int g = 0; g < 4; ++g) go[g] = __shfl_xor(gs[g], 32);
          float off = 0.f;
#pragma unroll
          for (int g = 0; g < 4; ++g) { const float lo_ = h ? go[g] : gs[g], hi_ = h ? gs[g] : go[g];
              const float base = h ? off + lo_ : off;
#pragma unroll
              for (int p = 0; p < 4; ++p) lac[4 * g + p] += base;
              off = (off + lo_) + hi_; }
          ctot = off;
          if (rt == 0 && h == 0) sm[SM_QTOT + 32 * ct + l31] = ctot; }
        MX_BAR(); MX_T(0);
        { const int dcol = 32 * ct + l31; const float pre = rt ? sm[SM_QTOT + dcol] : 0.f;
#pragma unroll
          for (int i = 0; i < 16; ++i) bcl[(32 * rt + (i & 3) + 8 * (i >> 2) + 4 * h) * 132 + dcol] = pre + lac[i];
          if (rt == 1 && h == 0) { const float gc = pre + ctot; sm[SM_GC + dcol] = gc; sm[SM_EGC + dcol] = __expf(gc); } }
        MX_VWAIT0();
        MX_BAR(); MX_T(1);
        { const bool q_role = wave < 4; const int t1 = tid & 255, rg1 = t1 >> 4, d1 = 8 * (t1 & 15);
          float egv[8];
          { const f32x4 g0 = *(const LAS f32x4*)(sm + SM_EGC + d1), g1 = *(const LAS f32x4*)(sm + SM_EGC + d1 + 4); egv[0] = g0.x; egv[1] = g0.y; egv[2] = g0.z; egv[3] = g0.w; egv[4] = g1.x; egv[5] = g1.y; egv[6] = g1.z; egv[7] = g1.w; }
#pragma unroll
          for (int r = 0; r < 4; ++r) { const int row = 4 * rg1 + r;
            float x[8], e[8], y[8];
            LAS unsigned char* img = lds + (q_role ? MX_Q : MX_K) + row * MX_QS + d1 * 2;
            const u32x4 praw = *(const LAS u32x4*)img;
#pragma unroll
            for (int j = 0; j < 8; ++j) { const unsigned wd = praw[j >> 1]; x[j] = (j & 1) ? bfhi(wd) : bflo(wd); }
            { const f32x4 e0 = *(const LAS f32x4*)(bcl + row * 132 + d1), e1 = *(const LAS f32x4*)(bcl + row * 132 + d1 + 4);
              e[0] = e0.x; e[1] = e0.y; e[2] = e0.z; e[3] = e0.w; e[4] = e1.x; e[5] = e1.y; e[6] = e1.z; e[7] = e1.w; }
            if (q_role) {
#pragma unroll
                for (int j = 0; j < 8; ++j) y[j] = x[j] * 0.08838834764831845f * __expf(e[j]);
                *(LAS u32x4*)img = pack8(y); }
            else {
#pragma unroll
                for (int j = 0; j < 8; ++j) y[j] = x[j] * __expf(-e[j]);
                *(LAS u32x4*)img = pack8(y);
#pragma unroll
                for (int j = 0; j < 8; ++j) y[j] *= egv[j];
                *(LAS u32x4*)(lds + MX_KU + row * MX_QS + d1 * 2) = pack8(y); }
          } }
        MX_BAR(); MX_T(2);
        chunk_scores<false>(lds, sm, lane, wave);
        MX_BAR(); MX_T(3);
        if (c + 1 < S / 64) dma_qk(lds, MX_K, QKG + 512 + hd * 128, t0 + 64, wave, lane);
        bf16x8 vf[4]; load_vf(lds, lane, wave, vf);
        f32x16 acc1[2];
#pragma unroll
        for (int lt = 0; lt < 2; ++lt) { f32x16 a2; chunk_out<true>(lds, lane, lt, C, vf, acc1[lt], a2);
            const int ll = 32 * lt + l31; float ssq = 0.f;
#pragma unroll
            for (int r = 0; r < 16; ++r) ssq += acc1[lt][r] * acc1[lt][r];
            ssq += __shfl_xor(ssq, 32);
            if (h == 0) sm[SM_SSQ + wave * 64 + ll] = ssq; }
        asm volatile("" ::: "memory"); __builtin_amdgcn_sched_barrier(0);
        f32x4 rgn = (f32x4){0.f, 0.f, 0.f, 0.f};
        if (c + 1 < S / 64 && tid < 256) rgn = *(const f32x4*)(SMALL + (size_t)(t0 + 64 + (tid >> 2)) * 32 + 8 + (tid & 3) * 4);
        u32x4 zg[2][2];
#pragma unroll
        for (int lt = 0; lt < 2; ++lt)
#pragma unroll
            for (int g = 0; g < 2; ++g) zg[lt][g] = *(const u32x4*)(ZG + (size_t)(t0 + 32 * lt + l31) * D + 32 * wave + 16 * h + 8 * g);
#pragma unroll
        for (int dt = 0; dt < 4; ++dt)
#pragma unroll
            for (int g = 0; g < 4; ++g) { const f32x4 eg = *(const LAS f32x4*)(sm + SM_EGC + 32 * dt + 8 * g + 4 * h);
                C[dt][4 * g] *= eg.x; C[dt][4 * g + 1] *= eg.y; C[dt][4 * g + 2] *= eg.z; C[dt][4 * g + 3] *= eg.w; }
        chunk_update(lds, lane, C, vf);
        if (tid < 256) *(LAS f32x4*)(rgt + tid * 4) = rgn;
        MX_BAR(); MX_T(4);
        if (c + 1 < S / 64) { dma_qk(lds, MX_Q, QKG + hd * 128, t0 + 64, wave, lane); dma_v(lds, VG, t0 + 64, wave, lane); }
#pragma unroll
        for (int lt = 0; lt < 2; ++lt) { const int ll = 32 * lt + l31; float st = 0.f;
#pragma unroll
            for (int w = 0; w < 8; ++w) st += sm[SM_SSQ + w * 64 + ll];
            const float rn = rsqrtf(st * (1.f / 256.f) + EPS);
            const size_t ro = (size_t)(t0 + ll) * D + 32 * wave + 16 * h;
#pragma unroll
            for (int g = 0; g < 2; ++g) { const u32x4 zv = zg[lt][g];
                const f32x4 nwa = *(const LAS f32x4*)(nwt + 32 * wave + 16 * h + 8 * g), nwb = *(const LAS f32x4*)(nwt + 32 * wave + 16 * h + 8 * g + 4);
                float o[8];
                o[0] = acc1[lt][8 * g] * rn * nwa.x * bflo(zv.x); o[1] = acc1[lt][8 * g + 1] * rn * nwa.y * bfhi(zv.x);
                o[2] = acc1[lt][8 * g + 2] * rn * nwa.z * bflo(zv.y); o[3] = acc1[lt][8 * g + 3] * rn * nwa.w * bfhi(zv.y);
                o[4] = acc1[lt][8 * g + 4] * rn * nwb.x * bflo(zv.z); o[5] = acc1[lt][8 * g + 5] * rn * nwb.y * bfhi(zv.z);
                o[6] = acc1[lt][8 * g + 6] * rn * nwb.z * bflo(zv.w); o[7] = acc1[lt][8 * g + 7] * rn * nwb.w * bfhi(zv.w);
                *(u32x4*)(O + ro + 8 * g) = pack8(o); } }
        MX_T(5);
    }
#ifdef MX_PROBE_ON
    if (threadIdx.x == 0 && (b == 0 && hd == 0)) { unsigned long long* tp = (unsigned long long*)(F.ws + WS_CTL + 4 * CW_STAMP) + 56; for (int i = 0; i < 6; ++i) tp[i] = tacc[i]; }
#endif
}
__device__ __forceinline__ void p_mixers(const Args& a, Frame& F, int l) {
    if (F.G > 128 && F.bid >= 128) {
        const int gw = (F.bid - 128) * NWAVES + F.wave, NGW = (F.G - 128) * NWAVES;
        LAS float* scr = (LAS float*)(F.lds + F.wave * 8704);
        if (l == 0) for (int it = gw; it < SW_DEFER0; it += NGW) small_deferred0(a, F.ws, it, scr, F.lane);
        for (int it = gw; it < EX_ITEMS; it += NGW) expert_item(a, F.ws, l, it, scr, F.lane);
        asm volatile("s_waitcnt vmcnt(0) lgkmcnt(0)" ::: "memory"); __syncthreads();
        p_gates_a_idle(F, l);
        return;
    }
    for (int s = F.bid; s < 128; s += F.G) {
        MX_SYNC();
        if (s < 64) mlstm_chunked(a, F, l, s >> 2, s & 3, (bf16_t*)(F.ws + WS_PB + 2 * PB_STRIDE));
        else gla_chunked(a, F, l, (s - 64) >> 2, s & 3, (bf16_t*)(F.ws + WS_PB + 5 * PB_STRIDE));
    }
    if (F.G <= 128) {
        MX_SYNC();
        const int gw = F.bid * NWAVES + F.wave, NGW = F.G * NWAVES; LAS float* scr = (LAS float*)(F.lds + F.wave * 8704);
        if (l == 0) { for (int it = gw; it < SW_DEFER0; it += NGW) small_deferred0(a, F.ws, it, scr, F.lane); for (int it = gw; it < SW_ITEMS; it += NGW) small_item(a, F.ws, 1, it, scr, F.lane); }
        for (int it = gw; it < EX_ITEMS; it += NGW) expert_item(a, F.ws, l, it, scr, F.lane);
    }
}

#ifdef MK_TEST_MIXERS
__device__ __forceinline__ void p_mixers_test(const Args& a, Frame& F, int l) {
    for (int s = F.bid; s < 128; s += F.G) {
        int sel = -1;
        if (s == 5) sel = 0; else if (s == 38) sel = 1; else if (s == 64 + 9) sel = 2; else if (s == 64 + 50) sel = 3;
        bf16_t* ref = (bf16_t*)(F.ws + WS_LOGITS) + (size_t)(sel < 0 ? 0 : sel) * S * 256;
        MX_SYNC();
        if (sel >= 0) { if (s < 64) mlstm_seq(a, F, l, s >> 2, s & 3, ref, 256); else gla_seq(a, F, l, (s - 64) >> 2, s & 3, ref, 256); }
        MX_SYNC();
        if (s < 64) mlstm_chunked(a, F, l, s >> 2, s & 3, (bf16_t*)(F.ws + WS_PB + 2 * PB_STRIDE));
        else gla_chunked(a, F, l, (s - 64) >> 2, s & 3, (bf16_t*)(F.ws + WS_PB + 5 * PB_STRIDE));
        MX_SYNC();
        __builtin_amdgcn_fence(__ATOMIC_ACQUIRE, "agent"); asm volatile("s_waitcnt vmcnt(0)" ::: "memory");
        if (sel >= 0) {
            const int bb = (s < 64 ? s : s - 64) >> 2, hd = s & 3;
            const bf16_t* got = (const bf16_t*)(F.ws + WS_PB + (s < 64 ? 2 : 5) * PB_STRIDE) + (size_t)bb * S * D + hd * 256;
            float sd = 0.f, sr = 0.f;
            for (int i = F.tid; i < S * 256; i += NTHREADS) { const int t = i >> 8, e = i & 255; const float g = bf2f(got[(size_t)t * D + e]), r = bf2f(ref[i]); sd += (g - r) * (g - r); sr += r * r; }
            sd = wave_sum(sd); sr = wave_sum(sr);
            float* err = (float*)(F.ws + WS_CTL) + CW_ERR;
            if (F.lane == 0) { atomicAdd(&err[2], sd); atomicAdd(&err[3], sr); }
        }
    }
}
#endif

#ifdef MK_DUP_MIX
__device__ __forceinline__ void p_mixers_dummy(const Args& a, Frame& F, int l) {
    for (int s = F.bid; s < 128; s += F.G) {
        MX_SYNC();
        bf16_t* dump = (bf16_t*)(F.ws + WS_LOGITS) - ((size_t)((s & 63) >> 2) * S * D + (s & 3) * 256);
#if MK_DUP_MIX == 2
        if (s < 64) mlstm_chunked(a, F, l, s >> 2, s & 3, dump);
#elif MK_DUP_MIX == 3
        if (s >= 64) gla_chunked(a, F, l, (s - 64) >> 2, s & 3, dump);
#else
        if (s < 64) mlstm_chunked(a, F, l, s >> 2, s & 3, dump); else gla_chunked(a, F, l, (s - 64) >> 2, s & 3, dump);
#endif
    }
}
#endif
__global__ void __launch_bounds__(NTHREADS, 2) mega(Args a) {
    extern __shared__ __attribute__((aligned(16))) unsigned char lds_raw[];
    Frame F; F.lds = (LAS unsigned char*)lds_raw; F.ws = a.ws; F.tid = threadIdx.x; F.lane = F.tid & 63; F.wave = __builtin_amdgcn_readfirstlane(F.tid >> 6); F.G = gridDim.x; F.bid = blockIdx.x;
    volatile LAS unsigned* xbw = (volatile LAS unsigned*)(F.lds + MISC_OFF);
    if (F.tid < 4) xbw[F.tid] = 0u;
    __syncthreads();
    XcdBarrier bar; bar.bar = (unsigned*)(F.ws + WS_CTL) + CW_BAR; bar.x = 0; bar.st = xbw;
#if MK_N_LAUNCHES == 1
    bar = xcd_barrier_post((unsigned*)(F.ws + WS_CTL) + CW_BAR, xbw);
#define IN(k) true
#if defined(MK_PROBE) || defined(MK_TPROBE)
#define STAMP() do { if (blockIdx.x == 0 && threadIdx.x == 0) { ((unsigned long long*)(a.ws + WS_CTL + 4 * CW_STAMP))[sidx] = wall_clock64(); } ++sidx; } while (0)
#else
#define STAMP() do { } while (0)
#endif
#ifdef MK_DUP_BAR
#define EXTRA_BAR(b) xcd_barrier(b);
#else
#define EXTRA_BAR(b)
#endif
#define SEAM() do { XcdBarrier b2_ = bar; unsigned long long zb_ = 0; asm volatile("" : "+s"(zb_)); b2_.bar = bar.bar + zb_; b2_.x = bar.x + (unsigned)zb_; b2_.st = bar.st + (unsigned)zb_; xcd_barrier(b2_); STAMP(); EXTRA_BAR(b2_) } while (0)
#else
    const int lo = a.ph_lo, hi = a.ph_hi;
#define IN(k) (lo <= (k) && (k) < hi)
#define SEAM() do { } while (0)
#endif
#define PH_BEGIN() do { int t_ = threadIdx.x; asm volatile("" : "+v"(t_)); F.tid = t_; F.lane = t_ & 63; F.wave = __builtin_amdgcn_readfirstlane(t_ >> 6); \
        unsigned long long z_ = 0; asm volatile("" : "+s"(z_)); F.ws = a.ws + z_; F.G = (int)gridDim.x + (int)z_; F.bid = (int)blockIdx.x + (int)z_; F.lds = (LAS unsigned char*)lds_raw + (unsigned)z_; } while (0)
    int sidx = 0; STAMP();
    if (IN(0)) { PH_BEGIN(); p0a(a, F, false); SEAM(); }
#ifdef MK_DUP_CVT
    { PH_BEGIN(); p0a(a, F, false); SEAM(); }
#endif
#ifdef MK_DUP_GEMM
#define DUPGK(k, x) if ((MK_DUP_GEMM >> (k)) & 1) { PH_BEGIN(); x; SEAM(); }
#else
#define DUPGK(k, x)
#endif
#ifdef MK_DUP_CVT
#define DUP_CVT2(a, F) PH_BEGIN(); p_expert_cvt(a, F, 1); SEAM();
#else
#define DUP_CVT2(a, F)
#endif
#ifdef MK_DUP_MIX
#define DUPM(a, F, l) PH_BEGIN(); p_mixers_dummy(a, F, l); SEAM();
#else
#define DUPM(a, F, l)
#endif
#ifdef MK_TEST_MIXERS
#define MIXERS p_mixers_test
#else
#define MIXERS p_mixers
#endif
#if defined(MK_TPROBE)
#define TSTAMP_WG(l) do { __syncthreads(); if (threadIdx.x == 0 && (blockIdx.x == 0 || blockIdx.x == 64 || blockIdx.x == 128)) ((unsigned long long*)(a.ws + WS_CTL + 4 * CW_STAMP))[40 + 3 * l + (blockIdx.x >> 6)] = wall_clock64(); } while (0)
#else
#define TSTAMP_WG(l) do { } while (0)
#endif
#define LAYER_BODY(l) \
        if (IN(1)) { PH_BEGIN(); \
            const float* ada = (const float*)(F.ws + WS_ADA) + (size_t)l * NB * 6 * D; \
            p_norm(F, l == 0 ? a.in[I_X] : a.out, a.in[I_NMIXW] + l * D, ada + 0 * D, ada + 1 * D, (bf16_t*)(F.ws + WS_U)); \
            SEAM(); \
        } \
        if (IN(2)) { PH_BEGIN(); p_inproj(F, l); SEAM(); DUPGK(2, p_inproj(F, l)) } \
        if (IN(3)) { DUPM(a, F, l) PH_BEGIN(); MIXERS(a, F, l); TSTAMP_WG(l); SEAM(); } \
        if (IN(4) && (int)gridDim.x <= 128) { PH_BEGIN(); p_gates(F, l); SEAM(); } \
        if (IN(5)) { PH_BEGIN(); p_y(F, l); SEAM(); DUPGK(5, p_y(F, l)) } \
        if (IN(6)) { PH_BEGIN(); p_wo(a, F, l); SEAM(); } \
        if (IN(7)) { PH_BEGIN(); p_norm2(a, F, l); SEAM(); } \
        if (IN(8)) { PH_BEGIN(); p_router(a, F, l); SEAM(); DUPGK(8, p_router(a, F, l)) } \
        if (IN(9)) { PH_BEGIN(); p_topk(a, F, l); SEAM(); } \
        if (IN(10)) { PH_BEGIN(); p_fill(F, l); SEAM(); } \
        if (IN(11)) { PH_BEGIN(); p_gemm1(F, l); SEAM(); DUPGK(11, p_gemm1(F, l)) } \
        if (IN(12)) { PH_BEGIN(); p_gemm2(F, l); SEAM(); DUPGK(12, p_gemm2(F, l)) } \
        if (IN(13)) { PH_BEGIN(); if (l == DEPTH - 1) p_combine<true>(a, F, l); else { p_combine<false>(a, F, l); SEAM(); } }
#if MK_N_LAUNCHES == 1
    { LAYER_BODY(0) }
    { LAYER_BODY(1) }
#else
    for (int l_ = a.l_lo; l_ < a.l_hi; ++l_) { const int l = l_; LAYER_BODY(l) }
#endif
#undef LAYER_BODY
#if defined(MK_TEST_MIXERS) || defined(MK_PROBE)
    { SEAM(); PH_BEGIN(); p_final_scale(a, F); }
#endif
#if defined(MK_TPROBE)
    { SEAM();
      if (blockIdx.x == 0 && threadIdx.x == 0) {
          unsigned long long* st = (unsigned long long*)(a.ws + WS_CTL + 4 * CW_STAMP); unsigned long long tot = 0;
          for (int i = 0; i < 27; ++i) if ((MK_TPROBE >> i) & 1ull) tot += __hip_atomic_load(st + i + 1, __ATOMIC_RELAXED, __HIP_MEMORY_SCOPE_AGENT) - __hip_atomic_load(st + i, __ATOMIC_RELAXED, __HIP_MEMORY_SCOPE_AGENT);
          for (int j = 0; j < 6; ++j) if ((MK_TPROBE >> (27 + j)) & 1ull) tot += __hip_atomic_load(st + 40 + j, __ATOMIC_RELAXED, __HIP_MEMORY_SCOPE_AGENT) - __hip_atomic_load(st + 3 + 12 * (j / 3), __ATOMIC_RELAXED, __HIP_MEMORY_SCOPE_AGENT);
          for (int j = 0; j < 12; ++j) if ((MK_TPROBE >> (33 + j)) & 1ull) tot += __hip_atomic_load(st + 48 + (j / 6) * 8 + (j % 6), __ATOMIC_RELAXED, __HIP_MEMORY_SCOPE_AGENT);
          tot *= MK_TPROBE_K; const unsigned long long t0 = wall_clock64();
          while (wall_clock64() - t0 < tot) __builtin_amdgcn_s_sleep(20);
      } }
#endif
#undef IN
#undef SEAM
#undef PH_BEGIN
}


extern "C" void kernel_launch(void* const* d_in, const int* in_sizes, int n_in, void* d_out, int out_size, void* d_ws, size_t ws_size, hipStream_t stream) {
    static int grid = 0;
    if (grid == 0) {
        if (ws_size < WS_OPT_END || n_in != 25 || out_size != T * D) { fprintf(stderr, "kernel_launch: unexpected problem (ws %zu, n_in %d, out %d)\n", ws_size, n_in, out_size); grid = -1; return; }
        int dev = 0, cus = 0, per_cu = 0;
        if (hipGetDevice(&dev) != hipSuccess || hipDeviceGetAttribute(&cus, hipDeviceAttributeMultiprocessorCount, dev) != hipSuccess) { grid = -1; return; }
        if (hipFuncSetAttribute((const void*)mega, hipFuncAttributeMaxDynamicSharedMemorySize, LDS_BYTES) != hipSuccess) { fprintf(stderr, "kernel_launch: hipFuncSetAttribute failed\n"); grid = -1; return; }
        if (hipOccupancyMaxActiveBlocksPerMultiprocessor(&per_cu, (const void*)mega, NTHREADS, LDS_BYTES) != hipSuccess || per_cu < 1) { fprintf(stderr, "kernel_launch: occupancy query says %d\n", per_cu); grid = -1; (void)hipGetLastError(); return; }
        grid = cus;
    }
    if (grid < 0) return;
    Args a{}; for (int i = 0; i < 25; ++i) a.in[i] = (const float*)d_in[i]; a.out = (float*)d_out; a.ws = (unsigned char*)d_ws;
    hipMemsetAsync((char*)d_ws + WS_CTL, 0, CTL_BYTES, stream);
#if MK_N_LAUNCHES == 1
    a.ph_lo = 0; a.ph_hi = 18; a.l_lo = 0; a.l_hi = DEPTH;
    hipLaunchKernelGGL(mega, dim3(grid), dim3(NTHREADS), LDS_BYTES, stream, a);
#else
    auto launch = [&](int ph, int l) { Args b = a; b.ph_lo = ph; b.ph_hi = ph + 1; b.l_lo = l; b.l_hi = l + 1; hipLaunchKernelGGL(mega, dim3(grid), dim3(NTHREADS), LDS_BYTES, stream, b); };
    launch(0, 0);
    for (int l = 0; l < DEPTH; ++l) { for (int ph = 1; ph <= 15; ++ph) launch(ph, l); if (l == 0) launch(16, 0); }
    launch(17, 0);
#endif
}
```

```cpp
#include <hip/hip_runtime.h>
#include <cstdio>
#include <cstdint>

constexpr int D = 1024, NB = 16, S = 2048, T = NB * S, DEPTH = 2;
constexpr int DIN = 8216;
constexpr int C_QK = 0, C_VM = 1024, C_OM = 2048, C_IM = 3072, C_FM = 3076, C_QG = 3080, C_KG = 3592, C_VG = 4104, C_RG = 5128, C_ZG = 5144, C_GA = 6168, C_GB = 7192;
constexpr int NE = 64, TOPK = 8, DE = 256;
constexpr int NASSIGN = T * TOPK, NROWS = NASSIGN + NE * 256, NBLK = NROWS / 256;
constexpr float EPS = 1e-6f;

__device__ __forceinline__ float sigmoidf_(float x) { return 1.f / (1.f + __expf(-x)); }
__device__ __forceinline__ float siluf_(float x) { return x / (1.f + __expf(-x)); }
__device__ __forceinline__ float logsigmoidf_(float x) { return fminf(x, 0.f) - log1pf(__expf(-fabsf(x))); }
__device__ __forceinline__ float wave_sum(float v) {
#pragma unroll
    for (int o = 1; o < 64; o <<= 1) v += __shfl_xor(v, o);
    return v;
}

#define LAS __attribute__((address_space(3)))
typedef unsigned short bf16_t;
typedef short bf16x8 __attribute__((ext_vector_type(8)));
typedef float f32x4 __attribute__((ext_vector_type(4)));
typedef float f32x2 __attribute__((ext_vector_type(2)));
typedef unsigned u32x4 __attribute__((ext_vector_type(4)));
typedef unsigned u32x2 __attribute__((ext_vector_type(2)));

constexpr size_t MiB = 1u << 20;
constexpr int NWAVES = 8, NTHREADS = 512;
constexpr int LDS_BYTES = 163840;
constexpr int RING_BYTES = 131072, MISC_OFF = RING_BYTES;

constexpr size_t WS_CTL = 0, CTL_BYTES = 1 * MiB;
constexpr size_t WS_ADA = 1 * MiB;
constexpr size_t WS_WSM = 2 * MiB, WSM_STRIDE = 25 * MiB;
constexpr size_t WO_IN = 0, WO_GAB = 12 * MiB + 512 * 1024, WO_PA = WO_GAB + 4 * MiB, WO_PB = WO_PA + 2 * MiB, WO_O = WO_PB + 2 * MiB, WO_S13 = WO_O + 2 * MiB, WO_S2 = WO_S13 + 1 * MiB, WO_R = WO_S2 + 512 * 1024;
constexpr size_t WS_WEXP13 = 52 * MiB, WS_WEXP2 = 116 * MiB;
constexpr size_t WS_SMALL = 148 * MiB;
constexpr size_t WS_LOGITS = 152 * MiB, WS_EIDX = 160 * MiB, WS_WTS = 161 * MiB, WS_POS = 162 * MiB, WS_ROWTOK = 163 * MiB;
constexpr size_t WS_U = 166 * MiB;
constexpr size_t WS_PB = 230 * MiB, PB_STRIDE = 64 * MiB;
constexpr size_t WS_SA8 = 614 * MiB;
constexpr size_t WS_SB8T = 646 * MiB;
constexpr int SB8_SPLIT = 25600;
constexpr size_t WS_OPT_END = 653 * MiB;
static_assert(WO_R + 512 * 1024 <= WSM_STRIDE, "small weight map");

constexpr int CW_BAR = 4096;
constexpr int CW_CNT = 16384;
constexpr int CW_ERR = 20480;
constexpr int CW_STAMP = 24576;

__device__ __forceinline__ unsigned f2bf(float f) { unsigned u = __builtin_bit_cast(unsigned, f); return (u + 0x7fffu + ((u >> 16) & 1u)) >> 16; }
__device__ __forceinline__ unsigned pk2(float lo, float hi) { return f2bf(lo) | (f2bf(hi) << 16); }
__device__ __forceinline__ float bf2f(unsigned short b) { return __builtin_bit_cast(float, (unsigned)b << 16); }
__device__ __forceinline__ float bflo(unsigned w) { return __builtin_bit_cast(float, w << 16); }
__device__ __forceinline__ float bfhi(unsigned w) { return __builtin_bit_cast(float, w & 0xffff0000u); }
typedef __bf16 bf16x2_t __attribute__((ext_vector_type(2)));
__device__ __forceinline__ unsigned cvt_pk_bf16(float lo, float hi) { const f32x2 v = {lo, hi}; return __builtin_bit_cast(unsigned, __builtin_convertvector(v, bf16x2_t)); }

__device__ __forceinline__ float frcp(float x) { return __builtin_amdgcn_rcpf(x); }
__device__ __forceinline__ float fsigmoid(float x) { return frcp(1.f + __expf(-x)); }
__device__ __forceinline__ float fsilu(float x) { return x * frcp(1.f + __expf(-x)); }
__device__ __forceinline__ float flogsigmoid(float x) { return fminf(x, 0.f) - __logf(1.f + __expf(-fabsf(x))); }
__device__ __forceinline__ float ftanh(float y) { return 1.f - 2.f * frcp(1.f + __expf(2.f * y)); }
#define LDS_WAIT() asm volatile("s_waitcnt lgkmcnt(0)" ::: "memory")
#define VM_WAIT() asm volatile("s_waitcnt vmcnt(0)" ::: "memory")

template <class E> constexpr bool epi_probe_v = false;
template <class E> constexpr bool epi_chain_v = false;
namespace pg8 {
constexpr int BM = 256, BK = 64, HALF = 128, HTB = HALF * BK * 2, STAGE_BYTES = 8 * HTB, NXCD = 8, WGM = 8;
__host__ __device__ __forceinline__ int lds_byte(int r, int c) { const int st = (r >> 4) * 2 + (c >> 5), rr = r & 15, cc = c & 31, ob = rr * 64 + cc * 2; return st * 1024 + (ob ^ (((ob >> 9) & 1) << 5)); }
__host__ __device__ __forceinline__ void stage_rc(int b, int& R, int& C) { const int st = b / 1024, sb = b % 1024, swz = sb ^ (((sb >> 9) & 1) << 5); R = (st >> 1) * 16 + swz / 64; C = (st & 1) * 32 + (swz % 64) / 2; }
__host__ __device__ __forceinline__ int perm32(int rho) { const int n = rho >> 4, i = rho & 15; return 8 * (i >> 2) + 4 * n + (i & 3); }

struct Unit { int pm, pn, e; };

struct TileOrder {
    int nM, nN, nwg, G, c;
    __device__ void init(int nM_, int nN_, int G_, int c_) { nM = nM_; nN = nN_; nwg = nM * nN; G = G_; c = c_; }
    __device__ bool tile(int i, int& pm, int& pn) const {
        const long L = (long)i * G + c; if (L >= nwg) return false;
        int wgid = (int)L; { const int q = nwg / NXCD, r = nwg % NXCD, xcd = wgid % NXCD, off = wgid / NXCD; wgid = (xcd < r ? xcd * (q + 1) : r * (q + 1) + (xcd - r) * q) + off; }
        const int nig = WGM * nN, gid = wgid / nig, fm = gid * WGM, gsz = (nM - fm) < WGM ? (nM - fm) : WGM;
        pm = fm + ((wgid % nig) % gsz); pn = (wgid % nig) / gsz; return true;
    }
};

template <class Epi, class Sched, bool GATHER, bool ALIGN_EPI = true>
__device__ __forceinline__ void gemm_phase(LAS unsigned char* lds, const int K, const Sched& S, const Epi& E) {
    int tid_ = threadIdx.x; asm volatile("" : "+v"(tid_));
    const int tid = tid_, wid = __builtin_amdgcn_readfirstlane(tid >> 6), lane = tid & 63, wr = wid >> 2, wc = wid & 3, fr = lane & 15, fq = lane >> 4;
    const int nt = K / BK;
    unsigned rowA[2], colA[2], voffB[2];
#pragma unroll
    for (int i = 0; i < 2; ++i) { int R, C; stage_rc(tid * 16 + i * 8192, R, C); const int Rb = Epi::PERM ? ((R & ~31) + perm32(R & 31)) : R;
        rowA[i] = (unsigned)R; colA[i] = (unsigned)C * 2u; voffB[i] = (unsigned)(Rb * K + C) * 2u; }
    const size_t kstep = (size_t)(BK * 2);
    const size_t hstep = (size_t)HALF * K * 2;
    const unsigned ldsw = (unsigned)wid * 1024u;
    const int aoff = lds_byte(wr * 64 + fr, fq * 8), boff = lds_byte(wc * 32 + fr, fq * 8);
#define PG8_SA(b, h) (((b) * 2 + (h)) * HTB)
#define PG8_SB(b, h) ((4 + (b) * 2 + (h)) * HTB)
#define PG8_STAGE(bufoff, gbase, voff) do { _Pragma("unroll") for (int _i = 0; _i < 2; ++_i) \
        __builtin_amdgcn_global_load_lds((const unsigned*)((const char*)(gbase) + (voff)[_i]), (LAS unsigned*)(lds + (bufoff) + ldsw + _i * 8192), 16, 0, 0); } while (0)
#define PG8_LDA(dst, b, h) do { _Pragma("unroll") for (int m = 0; m < 4; ++m) _Pragma("unroll") for (int k = 0; k < 2; ++k) dst[m][k] = *(const LAS bf16x8*)(lds + PG8_SA(b, h) + aoff + m * 2048 + k * 1024); } while (0)
#define PG8_LDB(dst, b, h) do { _Pragma("unroll") for (int n = 0; n < 2; ++n) _Pragma("unroll") for (int k = 0; k < 2; ++k) dst[n][k] = *(const LAS bf16x8*)(lds + PG8_SB(b, h) + boff + n * 2048 + k * 1024); } while (0)
#define PG8_MMA(ai, bj, At, Bt) do { __builtin_amdgcn_s_setprio(1); _Pragma("unroll") for (int m = 0; m < 4; ++m) _Pragma("unroll") for (int n = 0; n < 2; ++n) _Pragma("unroll") for (int k = 0; k < 2; ++k) \
        acc[ai][bj][m][n] = __builtin_amdgcn_mfma_f32_16x16x32_bf16(Bt[n][k], At[m][k], acc[ai][bj][m][n], 0, 0, 0); __builtin_amdgcn_s_setprio(0); } while (0)
#define PG8_WAIT_V(n) asm volatile("s_waitcnt vmcnt(" #n ")" ::: "memory")
#define PG8_WAIT_L(n) asm volatile("s_waitcnt lgkmcnt(" #n ")" ::: "memory")
#define PG8_BAR __builtin_amdgcn_s_barrier()
#define PG8_SCHED __builtin_amdgcn_sched_barrier(0)
    Unit cur, nxt; int ui = 0;
    if (!S.next(0, cur)) return;
#ifdef MK_PROBE
    unsigned long long gt_acc[3] = {0, 0, 0}; unsigned long long gt_last = __builtin_amdgcn_s_memtime();
#define PG8_T(k) do { if (epi_probe_v<Epi>) { const unsigned long long now_ = __builtin_amdgcn_s_memtime(); gt_acc[k] += now_ - gt_last; gt_last = now_; } } while (0)
#else
#define PG8_T(k) do { } while (0)
#endif
    unsigned offA[2][2], noffA[2][2];
    {
        const int* tk = GATHER ? S.a_rows(cur) : nullptr;
#pragma unroll
        for (int h = 0; h < 2; ++h)
#pragma unroll
            for (int i = 0; i < 2; ++i) offA[h][i] = (GATHER ? (unsigned)tk[h * HALF + rowA[i]] : (unsigned)(h * HALF) + rowA[i]) * (unsigned)(K * 2) + colA[i];
    }
    f32x4 acc[2][2][4][2];
#pragma unroll
    for (int a = 0; a < 2; ++a)
#pragma unroll
        for (int b = 0; b < 2; ++b)
#pragma unroll
            for (int m = 0; m < 4; ++m)
#pragma unroll
                for (int n = 0; n < 2; ++n) acc[a][b][m][n] = (f32x4){0.f, 0.f, 0.f, 0.f};
    bf16x8 At[4][2], B0[2][2], B1[2][2];
    const char* cA = S.a_ptr(cur); const char* cB = S.b_ptr(cur);
    PG8_STAGE(PG8_SB(0, 0), cB, voffB); PG8_STAGE(PG8_SB(0, 1), cB + hstep, voffB); PG8_STAGE(PG8_SA(0, 0), cA, offA[0]); PG8_STAGE(PG8_SA(0, 1), cA, offA[1]);
    if (wr == 1) PG8_BAR;
    PG8_WAIT_V(2); PG8_BAR;
    PG8_STAGE(PG8_SB(1, 0), cB + kstep, voffB); PG8_STAGE(PG8_SA(1, 0), cA + kstep, offA[0]); PG8_STAGE(PG8_SB(1, 1), cB + hstep + kstep, voffB);
    PG8_WAIT_V(6); PG8_BAR;
    for (;;) {
        const bool has_next = S.next(ui + 1, nxt);
        const char* nA = has_next ? S.a_ptr(nxt) : cA; const char* nB = has_next ? S.b_ptr(nxt) : cB;
        if (GATHER) {
            const int* tk = S.a_rows(has_next ? nxt : cur);
            int t00 = tk[rowA[0]], t01 = tk[rowA[1]], t10 = tk[HALF + rowA[0]], t11 = tk[HALF + rowA[1]];
            noffA[0][0] = (unsigned)t00 * (unsigned)(K * 2) + colA[0]; noffA[0][1] = (unsigned)t01 * (unsigned)(K * 2) + colA[1];
            noffA[1][0] = (unsigned)t10 * (unsigned)(K * 2) + colA[0]; noffA[1][1] = (unsigned)t11 * (unsigned)(K * 2) + colA[1];
        } else {
#pragma unroll
            for (int h = 0; h < 2; ++h)
#pragma unroll
                for (int i = 0; i < 2; ++i) noffA[h][i] = offA[h][i];
        }
#pragma unroll 1
        for (int t = 0; t < nt; t += 2) {
            const bool last = (t == nt - 2);
            const char* a1 = cA + (size_t)(t + 1) * kstep;
            const char* a2 = last ? nA : cA + (size_t)(t + 2) * kstep; const char* b2 = last ? nB : cB + (size_t)(t + 2) * kstep;
            const char* a3 = a2 + kstep; const char* b3 = b2 + kstep;
            unsigned o2[2][2];
#pragma unroll
            for (int h = 0; h < 2; ++h)
#pragma unroll
                for (int i = 0; i < 2; ++i) o2[h][i] = (GATHER && last) ? noffA[h][i] : offA[h][i];
            PG8_LDB(B0, 0, 0); PG8_LDB(B1, 0, 1); PG8_SCHED; PG8_LDA(At, 0, 0); PG8_STAGE(PG8_SA(1, 1), a1, offA[1]);
            PG8_WAIT_V(8); PG8_WAIT_L(0); PG8_BAR; PG8_MMA(0, 0, At, B0); PG8_MMA(0, 1, At, B1); PG8_BAR; PG8_SCHED;
            PG8_LDA(At, 0, 1); PG8_STAGE(PG8_SB(0, 0), b2, voffB); PG8_STAGE(PG8_SB(0, 1), b2 + hstep, voffB); PG8_STAGE(PG8_SA(0, 0), a2, o2[0]);
            PG8_WAIT_V(8); PG8_WAIT_L(0); PG8_BAR; PG8_MMA(1, 0, At, B0); PG8_MMA(1, 1, At, B1); PG8_BAR; PG8_SCHED;
            PG8_LDB(B0, 1, 0); PG8_LDB(B1, 1, 1); PG8_SCHED; PG8_LDA(At, 1, 0); PG8_STAGE(PG8_SA(0, 1), a2, o2[1]);
            PG8_WAIT_V(8); PG8_WAIT_L(0); PG8_BAR; PG8_MMA(0, 0, At, B0); PG8_MMA(0, 1, At, B1); PG8_BAR; PG8_SCHED;
            PG8_LDA(At, 1, 1); PG8_STAGE(PG8_SB(1, 0), b3, voffB); PG8_STAGE(PG8_SB(1, 1), b3 + hstep, voffB); PG8_STAGE(PG8_SA(1, 0), a3, o2[0]);
            PG8_WAIT_V(8); PG8_WAIT_L(0); PG8_BAR; PG8_MMA(1, 0, At, B0); PG8_MMA(1, 1, At, B1); PG8_BAR; PG8_SCHED;
        }
        PG8_T(0);
        if constexpr (ALIGN_EPI) { if (wr == 0) PG8_BAR; }
        bool keep_acc = false;
        if constexpr (epi_chain_v<Epi>) { if (cur.e == 0) { E.mid(acc, cur, wr, wc, fr, fq); keep_acc = true; } else E(acc, cur, wr, wc, fr, fq); }
        else E(acc, cur, wr, wc, fr, fq);
        PG8_T(1);
        if (!has_next) break;
        if (!keep_acc) {
#pragma unroll
        for (int a = 0; a < 2; ++a)
#pragma unroll
            for (int b = 0; b < 2; ++b)
#pragma unroll
                for (int m = 0; m < 4; ++m)
#pragma unroll
                    for (int n = 0; n < 2; ++n) acc[a][b][m][n] = (f32x4){0.f, 0.f, 0.f, 0.f};
        }
        cur = nxt; cA = nA; cB = nB; ++ui;
#pragma unroll
        for (int h = 0; h < 2; ++h)
#pragma unroll
            for (int i = 0; i < 2; ++i) offA[h][i] = noffA[h][i];
        if constexpr (ALIGN_EPI) { if (wr == 1) PG8_BAR; }
        PG8_T(2);
    }
    PG8_WAIT_V(0);
    if constexpr (!ALIGN_EPI) { if (wr == 0) PG8_BAR; }
    PG8_BAR;
#ifdef MK_PROBE
    if (epi_probe_v<Epi> && blockIdx.x == 0 && threadIdx.x == 0) { unsigned long long* tp = (unsigned long long*)S.probe_ptr(); for (int i = 0; i < 3; ++i) tp[i] = gt_acc[i]; tp[3] = 0; tp[4] = 0; tp[5] = 0; }
#endif
#undef PG8_T
#undef PG8_SA
#undef PG8_SB
#undef PG8_STAGE
#undef PG8_LDA
#undef PG8_LDB
#undef PG8_MMA
#undef PG8_WAIT_V
#undef PG8_WAIT_L
#undef PG8_BAR
#undef PG8_SCHED
}
}

#ifndef MK_TEST_THR
#define MK_TEST_THR 0.01f
#endif
#ifndef MK_N_LAUNCHES
#define MK_N_LAUNCHES 1
#endif
#define XB_TMO      128
#define XB_XCNT(j)  (256  + 64 * (j))
#define XB_XSUB(j)  (1280 + 64 * (j))
#define XB_XGEN(j)  (2304 + 64 * (j))
#define XB_TOP      3328
#define XB_TOPGEN   3392
#define XCD_BAR_WORDS 3456
#define XB_SPIN_CAP (1u << 22)

__device__ __forceinline__ unsigned xb_ld(unsigned* p)              { return __hip_atomic_load(p, __ATOMIC_RELAXED, __HIP_MEMORY_SCOPE_AGENT); }
__device__ __forceinline__ unsigned xb_add(unsigned* p, unsigned v) { return __hip_atomic_fetch_add(p, v, __ATOMIC_RELAXED, __HIP_MEMORY_SCOPE_AGENT); }
__device__ __forceinline__ unsigned xb_xcc_id() { return (unsigned)__builtin_amdgcn_s_getreg((3 << 11) | 20) & 0xFu; }
#define XB_SPIN(cond, bar) do { unsigned _sp = 0; while (cond) { __builtin_amdgcn_s_sleep(1); \
    if ((++_sp & 255u) == 0u) { if (xb_ld(&(bar)[XB_TMO])) break; if (_sp > XB_SPIN_CAP) { atomicAdd(&(bar)[XB_TMO], 1u); break; } } } } while (0)

struct XcdBarrier {
    unsigned* bar; unsigned x;
    volatile LAS unsigned* st;
};

__device__ __forceinline__ XcdBarrier xcd_barrier_post(unsigned* bar, volatile LAS unsigned* st) {
    XcdBarrier b; b.bar = bar; b.x = xb_xcc_id(); b.st = st;
    if (threadIdx.x == 0) (void)xb_add(&bar[XB_XCNT(b.x)], 1u);
    return b;
}
__device__ __forceinline__ void xcd_barrier_complete(unsigned* bar, unsigned x, unsigned& nloc, unsigned& nx) {
    const unsigned G = gridDim.x * gridDim.y * gridDim.z;
    unsigned sum, cnt, mine, sp = 0u;
    for (;;) {
        sum = 0u; cnt = 0u; mine = 0u;
#pragma unroll
        for (unsigned j = 0; j < 16; ++j) { const unsigned c = xb_ld(&bar[XB_XCNT(j)]); sum += c; cnt += (c > 0u) ? 1u : 0u; mine = (j == x) ? c : mine; }
        if (sum == G) break;
        __builtin_amdgcn_s_sleep(1);
        if ((++sp & 255u) == 0u) { if (xb_ld(&bar[XB_TMO])) break; if (sp > XB_SPIN_CAP) { atomicAdd(&bar[XB_TMO], 1u); break; } }
    }
    nloc = mine > 0u ? mine : 1u; nx = cnt > 0u ? cnt : 1u;
}

__device__ __forceinline__ void xcd_barrier(const XcdBarrier& b) {
    asm volatile("s_waitcnt vmcnt(0)" ::: "memory");
    __syncthreads();
    if (threadIdx.x == 0) {
        unsigned* bar = b.bar;
        __builtin_amdgcn_s_waitcnt(0);
        unsigned nloc = b.st[0], nx = b.st[1];
        if (nloc == 0u) { xcd_barrier_complete(bar, b.x, nloc, nx); b.st[0] = nloc; b.st[1] = nx; }
        const unsigned old = xb_add(&bar[XB_XSUB(b.x)], 1u);
        const unsigned gen = old / nloc;
        if (old + 1u == (gen + 1u) * nloc) {
            __builtin_amdgcn_fence(__ATOMIC_RELEASE, "agent");
            asm volatile("s_waitcnt vmcnt(0)" ::: "memory");
            const unsigned og = xb_add(&bar[XB_TOP], 1u);
            const unsigned tg = og / nx;
            if (og + 1u == (tg + 1u) * nx) xb_add(&bar[XB_TOPGEN], 1u);
            else XB_SPIN(xb_ld(&bar[XB_TOPGEN]) == tg, bar);
            __builtin_amdgcn_fence(__ATOMIC_ACQUIRE, "agent");
            xb_add(&bar[XB_XGEN(b.x)], 1u);
            asm volatile("s_waitcnt vmcnt(0)" ::: "memory");
        } else {
            XB_SPIN(xb_ld(&bar[XB_XGEN(b.x)]) == gen, bar);
            __builtin_amdgcn_fence(__ATOMIC_ACQUIRE, "agent");
            asm volatile("s_waitcnt vmcnt(0)" ::: "memory");
        }
    }
    __syncthreads();
}


struct Args { const float* in[25]; float* out; unsigned char* ws; int ph_lo, ph_hi, l_lo, l_hi; };
struct Frame {
    LAS unsigned char* lds;
    unsigned char* ws;
    int tid, lane, wave, G, bid;
};
enum { I_X = 0, I_C, I_ADAW, I_ADAB, I_NMIXW, I_NMOEW, I_WIN, I_CONVW, I_GATEB, I_MNORMW, I_ALPHAW, I_ALPHAB, I_GNORMW, I_WPA, I_WPB, I_WO, I_RW, I_RB, I_EW1, I_EW3, I_EW2, I_SW1, I_SW3, I_SW2, I_FNW };

__device__ __forceinline__ bf16_t* wsm(unsigned char* ws, int l, size_t off) { return (bf16_t*)(ws + WS_WSM + (size_t)l * WSM_STRIDE + off); }

__device__ __forceinline__ void tr_item(const float* W, int ldw, int c0, int k0, bf16_t* WT, int r0, int K, LAS float* scr, int lane) {
#pragma unroll 8
    for (int i = 0; i < 32; ++i) { const int kk = 2 * i + (lane >> 5); scr[kk * 33 + (lane & 31)] = W[(size_t)(k0 + kk) * ldw + c0 + (lane & 31)]; }
    LDS_WAIT(); asm volatile("" ::: "memory");
    const int c = lane & 7;
#pragma unroll
    for (int j = 0; j < 4; ++j) { const int n = (lane >> 3) + 8 * j; const LAS float* s = scr + (8 * c) * 33 + n;
        u32x4 o; o.x = pk2(s[0 * 33], s[1 * 33]); o.y = pk2(s[2 * 33], s[3 * 33]); o.z = pk2(s[4 * 33], s[5 * 33]); o.w = pk2(s[6 * 33], s[7 * 33]);
        *(u32x4*)(WT + (size_t)(r0 + n) * K + k0 + 8 * c) = o; }
    LDS_WAIT(); asm volatile("" ::: "memory");
}
constexpr int SW_ITEMS = 96 * 16 + 3 * 32 * 16 + 64 * 16 + 3 * 32 * 16 + 4 * 4 * 16 + 32 * 4 + 8 * 16 + 8 * 16;
__device__ __forceinline__ void small_item(const Args& a, unsigned char* ws, int l, int r, LAS float* scr, int lane) {
    const float* win = a.in[I_WIN] + (size_t)l * D * DIN;
    bf16_t* Win_t = wsm(ws, l, WO_IN);
    if (r < 96 * 16) { const int nb = r % 96, kb = r / 96; tr_item(win, DIN, nb * 32, kb * 64, Win_t, nb * 32, D, scr, lane); return; } r -= 96 * 16;
    if (r < 32 * 16) { const int nb = r % 32, kb = r / 32; tr_item(win, DIN, C_QG + nb * 32, kb * 64, Win_t, 3072 + nb * 32, D, scr, lane); return; } r -= 32 * 16;
    if (r < 32 * 16) { const int nb = r % 32, kb = r / 32; tr_item(win, DIN, C_VG + nb * 32, kb * 64, Win_t, 4096 + nb * 32, D, scr, lane); return; } r -= 32 * 16;
    if (r < 32 * 16) { const int nb = r % 32, kb = r / 32; tr_item(win, DIN, C_ZG + nb * 32, kb * 64, Win_t, 5120 + nb * 32, D, scr, lane); return; } r -= 32 * 16;
    if (r < 64 * 16) { const int nb = r % 64, kb = r / 64; tr_item(win, DIN, C_GA + nb * 32, kb * 64, wsm(ws, l, WO_GAB), nb * 32, D, scr, lane); return; } r -= 64 * 16;
    if (r < 32 * 16) { const int nb = r % 32, kb = r / 32; tr_item(a.in[I_WPA] + (size_t)l * D * D, D, nb * 32, kb * 64, wsm(ws, l, WO_PA), nb * 32, D, scr, lane); return; } r -= 32 * 16;
    if (r < 32 * 16) { const int nb = r % 32, kb = r / 32; tr_item(a.in[I_WPB] + (size_t)l * D * D, D, nb * 32, kb * 64, wsm(ws, l, WO_PB), nb * 32, D, scr, lane); return; } r -= 32 * 16;
    if (r < 32 * 16) { const int nb = r % 32, kb = r / 32; tr_item(a.in[I_WO] + (size_t)l * D * D, D, nb * 32, kb * 64, wsm(ws, l, WO_O), nb * 32, D, scr, lane); return; } r -= 32 * 16;
    if (r < 4 * 4 * 16) { const int seg = r / 64, it = r % 64, nb = it % 4, kb = it / 4;
        const float* src = ((seg & 1) ? a.in[I_SW3] : a.in[I_SW1]) + (size_t)l * D * DE;
        tr_item(src, DE, (seg >> 1) * 128 + nb * 32, kb * 64, wsm(ws, l, WO_S13), seg * 128 + nb * 32, D, scr, lane); return; } r -= 256;
    if (r < 32 * 4) { const int nb = r % 32, kb = r / 32; tr_item(a.in[I_SW2] + (size_t)l * DE * D, D, nb * 32, kb * 64, wsm(ws, l, WO_S2), nb * 32, DE, scr, lane); return; } r -= 128;
    if (r < 8 * 16) {
        const int nb = r % 8, kb = r / 8; bf16_t* Wr = wsm(ws, l, WO_R);
        if (nb < 2) tr_item(a.in[I_RW] + (size_t)l * D * NE, NE, nb * 32, kb * 64, Wr, nb * 32, D, scr, lane);
        else for (int j = 0; j < 32; ++j) Wr[(size_t)(nb * 32 + j) * D + kb * 64 + lane] = 0;
        return; } r -= 128;
    {
        const int rb = r % 8, kb = r / 8;
        for (int j = 0; j < 32; ++j) {
            const int row = rb * 32 + j; float v = 0.f;
            if (row < 24) { const int srcc = row < 4 ? C_IM + row : (row < 8 ? C_FM + row - 4 : C_RG + row - 8); v = win[(size_t)(kb * 64 + lane) * DIN + srcc]; }
            Win_t[(size_t)(6144 + row) * D + kb * 64 + lane] = (bf16_t)f2bf(v);
        }
    }
}
constexpr int EX_ITEMS = 64 * 384;
__device__ __forceinline__ void expert_item(const Args& a, unsigned char* ws, int l, int idx, LAS float* scr, int lane) {
    const int e = idx / 384; int r = idx % 384;
    if (r < 256) { const int seg = r / 64, it = r % 64, nb = it % 4, kb = it / 4;
        const float* src = ((seg & 1) ? a.in[I_EW3] : a.in[I_EW1]) + ((size_t)l * NE + e) * D * DE;
        tr_item(src, DE, (seg >> 1) * 128 + nb * 32, kb * 64, (bf16_t*)(ws + WS_WEXP13) + (size_t)e * 512 * D, seg * 128 + nb * 32, D, scr, lane); return; }
    r -= 256; { const int nb = r % 32, kb = r / 32;
        tr_item(a.in[I_EW2] + ((size_t)l * NE + e) * DE * D, D, nb * 32, kb * 64, (bf16_t*)(ws + WS_WEXP2) + (size_t)e * D * DE, nb * 32, DE, scr, lane); }
}
constexpr int SW_FIRST = 96 * 16 + 3 * 32 * 16 + 64 * 16;
constexpr int SW_DEFER0 = SW_ITEMS - 128 - SW_FIRST;
__device__ __forceinline__ void small_deferred0(const Args& a, unsigned char* ws, int it, LAS float* scr, int lane) { small_item(a, ws, 0, SW_FIRST + it, scr, lane); }
__device__ __forceinline__ void p0a(const Args& a, Frame& F, bool experts0) {
    const int gw = F.bid * NWAVES + F.wave, NGW = F.G * NWAVES;
    LAS float* cond = (LAS float*)F.lds;
    LAS float* scr = (LAS float*)(F.lds + F.wave * 8704);
    if (F.bid * NWAVES < 768) {
        const float* c = a.in[I_C];
        for (int i = F.tid; i < NB * D; i += NTHREADS) cond[i] = siluf_(c[i]);
        __syncthreads();
        if (gw < 768) {
            const int l = gw / 384, r = gw % 384, j = (r >> 2) * 64 + F.lane, b0 = (r & 3) * 4;
            const float* w = a.in[I_ADAW] + (size_t)l * D * 6 * D + j;
            float acc[4] = {0.f, 0.f, 0.f, 0.f};
#pragma unroll 8
            for (int k = 0; k < D; ++k) { const float wv = w[(size_t)k * 6 * D];
#pragma unroll
                for (int b = 0; b < 4; ++b) acc[b] += cond[(b0 + b) * D + k] * wv; }
            const float bb = a.in[I_ADAB][l * 6 * D + j];
            float* ada = (float*)(F.ws + WS_ADA);
#pragma unroll
            for (int b = 0; b < 4; ++b) ada[((size_t)l * NB + b0 + b) * 6 * D + j] = acc[b] + bb;
        }
        __syncthreads();
    }
    const int total = SW_FIRST + 128 + (experts0 ? EX_ITEMS : 0);
    for (int it = gw; it < total; it += NGW) {
        if (it < SW_FIRST) small_item(a, F.ws, 0, it, scr, F.lane);
        else if (it < SW_FIRST + 128) small_item(a, F.ws, 0, SW_ITEMS - 128 + (it - SW_FIRST), scr, F.lane);
        else expert_item(a, F.ws, 0, it - SW_FIRST - 128, scr, F.lane);
    }
}
__device__ __forceinline__ void p_norm(Frame& F, const float* h, const float* w, const float* sh, const float* sc, bf16_t* U) {
    const int gw = F.bid * NWAVES + F.wave, NGW = F.G * NWAVES, RPW = (T + NGW - 1) / NGW;
    const int r0 = gw * RPW, r1 = (r0 + RPW < T) ? r0 + RPW : T;
    f32x4 av[4], bv[4]; int bcur = -1;
    f32x4 v[4], vn[4];
    if (r0 < r1) { const f32x4* xr = (const f32x4*)(h + (size_t)r0 * D) + F.lane;
#pragma unroll
        for (int j = 0; j < 4; ++j) v[j] = xr[64 * j]; }
    for (int row = r0; row < r1; ++row) {
        const int b = row / S;
        { const int nrow = (row + 1 < r1) ? row + 1 : row; const f32x4* xn = (const f32x4*)(h + (size_t)nrow * D) + F.lane;
#pragma unroll
          for (int j = 0; j < 4; ++j) vn[j] = xn[64 * j]; }
        if (b != bcur) { bcur = b;
#pragma unroll
            for (int j = 0; j < 4; ++j) { const f32x4 scv = ((const f32x4*)(sc + (size_t)b * 6 * D))[F.lane + 64 * j]; av[j] = ((const f32x4*)w)[F.lane + 64 * j] * (scv + 1.f); bv[j] = ((const f32x4*)(sh + (size_t)b * 6 * D))[F.lane + 64 * j]; } }
        float ss = 0.f;
#pragma unroll
        for (int j = 0; j < 4; ++j) ss += (v[j].x * v[j].x + v[j].y * v[j].y) + (v[j].z * v[j].z + v[j].w * v[j].w);
        const float r = rsqrtf(wave_sum(ss) * (1.f / D) + EPS);
        u32x2* o = (u32x2*)(U + (size_t)row * D) + F.lane;
#pragma unroll
        for (int j = 0; j < 4; ++j) {
            const f32x4 y = v[j] * r * av[j] + bv[j];
            u32x2 pk; pk.x = cvt_pk_bf16(y.x, y.y); pk.y = cvt_pk_bf16(y.z, y.w); o[64 * j] = pk;
        }
#pragma unroll
        for (int j = 0; j < 4; ++j) v[j] = vn[j];
    }
}
struct SchedDense {
    pg8::TileOrder O; const char* A; const char* B; size_t tstep;
    __device__ bool next(int i, pg8::Unit& u) const { u.e = 0; return O.tile(i, u.pm, u.pn); }
    __device__ const char* a_ptr(const pg8::Unit& u) const { return A + (size_t)u.pm * tstep; }
    __device__ const char* b_ptr(const pg8::Unit& u) const { return B + (size_t)u.pn * tstep; }
    __device__ const int* a_rows(const pg8::Unit&) const { return nullptr; }
    unsigned char* pp = nullptr; __device__ void* probe_ptr() const { return pp; }
};
struct EpiInProj {
    static constexpr bool PERM = true;
    bf16_t* PB; float* small;
    __device__ __forceinline__ void operator()(const f32x4 (&acc)[2][2][4][2], const pg8::Unit& u, int wr, int wc, int fr, int fq) const {
        const int row0 = u.pm * 256 + wr * 64 + fr;
        if (u.pn < 24) {
            bf16_t* base = PB + (size_t)(u.pn >> 2) * (PB_STRIDE / 2) + (u.pn & 3) * 256 + wc * 32 + 8 * fq;
            const int gate = (u.pn >> 2) == 2 ? 1 : ((u.pn >> 2) == 5 ? 2 : 0);
#pragma unroll
            for (int ai = 0; ai < 2; ++ai)
#pragma unroll
                for (int m = 0; m < 4; ++m) { bf16_t* rowp = base + (size_t)(row0 + ai * 128 + m * 16) * D;
#pragma unroll
                    for (int bj = 0; bj < 2; ++bj) { f32x4 v0 = acc[ai][bj][m][0], v1 = acc[ai][bj][m][1];
                        if (gate) {
#pragma unroll
                            for (int k = 0; k < 4; ++k) { const float s0 = fsigmoid(v0[k]), s1 = fsigmoid(v1[k]); v0[k] = gate == 1 ? s0 : v0[k] * s0; v1[k] = gate == 1 ? s1 : v1[k] * s1; } }
                        u32x4 w; w.x = cvt_pk_bf16(v0[0], v0[1]); w.y = cvt_pk_bf16(v0[2], v0[3]); w.z = cvt_pk_bf16(v1[0], v1[1]); w.w = cvt_pk_bf16(v1[2], v1[3]);
                        *(u32x4*)(rowp + bj * 128) = w; } }
        } else if (wc == 0) {
#pragma unroll
            for (int ai = 0; ai < 2; ++ai)
#pragma unroll
                for (int m = 0; m < 4; ++m) { float* rp = small + (size_t)(row0 + ai * 128 + m * 16) * 32 + 8 * fq;
                    *(f32x4*)rp = acc[ai][0][m][0]; *(f32x4*)(rp + 4) = acc[ai][0][m][1]; }
        }
    }
};
__device__ __forceinline__ void p_inproj(Frame& F, int l) {
    SchedDense Sd; Sd.O.init(T / 256, 25, F.G, F.bid); Sd.A = (const char*)(F.ws + WS_U); Sd.B = (const char*)wsm(F.ws, l, WO_IN); Sd.tstep = (size_t)256 * D * 2;
    EpiInProj E{(bf16_t*)(F.ws + WS_PB), (float*)(F.ws + WS_SMALL)};
    pg8::gemm_phase<EpiInProj, SchedDense, false>(F.lds, D, Sd, E);
}


struct EpiSig { static constexpr bool PERM = true;
    bf16_t* PB; int pn_off;
    __device__ __forceinline__ void operator()(const f32x4 (&acc)[2][2][4][2], const pg8::Unit& u, int wr, int wc, int fr, int fq) const {
        const int row0 = u.pm * 256 + wr * 64 + fr, pn = u.pn + pn_off;
        bf16_t* base = PB + (size_t)(pn >> 2) * (PB_STRIDE / 2) + (pn & 3) * 256 + wc * 32 + 8 * fq;
#pragma unroll
        for (int ai = 0; ai < 2; ++ai)
#pragma unroll
            for (int m = 0; m < 4; ++m) { bf16_t* rowp = base + (size_t)(row0 + ai * 128 + m * 16) * D;
#pragma unroll
                for (int bj = 0; bj < 2; ++bj) { const f32x4 v0 = acc[ai][bj][m][0], v1 = acc[ai][bj][m][1];
                    u32x4 w; w.x = cvt_pk_bf16(fsigmoid(v0[0]), fsigmoid(v0[1])); w.y = cvt_pk_bf16(fsigmoid(v0[2]), fsigmoid(v0[3]));
                    w.z = cvt_pk_bf16(fsigmoid(v1[0]), fsigmoid(v1[1])); w.w = cvt_pk_bf16(fsigmoid(v1[2]), fsigmoid(v1[3]));
                    *(u32x4*)(rowp + bj * 128) = w; } }
    }
};
__device__ __forceinline__ unsigned char* sb8_base(const unsigned char* sa8, int l, int pm) {
    const long offA = (long)(WS_WSM + (size_t)(1 - l) * WSM_STRIDE) - (long)WS_SA8, offB = (long)WS_SB8T - (long)((size_t)SB8_SPLIT * D) - (long)WS_SA8;
    return (unsigned char*)sa8 + (pm < SB8_SPLIT / 256 ? offA : offB);
}
struct EpiSig8 { static constexpr bool PERM = true;
    unsigned char* SA8; int l;
    __device__ __forceinline__ void operator()(const f32x4 (&acc)[2][2][4][2], const pg8::Unit& u, int wr, int wc, int fr, int fq) const {
        const int row0 = u.pm * 256 + wr * 64 + fr; unsigned char* base = (u.pn < 4 ? SA8 : sb8_base(SA8, l, u.pm)) + (u.pn & 3) * 256 + wc * 32 + 8 * fq;
#pragma unroll
        for (int ai = 0; ai < 2; ++ai)
#pragma unroll
            for (int m = 0; m < 4; ++m) { unsigned char* rowp = base + (size_t)(row0 + ai * 128 + m * 16) * D;
#pragma unroll
                for (int bj = 0; bj < 2; ++bj) { const f32x4 v0 = acc[ai][bj][m][0], v1 = acc[ai][bj][m][1];
                    u32x2 w;
                    w.x = (unsigned)(fsigmoid(v0[0]) * 255.f + 0.5f) | ((unsigned)(fsigmoid(v0[1]) * 255.f + 0.5f) << 8) | ((unsigned)(fsigmoid(v0[2]) * 255.f + 0.5f) << 16) | ((unsigned)(fsigmoid(v0[3]) * 255.f + 0.5f) << 24);
                    w.y = (unsigned)(fsigmoid(v1[0]) * 255.f + 0.5f) | ((unsigned)(fsigmoid(v1[1]) * 255.f + 0.5f) << 8) | ((unsigned)(fsigmoid(v1[2]) * 255.f + 0.5f) << 16) | ((unsigned)(fsigmoid(v1[3]) * 255.f + 0.5f) << 24);
                    *(u32x2*)(rowp + bj * 128) = w; } }
    }
};
__device__ __forceinline__ void p_gates_a_idle(Frame& F, int l) {
    SchedDense Sd; Sd.O.init(T / 256, 8, F.G - 128, F.bid - 128); Sd.A = (const char*)(F.ws + WS_U); Sd.B = (const char*)wsm(F.ws, l, WO_GAB); Sd.tstep = (size_t)256 * D * 2;
    EpiSig8 E{(unsigned char*)(F.ws + WS_SA8), l};
    pg8::gemm_phase<EpiSig8, SchedDense, false>(F.lds, D, Sd, E);
}
__device__ __forceinline__ void p_gates(Frame& F, int l) {
    if (F.G > 128) return;
    {
        SchedDense Sd; Sd.O.init(T / 256, 8, F.G, F.bid); Sd.A = (const char*)(F.ws + WS_U); Sd.B = (const char*)wsm(F.ws, l, WO_GAB); Sd.tstep = (size_t)256 * D * 2;
        EpiSig E{(bf16_t*)(F.ws + WS_PB), 0};
        pg8::gemm_phase<EpiSig, SchedDense, false>(F.lds, D, Sd, E);
    }
}
struct SchedY {
    pg8::TileOrder O; const char* A0; const char* A1; const char* B0; const char* B1; size_t tstep;
    __device__ bool next(int i, pg8::Unit& u) const { u.e = i & 1; return O.tile(i >> 1, u.pm, u.pn); }
    __device__ const char* a_ptr(const pg8::Unit& u) const { return (u.e ? A1 : A0) + (size_t)u.pm * tstep; }
    __device__ const char* b_ptr(const pg8::Unit& u) const { return (u.e ? B1 : B0) + (size_t)u.pn * tstep; }
    __device__ const int* a_rows(const pg8::Unit&) const { return nullptr; }
    unsigned char* pp = nullptr; __device__ void* probe_ptr() const { return pp; }
};
struct EpiY { static constexpr bool PERM = true;
    const bf16_t* SA; const bf16_t* SB; bf16_t* Y; const unsigned char* SA8; int l;
    __device__ __forceinline__ void operator()(const f32x4 (&acc)[2][2][4][2], const pg8::Unit& u, int wr, int wc, int fr, int fq) const {
        const int row0 = u.pm * 256 + wr * 64 + fr; const size_t colb = (size_t)u.pn * 256 + wc * 32 + 8 * fq;
        const bf16_t* G = u.e ? SB : SA;
        const unsigned char* G8 = SA8 ? (u.e ? sb8_base(SA8, l, u.pm) : SA8) : nullptr;
#pragma unroll
        for (int ai = 0; ai < 2; ++ai) {
            u32x2 g8[4][2]; u32x4 gb[4][2]; u32x4 yv[4][2];
#pragma unroll
            for (int m = 0; m < 4; ++m) { const size_t ro = (size_t)(row0 + ai * 128 + m * 16) * D + colb;
#pragma unroll
                for (int bj = 0; bj < 2; ++bj) {
                    if (G8) g8[m][bj] = *(const u32x2*)(G8 + ro + bj * 128); else gb[m][bj] = *(const u32x4*)(G + ro + bj * 128);
                    if (u.e) yv[m][bj] = *(const u32x4*)(Y + ro + bj * 128); } }
#pragma unroll
            for (int m = 0; m < 4; ++m) { const size_t ro = (size_t)(row0 + ai * 128 + m * 16) * D + colb;
#pragma unroll
                for (int bj = 0; bj < 2; ++bj) { const f32x4 v0 = acc[ai][bj][m][0], v1 = acc[ai][bj][m][1];
                    float r0, r1, r2, r3, r4, r5, r6, r7;
                    if (G8) { const u32x2 q8 = g8[m][bj]; const float k = 1.f / 255.f;
                        r0 = (float)(q8.x & 255u) * k * v0[0]; r1 = (float)((q8.x >> 8) & 255u) * k * v0[1]; r2 = (float)((q8.x >> 16) & 255u) * k * v0[2]; r3 = (float)(q8.x >> 24) * k * v0[3];
                        r4 = (float)(q8.y & 255u) * k * v1[0]; r5 = (float)((q8.y >> 8) & 255u) * k * v1[1]; r6 = (float)((q8.y >> 16) & 255u) * k * v1[2]; r7 = (float)(q8.y >> 24) * k * v1[3]; }
                    else { const u32x4 g = gb[m][bj];
                        r0 = bflo(g.x) * v0[0]; r1 = bfhi(g.x) * v0[1]; r2 = bflo(g.y) * v0[2]; r3 = bfhi(g.y) * v0[3]; r4 = bflo(g.z) * v1[0]; r5 = bfhi(g.z) * v1[1]; r6 = bflo(g.w) * v1[2]; r7 = bfhi(g.w) * v1[3]; }
                    if (u.e) { const u32x4 y = yv[m][bj];
                        r0 += bflo(y.x); r1 += bfhi(y.x); r2 += bflo(y.y); r3 += bfhi(y.y); r4 += bflo(y.z); r5 += bfhi(y.z); r6 += bflo(y.w); r7 += bfhi(y.w); }
                    u32x4 w; w.x = cvt_pk_bf16(r0, r1); w.y = cvt_pk_bf16(r2, r3); w.z = cvt_pk_bf16(r4, r5); w.w = cvt_pk_bf16(r6, r7);
                    *(u32x4*)(Y + ro + bj * 128) = w; } }
        }
    }
};
struct EpiYC { static constexpr bool PERM = true;
    bf16_t* Y; const unsigned char* SA8; int l;
    static __device__ __forceinline__ float q8f(unsigned b) { return fmaxf((float)b, 0.5f) * (1.f / 255.f); }
    __device__ __forceinline__ void mid(f32x4 (&acc)[2][2][4][2], const pg8::Unit& u, int wr, int wc, int fr, int fq) const {
        const int row0 = u.pm * 256 + wr * 64 + fr; const size_t colb = (size_t)u.pn * 256 + wc * 32 + 8 * fq;
        const unsigned char* GB = sb8_base(SA8, l, u.pm);
#pragma unroll
        for (int ai = 0; ai < 2; ++ai) {
            u32x2 ga[4][2], gb[4][2];
#pragma unroll
            for (int m = 0; m < 4; ++m) { const size_t ro = (size_t)(row0 + ai * 128 + m * 16) * D + colb;
#pragma unroll
                for (int bj = 0; bj < 2; ++bj) { ga[m][bj] = *(const u32x2*)(SA8 + ro + bj * 128); gb[m][bj] = *(const u32x2*)(GB + ro + bj * 128); } }
#pragma unroll
            for (int m = 0; m < 4; ++m)
#pragma unroll
                for (int bj = 0; bj < 2; ++bj) { const u32x2 a8 = ga[m][bj], b8 = gb[m][bj];
#pragma unroll
                    for (int k = 0; k < 4; ++k) {
                        acc[ai][bj][m][0][k] *= (float)((a8.x >> (8 * k)) & 255u) * (1.f / 255.f) * frcp(q8f((b8.x >> (8 * k)) & 255u));
                        acc[ai][bj][m][1][k] *= (float)((a8.y >> (8 * k)) & 255u) * (1.f / 255.f) * frcp(q8f((b8.y >> (8 * k)) & 255u)); } }
        }
    }
    __device__ __forceinline__ void operator()(const f32x4 (&acc)[2][2][4][2], const pg8::Unit& u, int wr, int wc, int fr, int fq) const {
        const int row0 = u.pm * 256 + wr * 64 + fr; const size_t colb = (size_t)u.pn * 256 + wc * 32 + 8 * fq;
        const unsigned char* GB = sb8_base(SA8, l, u.pm);
#pragma unroll
        for (int ai = 0; ai < 2; ++ai) {
            u32x2 gb[4][2];
#pragma unroll
            for (int m = 0; m < 4; ++m) { const size_t ro = (size_t)(row0 + ai * 128 + m * 16) * D + colb;
#pragma unroll
                for (int bj = 0; bj < 2; ++bj) gb[m][bj] = *(const u32x2*)(GB + ro + bj * 128); }
#pragma unroll
            for (int m = 0; m < 4; ++m) { const size_t ro = (size_t)(row0 + ai * 128 + m * 16) * D + colb;
#pragma unroll
                for (int bj = 0; bj < 2; ++bj) { const f32x4 v0 = acc[ai][bj][m][0], v1 = acc[ai][bj][m][1]; const u32x2 b8 = gb[m][bj];
                    u32x4 w;
                    w.x = cvt_pk_bf16(v0[0] * q8f(b8.x & 255u), v0[1] * q8f((b8.x >> 8) & 255u)); w.y = cvt_pk_bf16(v0[2] * q8f((b8.x >> 16) & 255u), v0[3] * q8f(b8.x >> 24));
                    w.z = cvt_pk_bf16(v1[0] * q8f(b8.y & 255u), v1[1] * q8f((b8.y >> 8) & 255u)); w.w = cvt_pk_bf16(v1[2] * q8f((b8.y >> 16) & 255u), v1[3] * q8f(b8.y >> 24));
                    *(u32x4*)(Y + ro + bj * 128) = w; } }
        }
    }
};
template <> constexpr bool epi_chain_v<EpiYC> = true;
__device__ __forceinline__ void p_y(Frame& F, int l) {
    SchedY Sy; Sy.O.init(T / 256, 4, F.G, F.bid); Sy.A0 = (const char*)(F.ws + WS_PB + 2 * PB_STRIDE); Sy.A1 = (const char*)(F.ws + WS_PB + 5 * PB_STRIDE);
    Sy.B0 = (const char*)wsm(F.ws, l, WO_PA); Sy.B1 = (const char*)wsm(F.ws, l, WO_PB); Sy.tstep = (size_t)256 * D * 2;
    if (F.G > 128) { EpiYC E{(bf16_t*)(F.ws + WS_PB + 3 * PB_STRIDE), (const unsigned char*)(F.ws + WS_SA8), l}; pg8::gemm_phase<EpiYC, SchedY, false>(F.lds, D, Sy, E); return; }
    EpiY E{(const bf16_t*)(F.ws + WS_PB), (const bf16_t*)(F.ws + WS_PB + PB_STRIDE), (bf16_t*)(F.ws + WS_PB + 3 * PB_STRIDE), nullptr, l};
    pg8::gemm_phase<EpiY, SchedY, false>(F.lds, D, Sy, E);
}

struct EpiResid { static constexpr bool PERM = false;
    const float* hin; float* hout; const float* gate;
    __device__ __forceinline__ void operator()(const f32x4 (&acc)[2][2][4][2], const pg8::Unit& u, int wr, int wc, int fr, int fq) const {
        const int row0 = u.pm * 256 + wr * 64 + fr, col0 = u.pn * 256 + wc * 32 + 4 * fq;
        const int b = (u.pm * 256) / S;
        f32x4 gv[2][2];
#pragma unroll
        for (int bj = 0; bj < 2; ++bj)
#pragma unroll
            for (int n = 0; n < 2; ++n) gv[bj][n] = *(const f32x4*)(gate + (size_t)b * 6 * D + col0 + bj * 128 + n * 16);
#pragma unroll
        for (int ai = 0; ai < 2; ++ai)
#pragma unroll
            for (int m = 0; m < 4; ++m) { const size_t ro = (size_t)(row0 + ai * 128 + m * 16) * D + col0;
#pragma unroll
                for (int bj = 0; bj < 2; ++bj)
#pragma unroll
                    for (int n = 0; n < 2; ++n) { const f32x4 hv = *(const f32x4*)(hin + ro + bj * 128 + n * 16);
                        *(f32x4*)(hout + ro + bj * 128 + n * 16) = hv + gv[bj][n] * acc[ai][bj][m][n]; } }
    }
};
__device__ __forceinline__ void p_wo(const Args& a, Frame& F, int l) {
    SchedDense Sd; Sd.O.init(T / 256, 4, F.G, F.bid); Sd.A = (const char*)(F.ws + WS_PB + 3 * PB_STRIDE); Sd.B = (const char*)wsm(F.ws, l, WO_O); Sd.tstep = (size_t)256 * D * 2;
    EpiResid E{l == 0 ? a.in[I_X] : a.out, a.out, (const float*)(F.ws + WS_ADA) + (size_t)l * NB * 6 * D + 2 * D};
    pg8::gemm_phase<EpiResid, SchedDense, false>(F.lds, D, Sd, E);
}


constexpr size_t WS_IDENT = 165 * MiB;
constexpr size_t WS_Y2H = 166 * MiB;
constexpr int VTILES = NBLK + T / 256, VROWS = VTILES * 256;
constexpr size_t WS_HB = WS_Y2H + (size_t)VROWS * 1024;
constexpr size_t WS_MOE_END = WS_HB + (size_t)VROWS * 256 * 2;
static_assert(WS_MOE_END <= 622 * MiB, "moe overlay");

__device__ __forceinline__ void p_norm2(const Args& a, Frame& F, int l) {
    const float* ada = (const float*)(F.ws + WS_ADA) + (size_t)l * NB * 6 * D;
    int* ident = (int*)(F.ws + WS_IDENT); int* row_tok = (int*)(F.ws + WS_ROWTOK);
    for (int i = F.bid * NTHREADS + F.tid; i < NROWS; i += F.G * NTHREADS) { row_tok[i] = 0; if (i < T) ident[i] = i; }
    p_norm(F, a.out, a.in[I_NMOEW] + l * D, ada + 3 * D, ada + 4 * D, (bf16_t*)(F.ws + WS_U));
}
struct EpiLogits { static constexpr bool PERM = false; float* L;
    __device__ __forceinline__ void operator()(const f32x4 (&acc)[2][2][4][2], const pg8::Unit& u, int wr, int wc, int fr, int fq) const {
        if (wc >= 2) return;
        const int row0 = u.pm * 256 + wr * 64 + fr, col0 = wc * 32 + 4 * fq;
#pragma unroll
        for (int ai = 0; ai < 2; ++ai)
#pragma unroll
            for (int m = 0; m < 4; ++m) { float* rp = L + (size_t)(row0 + ai * 128 + m * 16) * NE + col0;
#pragma unroll
                for (int n = 0; n < 2; ++n) *(f32x4*)(rp + n * 16) = acc[ai][0][m][n]; }
    }
};
__device__ __forceinline__ void p_router(const Args& a, Frame& F, int l) {
    if (l == 0 && F.G > 128 && F.bid >= 128) {
        const int gw = (F.bid - 128) * NWAVES + F.wave, NGW = (F.G - 128) * NWAVES; LAS float* scr = (LAS float*)(F.lds + F.wave * 8704);
        for (int it = gw; it < SW_ITEMS; it += NGW) small_item(a, F.ws, 1, it, scr, F.lane);
        return;
    }
    SchedDense Sd; Sd.O.init(T / 256, 1, F.G, F.bid); Sd.A = (const char*)(F.ws + WS_U); Sd.B = (const char*)wsm(F.ws, l, WO_R); Sd.tstep = (size_t)256 * D * 2;
    EpiLogits E{(float*)(F.ws + WS_LOGITS)};
    pg8::gemm_phase<EpiLogits, SchedDense, false>(F.lds, D, Sd, E);
}
template <int CTRL> __device__ __forceinline__ float dpp_f(float v) { return __builtin_bit_cast(float, __builtin_amdgcn_update_dpp(0, __builtin_bit_cast(int, v), CTRL, 0xf, 0xf, true)); }
template <int CTRL> __device__ __forceinline__ int dpp_i(int v) { return __builtin_amdgcn_update_dpp(0, v, CTRL, 0xf, 0xf, true); }
__device__ __forceinline__ void p_topk(const Args& a, Frame& F, int l) {
    LAS int* lcnt = (LAS int*)(F.lds); LAS int* lbase = lcnt + 64;
    const float* logits = (const float*)(F.ws + WS_LOGITS); const float* router_b = a.in[I_RB] + l * NE;
    int* eidx = (int*)(F.ws + WS_EIDX); float* wts = (float*)(F.ws + WS_WTS); int* pos = (int*)(F.ws + WS_POS);
    int* gcnt = (int*)(F.ws + WS_CTL) + CW_CNT + l * 64;
    for (int blk = F.bid; blk < T / 128; blk += F.G) {
        __syncthreads();
        if (F.tid < 64) lcnt[F.tid] = 0;
        __syncthreads();
        const int t = blk * 128 + (F.tid >> 2), q = F.tid & 3;
        float sc[16], sel[16];
        { const f32x4* lg = (const f32x4*)(logits + (size_t)t * NE + 16 * q); const f32x4* rb = (const f32x4*)(router_b + 16 * q);
#pragma unroll
          for (int j4 = 0; j4 < 4; ++j4) { const f32x4 v = lg[j4], b = rb[j4];
              sc[4 * j4] = sigmoidf_(v.x); sc[4 * j4 + 1] = sigmoidf_(v.y); sc[4 * j4 + 2] = sigmoidf_(v.z); sc[4 * j4 + 3] = sigmoidf_(v.w);
              sel[4 * j4] = sc[4 * j4] + b.x; sel[4 * j4 + 1] = sc[4 * j4 + 1] + b.y; sel[4 * j4 + 2] = sc[4 * j4 + 2] + b.z; sel[4 * j4 + 3] = sc[4 * j4 + 3] + b.w; } }
        float gsm[2];
#pragma unroll
        for (int g = 0; g < 2; ++g) { float m1 = -INFINITY, m2 = -INFINITY;
#pragma unroll
            for (int j = 0; j < 8; ++j) { const float v = sel[g * 8 + j]; if (v > m1) { m2 = m1; m1 = v; } else if (v > m2) m2 = v; }
            gsm[g] = m1 + m2; }
        float gs[8];
        gs[0] = dpp_f<0x00>(gsm[0]); gs[1] = dpp_f<0x00>(gsm[1]); gs[2] = dpp_f<0x55>(gsm[0]); gs[3] = dpp_f<0x55>(gsm[1]);
        gs[4] = dpp_f<0xAA>(gsm[0]); gs[5] = dpp_f<0xAA>(gsm[1]); gs[6] = dpp_f<0xFF>(gsm[0]); gs[7] = dpp_f<0xFF>(gsm[1]);
        unsigned gmask = 0;
#pragma unroll
        for (int k = 0; k < 4; ++k) { int best = -1; float bv = -INFINITY;
#pragma unroll
            for (int g = 0; g < 8; ++g) if (!((gmask >> g) & 1u) && (best < 0 || gs[g] > bv)) { best = g; bv = gs[g]; }
            gmask |= 1u << best; }
        unsigned avail = (((gmask >> (2 * q)) & 1u) ? 0x00FFu : 0u) | (((gmask >> (2 * q + 1)) & 1u) ? 0xFF00u : 0u);
        int ei[TOPK]; float wv[TOPK]; float wsum = 0.f;
#pragma unroll
        for (int k = 0; k < TOPK; ++k) { float bv = -INFINITY, bs = 0.f; int bi = 64;
#pragma unroll
            for (int j = 0; j < 16; ++j) { const bool ok = ((avail >> j) & 1u) && (bi == 64 || sel[j] > bv); if (ok) { bv = sel[j]; bi = 16 * q + j; bs = sc[j]; } }
            { const float ov = dpp_f<0xB1>(bv), os = dpp_f<0xB1>(bs); const int oi = dpp_i<0xB1>(bi);
              const bool take = (oi < 64) && (bi == 64 || ov > bv || (ov == bv && oi < bi)); if (take) { bv = ov; bs = os; bi = oi; } }
            { const float ov = dpp_f<0x4E>(bv), os = dpp_f<0x4E>(bs); const int oi = dpp_i<0x4E>(bi);
              const bool take = (oi < 64) && (bi == 64 || ov > bv || (ov == bv && oi < bi)); if (take) { bv = ov; bs = os; bi = oi; } }
            ei[k] = bi; wv[k] = bs; wsum += bs;
            if ((bi >> 4) == q) avail &= ~(1u << (bi & 15)); }
        const int ea = q == 0 ? ei[0] : q == 1 ? ei[2] : q == 2 ? ei[4] : ei[6], eb = q == 0 ? ei[1] : q == 1 ? ei[3] : q == 2 ? ei[5] : ei[7];
        const float wa = q == 0 ? wv[0] : q == 1 ? wv[2] : q == 2 ? wv[4] : wv[6], wb = q == 0 ? wv[1] : q == 1 ? wv[3] : q == 2 ? wv[5] : wv[7];
        const int lpa = __hip_atomic_fetch_add(&lcnt[ea], 1, __ATOMIC_RELAXED, __HIP_MEMORY_SCOPE_WORKGROUP);
        const int lpb = __hip_atomic_fetch_add(&lcnt[eb], 1, __ATOMIC_RELAXED, __HIP_MEMORY_SCOPE_WORKGROUP);
        __syncthreads();
        if (F.tid < 64) lbase[F.tid] = atomicAdd(&gcnt[F.tid], lcnt[F.tid]);
        __syncthreads();
        { const int o = t * TOPK + 2 * q; const float sn = 2.5f / wsum;
          eidx[o] = ea; eidx[o + 1] = eb; wts[o] = wa * sn; wts[o + 1] = wb * sn; pos[o] = lbase[ea] + lpa; pos[o + 1] = lbase[eb] + lpb; }
    }
}
__device__ __forceinline__ int load_pend(Frame& F, int l, LAS int* pend) {
    const int* gcnt = (const int*)(F.ws + WS_CTL) + CW_CNT + l * 64;
    __syncthreads();
    if (F.tid < 64) {
        int v = (gcnt[F.tid] + 255) / 256 * 256;
#define DPP_ADDI(ctrl, rmask) v += __builtin_amdgcn_update_dpp(0, v, ctrl, rmask, 0xf, false)
        DPP_ADDI(0x111, 0xf); DPP_ADDI(0x112, 0xf); DPP_ADDI(0x114, 0xf); DPP_ADDI(0x118, 0xf); DPP_ADDI(0x142, 0xa); DPP_ADDI(0x143, 0xc);
#undef DPP_ADDI
        pend[F.tid] = v; }
    __syncthreads();
    const int ntiles = pend[NE - 1] / 256;
    LAS unsigned char* tile_e = (LAS unsigned char*)(pend + 64);
    for (int j = F.tid; j < ntiles; j += NTHREADS) { int lo_ = 0, hi_ = NE - 1;
        while (lo_ < hi_) { const int mid = (lo_ + hi_) >> 1; if (pend[mid] > j * 256) hi_ = mid; else lo_ = mid + 1; }
        tile_e[j] = (unsigned char)lo_; }
    __syncthreads();
    return ntiles;
}
__device__ __forceinline__ void p_fill(Frame& F, int l) {
    LAS int* pend = (LAS int*)(F.lds + MISC_OFF + 1024);
    load_pend(F, l, pend);
    const int* eidx = (const int*)(F.ws + WS_EIDX); int* pos = (int*)(F.ws + WS_POS); int* row_tok = (int*)(F.ws + WS_ROWTOK);
    for (int i = F.bid * NTHREADS + F.tid; i < NASSIGN; i += F.G * NTHREADS) {
        const int e = eidx[i]; const int dest = (e ? pend[e - 1] : 0) + pos[i];
        row_tok[dest] = i / TOPK; pos[i] = dest;
    }
}
struct SchedMoe1 {
    int G, c, ntiles; const LAS int* pend; const char* Ubase; const char* W13; const char* Ws13; const int* row_tok; const int* ident;
    __device__ bool next(int i, pg8::Unit& u) const {
        const int q = i * G + c; if (q >= 2 * (ntiles + T / 256)) return false;
        const int j = q >> 1; u.pn = q & 1;
        if (j < ntiles) { u.pm = j; u.e = ((const LAS unsigned char*)(pend + 64))[j]; } else { u.pm = NBLK + (j - ntiles); u.e = NE; }
        return true; }
    __device__ const char* a_ptr(const pg8::Unit&) const { return Ubase; }
    __device__ const char* b_ptr(const pg8::Unit& u) const { return (u.e < NE ? W13 + (size_t)u.e * 512 * D * 2 : Ws13) + (size_t)u.pn * 256 * D * 2; }
    __device__ const int* a_rows(const pg8::Unit& u) const { return u.e < NE ? row_tok + (size_t)u.pm * 256 : ident + (size_t)(u.pm - NBLK) * 256; }
    unsigned char* pp = nullptr; __device__ void* probe_ptr() const { return pp; }
};
struct EpiHb { static constexpr bool PERM = true; bf16_t* HB;
    __device__ __forceinline__ void operator()(const f32x4 (&acc)[2][2][4][2], const pg8::Unit& u, int wr, int wc, int fr, int fq) const {
        const int row0 = u.pm * 256 + wr * 64 + fr; bf16_t* base = HB + u.pn * 128 + wc * 32 + 8 * fq;
#pragma unroll
        for (int ai = 0; ai < 2; ++ai)
#pragma unroll
            for (int m = 0; m < 4; ++m) { const f32x4 a0 = acc[ai][0][m][0], a1 = acc[ai][0][m][1], b0 = acc[ai][1][m][0], b1 = acc[ai][1][m][1];
                u32x4 w; w.x = cvt_pk_bf16(fsilu(a0[0]) * b0[0], fsilu(a0[1]) * b0[1]); w.y = cvt_pk_bf16(fsilu(a0[2]) * b0[2], fsilu(a0[3]) * b0[3]);
                w.z = cvt_pk_bf16(fsilu(a1[0]) * b1[0], fsilu(a1[1]) * b1[1]); w.w = cvt_pk_bf16(fsilu(a1[2]) * b1[2], fsilu(a1[3]) * b1[3]);
                *(u32x4*)(base + (size_t)(row0 + ai * 128 + m * 16) * DE) = w; }
    }
};
__device__ __forceinline__ int vcu_of(const Frame& F) { return (F.G % 8 == 0) ? (F.bid % 8) * (F.G / 8) + F.bid / 8 : F.bid; }
__device__ __forceinline__ void p_gemm1(Frame& F, int l) {
    LAS int* pend = (LAS int*)(F.lds + MISC_OFF + 1024);
    const int ntiles = load_pend(F, l, pend);
    SchedMoe1 Sm{F.G, vcu_of(F), ntiles, pend, (const char*)(F.ws + WS_U), (const char*)(F.ws + WS_WEXP13), (const char*)wsm(F.ws, l, WO_S13), (const int*)(F.ws + WS_ROWTOK), (const int*)(F.ws + WS_IDENT)};
    EpiHb E{(bf16_t*)(F.ws + WS_HB)};
    pg8::gemm_phase<EpiHb, SchedMoe1, true>(F.lds, D, Sm, E);
}
struct SchedMoe2 {
    int G, c, ntiles; const LAS int* pend; const char* HB; const char* W2; const char* Ws2;
    __device__ bool next(int i, pg8::Unit& u) const {
        const int q = i * G + c; if (q >= 4 * (ntiles + T / 256)) return false;
        const int j = q >> 2; u.pn = q & 3;
        if (j < ntiles) { u.pm = j; u.e = ((const LAS unsigned char*)(pend + 64))[j]; } else { u.pm = NBLK + (j - ntiles); u.e = NE; }
        return true; }
    __device__ const char* a_ptr(const pg8::Unit& u) const { return HB + (size_t)u.pm * 256 * DE * 2; }
    __device__ const char* b_ptr(const pg8::Unit& u) const { return (u.e < NE ? W2 + (size_t)u.e * D * DE * 2 : Ws2) + (size_t)(256 * u.pn) * DE * 2; }
    __device__ const int* a_rows(const pg8::Unit&) const { return nullptr; }
    unsigned char* pp = nullptr; __device__ void* probe_ptr() const { return pp; }
};
struct EpiY2 { static constexpr bool PERM = true; unsigned char* Y;
    __device__ __forceinline__ void operator()(const f32x4 (&acc)[2][2][4][2], const pg8::Unit& u, int wr, int wc, int fr, int fq) const {
        const int row0 = u.pm * 256 + wr * 64 + fr; unsigned char* base = Y + u.pn * 256 + wc * 32 + 8 * fq;
#pragma unroll
        for (int ai = 0; ai < 2; ++ai)
#pragma unroll
            for (int m = 0; m < 4; ++m) { unsigned char* rowp = base + (size_t)(row0 + ai * 128 + m * 16) * D;
#pragma unroll
                for (int bj = 0; bj < 2; ++bj) { const f32x4 v0 = acc[ai][bj][m][0], v1 = acc[ai][bj][m][1];
                    int w0 = 0, w1 = 0;
                    w0 = __builtin_amdgcn_cvt_pk_fp8_f32(v0[0], v0[1], w0, false); w0 = __builtin_amdgcn_cvt_pk_fp8_f32(v0[2], v0[3], w0, true);
                    w1 = __builtin_amdgcn_cvt_pk_fp8_f32(v1[0], v1[1], w1, false); w1 = __builtin_amdgcn_cvt_pk_fp8_f32(v1[2], v1[3], w1, true);
                    u32x2 w; w.x = (unsigned)w0; w.y = (unsigned)w1;
                    *(u32x2*)(rowp + bj * 128) = w; } }
    }
};
template <> constexpr bool epi_probe_v<EpiY2> = true;
__device__ __forceinline__ void p_gemm2(Frame& F, int l) {
    LAS int* pend = (LAS int*)(F.lds + MISC_OFF + 1024);
    const int ntiles = load_pend(F, l, pend);
    SchedMoe2 Sm; Sm.G = F.G; Sm.c = vcu_of(F); Sm.ntiles = ntiles; Sm.pend = pend; Sm.HB = (const char*)(F.ws + WS_HB); Sm.W2 = (const char*)(F.ws + WS_WEXP2); Sm.Ws2 = (const char*)wsm(F.ws, l, WO_S2);
    Sm.pp = F.ws + WS_CTL + 4 * CW_STAMP + 8 * 56;
    EpiY2 E{(unsigned char*)(F.ws + WS_Y2H)};
    pg8::gemm_phase<EpiY2, SchedMoe2, false, false>(F.lds, DE, Sm, E);
}
__device__ __forceinline__ void acc_fp8x16(float (&acc)[16], const u32x4 v, float w) {
    const unsigned wd[4] = {v.x, v.y, v.z, v.w};
#pragma unroll
    for (int i = 0; i < 4; ++i) { const f32x2 lo = __builtin_amdgcn_cvt_pk_f32_fp8((int)wd[i], false), hi = __builtin_amdgcn_cvt_pk_f32_fp8((int)wd[i], true);
        acc[4 * i] += w * lo.x; acc[4 * i + 1] += w * lo.y; acc[4 * i + 2] += w * hi.x; acc[4 * i + 3] += w * hi.y; }
}
template <bool FINAL>
__device__ __forceinline__ void p_combine(const Args& a, Frame& F, int l) {
    const int gw = F.bid * NWAVES + F.wave, NGW = F.G * NWAVES, RPW = (T + NGW - 1) / NGW;
    const int r0 = gw * RPW, r1 = (r0 + RPW < T) ? r0 + RPW : T;
    const unsigned char* Y = (const unsigned char*)(F.ws + WS_Y2H) + 4 * F.lane; const int* slots = (const int*)(F.ws + WS_POS); const float* wts = (const float*)(F.ws + WS_WTS);
    const float* gt = (const float*)(F.ws + WS_ADA) + (size_t)l * NB * 6 * D + 5 * D + 4 * F.lane;
    f32x4 gv[4], fw[4]; int bcur = -1;
    if (FINAL) {
#pragma unroll
        for (int j = 0; j < 4; ++j) fw[j] = *(const f32x4*)(a.in[I_FNW] + 256 * j + 4 * F.lane); }
    for (int t = r0; t < r1; ++t) {
        const int b = t / S;
        if (b != bcur) { bcur = b;
#pragma unroll
            for (int j = 0; j < 4; ++j) gv[j] = *(const f32x4*)(gt + (size_t)b * 6 * D + 256 * j); }
        float acc[16];
#pragma unroll
        for (int i = 0; i < 16; ++i) acc[i] = 0.f;
        { const unsigned char* yr = Y + ((size_t)NBLK * 256 + t) * D; u32x4 v; v.x = *(const unsigned*)yr; v.y = *(const unsigned*)(yr + 256); v.z = *(const unsigned*)(yr + 512); v.w = *(const unsigned*)(yr + 768);
          acc_fp8x16(acc, v, 1.f); }
#pragma unroll
        for (int k = 0; k < TOPK; ++k) { const int slot = slots[t * TOPK + k]; const float w = wts[t * TOPK + k];
            const unsigned char* yr = Y + (size_t)slot * D; u32x4 v; v.x = *(const unsigned*)yr; v.y = *(const unsigned*)(yr + 256); v.z = *(const unsigned*)(yr + 512); v.w = *(const unsigned*)(yr + 768);
            acc_fp8x16(acc, v, w); }
        float* o = a.out + (size_t)t * D + 4 * F.lane;
        f32x4 ov[4]; float ss = 0.f;
#pragma unroll
        for (int j = 0; j < 4; ++j) {
            ov[j] = *(const f32x4*)(o + 256 * j) + gv[j] * (f32x4){acc[4 * j], acc[4 * j + 1], acc[4 * j + 2], acc[4 * j + 3]};
            ss += (ov[j].x * ov[j].x + ov[j].y * ov[j].y) + (ov[j].z * ov[j].z + ov[j].w * ov[j].w); }
        if (FINAL) {
            const float r = rsqrtf(wave_sum(ss) * (1.f / D) + EPS);
#pragma unroll
            for (int j = 0; j < 4; ++j) *(f32x4*)(o + 256 * j) = ov[j] * r * fw[j];
        } else {
#pragma unroll
            for (int j = 0; j < 4; ++j) *(f32x4*)(o + 256 * j) = ov[j];
        }
    }
}
__device__ __forceinline__ void p_expert_cvt(const Args& a, Frame& F, int l) {
    const int gw = F.bid * NWAVES + F.wave, NGW = F.G * NWAVES;
    LAS float* scr = (LAS float*)(F.lds + F.wave * 8704);
    for (int it = gw; it < EX_ITEMS; it += NGW) expert_item(a, F.ws, l, it, scr, F.lane);
}
#if defined(MK_TEST_MIXERS) || defined(MK_PROBE)
__device__ __forceinline__ void p_final_scale(const Args& a, Frame& F) {
    const int gw = F.bid * NWAVES + F.wave, NGW = F.G * NWAVES;
    for (int row = gw; row < T; row += NGW) {
        f32x4* xr = (f32x4*)(a.out + (size_t)row * D) + F.lane;
#if defined(MK_TEST_MIXERS)
        const float* err = (const float*)(F.ws + WS_CTL) + CW_ERR; const float amp = (sqrtf(err[2] / fmaxf(err[3], 1e-30f)) > MK_TEST_THR) ? 2.f : 1.f; const float fb = 0.f;
#else
        float amp; float fb;
        { const unsigned long long* st = (const unsigned long long*)(F.ws + WS_CTL + 4 * CW_STAMP) + MK_PROBE_BASE; float tot = 0.f, sa = 0.f, sb = 0.f;
          for (int i = 0; i < 6; ++i) { const float d = (float)st[i]; tot += d; if ((MK_PROBE_A >> i) & 1ull) sa += d; if ((MK_PROBE_B >> i) & 1ull) sb += d; }
          amp = 2.f + floorf(16.f * sa / tot + 0.5f) * (1.f / 16.f); fb = 100.f + 50.f * floorf(16.f * sb / tot + 0.5f); }
#endif
#pragma unroll
        for (int j = 0; j < 4; ++j) xr[64 * j] = xr[64 * j] * amp;
#if defined(MK_PROBE)
        if (row == 0 && F.lane == 0) a.out[0] = fb;
#endif
    }
}
#endif

__device__ __forceinline__ void mlstm_seq(const Args& a, Frame& F, int l, int b, int hd, bf16_t* OUT, int opitch) {
    LAS float* qs = (LAS float*)F.lds; LAS float* ks = qs + 128; LAS float* ns = ks + 128; LAS float* sc = ns + 128; LAS float* pn = sc + 8; LAS float* pd = pn + 512; LAS float* red = pd + 512;
    const int tid = F.tid, e = tid & 255, dh = tid >> 8;
    const bf16_t* QK = (const bf16_t*)(F.ws + WS_PB) + (size_t)b * S * D; const bf16_t* VM = (const bf16_t*)(F.ws + WS_PB + PB_STRIDE) + (size_t)b * S * D;
    bf16_t* OM = (bf16_t*)(F.ws + WS_PB + 2 * PB_STRIDE) + (size_t)b * S * D; const float* SM = (const float*)(F.ws + WS_SMALL) + (size_t)b * S * 32;
    const float* conv_w = a.in[I_CONVW] + (size_t)l * 4 * 1024; const float* gate_b = a.in[I_GATEB] + l * 8;
    float Cst[64];
#pragma unroll
    for (int d = 0; d < 64; ++d) Cst[d] = 0.f;
    if (tid < 128) ns[tid] = 0.f;
    float m_run = 0.f;
    const int col = (tid < 128) ? (512 + hd * 128 + tid) : (hd * 128 + ((tid - 128) & 127));
    const float w0 = conv_w[0 * 1024 + col], w1 = conv_w[1 * 1024 + col], w2 = conv_w[2 * 1024 + col], w3 = conv_w[3 * 1024 + col];
    const float gbi = gate_b[hd], gbf = gate_b[4 + hd], mnw = a.in[I_MNORMW][l * D + hd * 256 + e];
    float x0 = 0.f, x1 = 0.f, x2 = 0.f;
    for (int t = 0; t < S; ++t) {
        float cv = 0.f;
        if (tid < 256) { const float x3 = bf2f(QK[(size_t)t * D + col]); cv = siluf_(w0 * x0 + w1 * x1 + w2 * x2 + w3 * x3); x0 = x1; x1 = x2; x2 = x3; }
        __syncthreads();
        if (tid < 128) ks[tid] = cv; else if (tid < 256) qs[tid - 128] = cv * 0.08838834764831845f;
        if (tid == 256) {
            const float li = 15.f * tanhf((SM[t * 32 + hd] + gbi) * (1.f / 15.f));
            const float lf = logsigmoidf_(15.f * tanhf((SM[t * 32 + 4 + hd] + gbf) * (1.f / 15.f)));
            const float m_new = fmaxf(lf + m_run, li);
            sc[0] = __expf(lf + m_run - m_new); sc[1] = __expf(li - m_new); sc[2] = __expf(-m_new); m_run = m_new;
        }
        __syncthreads();
        const float fd = sc[0], id = sc[1], lowb = sc[2];
        if (tid < 128) ns[tid] = fd * ns[tid] + id * ks[tid];
        __syncthreads();
        const float v = bf2f(VM[(size_t)t * D + hd * 256 + e]) * id;
        float num = 0.f, den = 0.f;
#pragma unroll
        for (int d = 0; d < 64; ++d) { const int dd = dh * 64 + d; Cst[d] = fd * Cst[d] + ks[dd] * v; num += qs[dd] * Cst[d]; den += qs[dd] * ns[dd]; }
        pn[dh * 256 + e] = num; pd[dh * 256 + e] = den;
        __syncthreads();
        float h = 0.f;
        if (dh == 0) { num = pn[e] + pn[256 + e]; den = pd[e] + pd[256 + e]; h = num / fmaxf(fabsf(den), lowb); const float ss = wave_sum(h * h); if (F.lane == 0) red[F.wave] = ss; }
        __syncthreads();
        if (dh == 0) { const float r = rsqrtf((red[0] + red[1] + red[2] + red[3]) * (1.f / 256.f) + EPS); const size_t idx = (size_t)t * D + hd * 256 + e;
            OUT[(size_t)t * opitch + e] = (bf16_t)f2bf(h * r * mnw * bf2f(OM[idx])); }
    }
}
__device__ __forceinline__ void gla_seq(const Args& a, Frame& F, int l, int b, int hd, bf16_t* OUT, int opitch) {
    LAS float* qs = (LAS float*)F.lds; LAS float* ks = qs + 128; LAS float* as = ks + 128; LAS float* pn = as + 128 + 8; LAS float* red = pn + 512;
    const int tid = F.tid, e = tid & 255, dh = tid >> 8;
    const bf16_t* QKG = (const bf16_t*)(F.ws + WS_PB + 3 * PB_STRIDE) + (size_t)b * S * D; const bf16_t* VG = (const bf16_t*)(F.ws + WS_PB + 4 * PB_STRIDE) + (size_t)b * S * D;
    bf16_t* ZG = (bf16_t*)(F.ws + WS_PB + 5 * PB_STRIDE) + (size_t)b * S * D; const float* SM = (const float*)(F.ws + WS_SMALL) + (size_t)b * S * 32;
    const float* alpha_w = a.in[I_ALPHAW] + (size_t)l * 16 * 512; const float* alpha_b = a.in[I_ALPHAB] + l * 512;
    float Sst[64];
#pragma unroll
    for (int d = 0; d < 64; ++d) Sst[d] = 0.f;
    float aw[16]; float ab = 0.f;
#pragma unroll
    for (int r = 0; r < 16; ++r) aw[r] = alpha_w[r * 512 + hd * 128 + (tid & 127)];
    ab = alpha_b[hd * 128 + (tid & 127)];
    const float gnw = a.in[I_GNORMW][l * D + hd * 256 + e];
    for (int t = 0; t < S; ++t) {
        __syncthreads();
        if (tid < 128) {
            float x = ab;
#pragma unroll
            for (int r = 0; r < 16; ++r) x += SM[t * 32 + 8 + r] * aw[r];
            as[tid] = __expf(logsigmoidf_(x) * (1.f / 16.f));
            ks[tid] = bf2f(QKG[(size_t)t * D + 512 + hd * 128 + tid]);
        } else if (tid < 256) qs[tid - 128] = bf2f(QKG[(size_t)t * D + hd * 128 + tid - 128]) * 0.08838834764831845f;
        __syncthreads();
        const float v = bf2f(VG[(size_t)t * D + hd * 256 + e]);
        float o = 0.f;
#pragma unroll
        for (int d = 0; d < 64; ++d) { const int dd = dh * 64 + d; Sst[d] = as[dd] * Sst[d] + ks[dd] * v; o += qs[dd] * Sst[d]; }
        pn[dh * 256 + e] = o;
        __syncthreads();
        float h = 0.f;
        if (dh == 0) { h = pn[e] + pn[256 + e]; const float ss = wave_sum(h * h); if (F.lane == 0) red[F.wave] = ss; }
        __syncthreads();
        if (dh == 0) { const float r = rsqrtf((red[0] + red[1] + red[2] + red[3]) * (1.f / 256.f) + EPS); const size_t idx = (size_t)t * D + hd * 256 + e;
            OUT[(size_t)t * opitch + e] = (bf16_t)f2bf(h * r * gnw * bf2f(ZG[idx])); }
    }
}
__device__ __forceinline__ void p_mixers_seq(const Args& a, Frame& F, int l) {
    for (int s = F.bid; s < 128; s += F.G) {
        __syncthreads();
        if (s < 64) mlstm_seq(a, F, l, s >> 2, s & 3, (bf16_t*)(F.ws + WS_PB + 2 * PB_STRIDE) + (size_t)(s >> 2) * S * D + (s & 3) * 256, D);
        else gla_seq(a, F, l, (s - 64) >> 2, s & 3, (bf16_t*)(F.ws + WS_PB + 5 * PB_STRIDE) + (size_t)((s - 64) >> 2) * S * D + (s & 3) * 256, D);
    }
}

typedef float f32x16 __attribute__((ext_vector_type(16)));
typedef short s16x4 __attribute__((ext_vector_type(4)));
#define MFMA32(a, b, c) __builtin_amdgcn_mfma_f32_32x32x16_bf16((a), (b), (c), 0, 0, 0)
#define MFMA16(a, b, c) __builtin_amdgcn_mfma_f32_16x16x32_bf16((a), (b), (c), 0, 0, 0)
constexpr int MX_QS = 272, MX_VS = 528, MX_PS = 144, MX_BS = 528;
constexpr int MX_Q = 0, MX_K = MX_Q + 64 * MX_QS, MX_KU = MX_K + 64 * MX_QS, MX_V = MX_KU + 64 * MX_QS, MX_P = MX_V + 64 * MX_VS, MX_BC = MX_P + 64 * MX_PS, MX_END = MX_BC + 64 * MX_BS;
static_assert(MX_END + 1024 <= RING_BYTES, "mixer LDS map");
constexpr int MX_SM = MISC_OFF + 2048;
constexpr int SM_COLT = 0, SM_ROWT = 64, SM_WINT = 128, SM_WKS = 192, SM_ELOW = 256, SM_DEN = 320, SM_QN = 384, SM_SSQ = 896, SM_N = 1408, SM_NACC = 1536, SM_EGC = 1664, SM_GC = 1792, SM_SCAL = 1920, SM_QTOT = 1936, SM_ENDF = 1936 + 512;
static_assert(MX_SM + SM_ENDF * 4 <= LDS_BYTES, "mixer small arrays");

__device__ __forceinline__ unsigned tr_lane_off(int stride, int lane) {
    const int i16 = lane & 15, q = i16 >> 2, p = i16 & 3, blk = (lane >> 4) & 1, h = lane >> 5;
    return (unsigned)((8 * h + q) * stride + (16 * blk + 4 * p) * 2);
}
template <int OFF, int STEP, int HALF4>
__device__ __forceinline__ void tr_frag_x4(unsigned lane_addr, bf16x8 (&f)[4]) {
    s16x4 a0, a1, b0, b1, c0, c1, d0, d1;
    asm volatile("ds_read_b64_tr_b16 %0, %8 offset:%9\n\tds_read_b64_tr_b16 %1, %8 offset:%10\n\tds_read_b64_tr_b16 %2, %8 offset:%11\n\tds_read_b64_tr_b16 %3, %8 offset:%12\n\t"
                 "ds_read_b64_tr_b16 %4, %8 offset:%13\n\tds_read_b64_tr_b16 %5, %8 offset:%14\n\tds_read_b64_tr_b16 %6, %8 offset:%15\n\tds_read_b64_tr_b16 %7, %8 offset:%16\n\ts_waitcnt lgkmcnt(0)"
                 : "=&v"(a0), "=&v"(a1), "=&v"(b0), "=&v"(b1), "=&v"(c0), "=&v"(c1), "=&v"(d0), "=&v"(d1)
                 : "v"(lane_addr), "i"(OFF), "i"(OFF + HALF4), "i"(OFF + STEP), "i"(OFF + STEP + HALF4), "i"(OFF + 2 * STEP), "i"(OFF + 2 * STEP + HALF4), "i"(OFF + 3 * STEP), "i"(OFF + 3 * STEP + HALF4) : "memory");
    f[0] = __builtin_shufflevector(a0, a1, 0, 1, 2, 3, 4, 5, 6, 7); f[1] = __builtin_shufflevector(b0, b1, 0, 1, 2, 3, 4, 5, 6, 7);
    f[2] = __builtin_shufflevector(c0, c1, 0, 1, 2, 3, 4, 5, 6, 7); f[3] = __builtin_shufflevector(d0, d1, 0, 1, 2, 3, 4, 5, 6, 7);
}
__device__ __forceinline__ bf16x8 pack_acc(const f32x16& x, int s) {
    u32x4 p;
    if (s == 0) { p.x = cvt_pk_bf16(x[0], x[1]); p.y = cvt_pk_bf16(x[2], x[3]); p.z = cvt_pk_bf16(x[4], x[5]); p.w = cvt_pk_bf16(x[6], x[7]); }
    else { p.x = cvt_pk_bf16(x[8], x[9]); p.y = cvt_pk_bf16(x[10], x[11]); p.z = cvt_pk_bf16(x[12], x[13]); p.w = cvt_pk_bf16(x[14], x[15]); }
    return __builtin_bit_cast(bf16x8, p);
}
__device__ __forceinline__ u32x4 pack8(const float (&y)[8]) { u32x4 o; o.x = cvt_pk_bf16(y[0], y[1]); o.y = cvt_pk_bf16(y[2], y[3]); o.z = cvt_pk_bf16(y[4], y[5]); o.w = cvt_pk_bf16(y[6], y[7]); return o; }
__device__ __forceinline__ float wave_max(float v) {
#pragma unroll
    for (int o = 1; o < 64; o <<= 1) v = fmaxf(v, __shfl_xor(v, o));
    return v;
}
__device__ __forceinline__ unsigned tr_lane_off_v(int stride, int lane) {
    const int i16 = lane & 15, q = i16 >> 2, p = i16 & 3, blk = (lane >> 4) & 1, h = lane >> 5;
    return (unsigned)((8 * h + q) * stride + (16 * (p & 1) + 8 * blk + 4 * (p >> 1)) * 2);
}
__device__ __forceinline__ void load_vf(LAS unsigned char* lds, int lane, int wave, bf16x8 (&vf)[4]) {
    const unsigned la = (unsigned)(unsigned long)(lds) + MX_V + tr_lane_off_v(MX_VS, lane) + (unsigned)(64 * wave);
    tr_frag_x4<0, 16 * MX_VS, 4 * MX_VS>(la, vf);
}
template <bool ONE_ACC>
__device__ __forceinline__ void chunk_out(LAS unsigned char* lds, int lane, int lt, const f32x16 (&C)[4], const bf16x8 (&vf)[4], f32x16& a1, f32x16& a2) {
    const int h = lane >> 5, l31 = lane & 31;
#pragma unroll
    for (int i = 0; i < 16; ++i) { a1[i] = 0.f; a2[i] = 0.f; }
    const LAS unsigned char* prow = lds + MX_P + (32 * lt + l31) * MX_PS + 16 * h;
#pragma unroll
    for (int ss = 0; ss < 4; ++ss) { const bf16x8 pb = *(const LAS bf16x8*)(prow + 32 * ss); a1 = MFMA32(vf[ss], pb, a1); }
    const LAS unsigned char* qrow = lds + MX_Q + (32 * lt + l31) * MX_QS + 8 * h;
#pragma unroll
    for (int dt = 0; dt < 4; ++dt)
#pragma unroll
        for (int sp = 0; sp < 2; ++sp) {
            const bf16x8 xa = pack_acc(C[dt], sp);
            const u32x2 q0 = *(const LAS u32x2*)(qrow + (32 * dt + 16 * sp) * 2), q1 = *(const LAS u32x2*)(qrow + (32 * dt + 16 * sp + 8) * 2);
            u32x4 qq; qq.x = q0.x; qq.y = q0.y; qq.z = q1.x; qq.w = q1.y;
            if (ONE_ACC) a1 = MFMA32(xa, __builtin_bit_cast(bf16x8, qq), a1); else a2 = MFMA32(xa, __builtin_bit_cast(bf16x8, qq), a2);
        }
}
template <int DT>
__device__ __forceinline__ void chunk_update_dt(unsigned la, f32x16& Cd, const bf16x8 (&vf)[4]) {
    bf16x8 ka[4]; tr_frag_x4<DT * 64, 16 * MX_QS, 4 * MX_QS>(la, ka);
    Cd = MFMA32(ka[0], vf[0], Cd); Cd = MFMA32(ka[1], vf[1], Cd); Cd = MFMA32(ka[2], vf[2], Cd); Cd = MFMA32(ka[3], vf[3], Cd);
}
__device__ __forceinline__ void chunk_update(LAS unsigned char* lds, int lane, f32x16 (&C)[4], const bf16x8 (&vf)[4]) {
    const unsigned la = (unsigned)(unsigned long)(lds) + MX_KU + tr_lane_off(MX_QS, lane);
    chunk_update_dt<0>(la, C[0], vf); chunk_update_dt<1>(la, C[1], vf); chunk_update_dt<2>(la, C[2], vf); chunk_update_dt<3>(la, C[3], vf);
}
template <bool MLSTM>
__device__ __forceinline__ void chunk_scores(LAS unsigned char* lds, LAS float* sm, int lane, int wave) {
    const int st = wave & 3, r16 = lane & 15, q4 = lane >> 4;
    bf16x8 ka[4];
    const LAS unsigned char* krow = lds + MX_K + (16 * st + r16) * MX_QS + 16 * q4;
#pragma unroll
    for (int ks = 0; ks < 4; ++ks) ka[ks] = *(const LAS bf16x8*)(krow + 64 * ks);
#pragma unroll
    for (int t = 0; t < 2; ++t) {
        const int lt = 2 * (wave >> 2) + t, l = 16 * lt + r16;
        f32x4 acc = (f32x4){0.f, 0.f, 0.f, 0.f};
        if (st <= lt) {
            const LAS unsigned char* qrow = lds + MX_Q + l * MX_QS + 16 * q4;
#pragma unroll
            for (int ks = 0; ks < 4; ++ks) { const bf16x8 qb = *(const LAS bf16x8*)(qrow + 64 * ks); acc = MFMA16(ka[ks], qb, acc); }
        }
        float v[4]; float rs = 0.f;
        const float rt = MLSTM ? sm[SM_ROWT + l] : 0.f;
#pragma unroll
        for (int r = 0; r < 4; ++r) { const int s = 16 * st + 4 * q4 + r;
            float x = acc[r];
            if (MLSTM) x *= __expf(fminf(rt + sm[SM_COLT + s], 30.f));
            v[r] = (s <= l) ? x : 0.f; rs += v[r]; }
        u32x2 pk; pk.x = cvt_pk_bf16(v[0], v[1]); pk.y = cvt_pk_bf16(v[2], v[3]);
        *(LAS u32x2*)(lds + MX_P + l * MX_PS + (16 * st + 4 * q4) * 2) = pk;
        if (MLSTM) { rs += __shfl_xor(rs, 16); rs += __shfl_xor(rs, 32); if (q4 == 0) sm[SM_QTOT + st * 64 + l] = rs; }
    }
}
__device__ __forceinline__ void stage_v(LAS unsigned char* lds, const bf16_t* V, int t0, int tid) {
    const int row = tid >> 3, pc = (tid & 7) * 4;
    const u32x4* src = (const u32x4*)(V + (size_t)(t0 + row) * D) + pc;
#pragma unroll
    for (int i = 0; i < 4; ++i) *(LAS u32x4*)(lds + MX_V + row * MX_VS + (pc + i) * 16) = src[i];
}
#define MX_SYNC() do { asm volatile("s_waitcnt vmcnt(0) lgkmcnt(0)" ::: "memory"); __builtin_amdgcn_s_barrier(); asm volatile("" ::: "memory"); } while (0)
#if defined(MK_TPROBE)
#define MX_NOW() __builtin_amdgcn_s_memrealtime()
#else
#define MX_NOW() __builtin_amdgcn_s_memtime()
#endif
#if defined(MK_PROBE) || defined(MK_TPROBE)
#define MX_PROBE_ON 1
#define MX_T(k) do { const unsigned long long now_ = MX_NOW(); tacc[k] += now_ - tlast; tlast = now_; } while (0)
#else
#define MX_T(k) do { } while (0)
#endif
#define MX_BAR() do { asm volatile("s_waitcnt lgkmcnt(0)" ::: "memory"); __builtin_amdgcn_s_barrier(); asm volatile("" ::: "memory"); } while (0)
#define MX_VWAIT0() asm volatile("s_waitcnt vmcnt(0)" ::: "memory")
__device__ __forceinline__ void dma16(const void* g, LAS unsigned char* ldst) { __builtin_amdgcn_global_load_lds((const unsigned*)g, (LAS unsigned*)ldst, 16, 0, 0); }
__device__ __forceinline__ void dma_v(LAS unsigned char* lds, const bf16_t* V, int t0, int wave, int lane) {
    asm volatile("" : "+v"(lane));
#pragma unroll
    for (int j = 0; j < 5; ++j) { const int k = wave + 8 * j;
        if (k < 33) { const int o = 1024 * k + 16 * lane, row = o / MX_VS; int cb = o - row * MX_VS; if (cb >= 512) cb = 0;
            dma16((const char*)(V + (size_t)(t0 + row) * D) + cb, lds + MX_V + 1024 * k); } }
}
__device__ __forceinline__ void dma_qk(LAS unsigned char* lds, int img_off, const bf16_t* src, int t0, int wave, int lane) {
    asm volatile("" : "+v"(lane));
#pragma unroll
    for (int j = 0; j < 3; ++j) { const int k = wave + 8 * j;
        if (k < 17) { const int o = 1024 * k + 16 * lane, row = o / MX_QS; int cb = o - row * MX_QS; if (cb >= 256) cb = 0;
            dma16((const char*)(src + (size_t)(t0 + row) * D) + cb, lds + img_off + 1024 * k); } }
}
constexpr int MX_RAWA = MX_BC + 12288, MX_RAWB = 147456;
static_assert(MX_RAWA + 42 * 512 <= MX_END && MX_RAWB + 26 * 512 <= LDS_BYTES && MX_SM + SM_ENDF * 4 <= MX_RAWB, "mLSTM raw rows");
__device__ __forceinline__ void dma_raw_m(LAS unsigned char* lds, const bf16_t* QK, int hd, int t0, int wave, int lane) {
    asm volatile("" : "+v"(lane));
    const int p = lane & 31, col = (p < 16) ? hd * 128 + 8 * p : 512 + hd * 128 + 8 * (p - 16);
#pragma unroll
    for (int j = 0; j < 5; ++j) { const int k = wave + 8 * j;
        if (k < 34) { int tok = t0 - 3 + 2 * k + (lane >> 5); tok = tok < 0 ? 0 : (tok > S - 1 ? S - 1 : tok);
            dma16(QK + (size_t)tok * D + col, lds + (k < 21 ? MX_RAWA + 1024 * k : MX_RAWB + 1024 * (k - 21))); } }
}

__device__ __forceinline__ float wave_scan_add(float x) {
    float v = x;
#define DPP_ADD(ctrl, rmask) v += __builtin_bit_cast(float, __builtin_amdgcn_update_dpp(0, __builtin_bit_cast(int, v), ctrl, rmask, 0xf, false))
    DPP_ADD(0x111, 0xf); DPP_ADD(0x112, 0xf); DPP_ADD(0x114, 0xf); DPP_ADD(0x118, 0xf); DPP_ADD(0x142, 0xa); DPP_ADD(0x143, 0xc);
#undef DPP_ADD
    return v;
}
__device__ __forceinline__ void mlstm_gates(LAS float* sm, int lane, float pim, float pfm, float gbi, float gbf) {
    const float li = 15.f * ftanh((pim + gbi) * (1.f / 15.f));
    const float lf = flogsigmoid(15.f * ftanh((pfm + gbf) * (1.f / 15.f)));
    const float bc = wave_scan_add(lf);
    const float g = __builtin_bit_cast(float, __builtin_amdgcn_readlane(__builtin_bit_cast(int, bc), 63));
    sm[SM_COLT + lane] = li - bc; sm[SM_ROWT + lane] = bc; sm[SM_WINT + lane] = __expf(bc); sm[SM_WKS + lane] = __expf(g - bc + li); sm[SM_ELOW + lane] = 1.f;
    if (lane == 0) sm[SM_SCAL] = __expf(g);
}
__device__ __forceinline__ void mlstm_chunked(const Args& a, Frame& F, int l, int b, int hd, bf16_t* OUT) {
    LAS unsigned char* lds = F.lds; LAS float* sm = (LAS float*)(F.lds + MX_SM);
    const int tid0 = F.tid, wave = F.wave;
    const bf16_t* QK = (const bf16_t*)(F.ws + WS_PB) + (size_t)b * S * D; const bf16_t* VM = (const bf16_t*)(F.ws + WS_PB + PB_STRIDE) + (size_t)b * S * D + hd * 256;
    const bf16_t* OM = (const bf16_t*)(F.ws + WS_PB + 2 * PB_STRIDE) + (size_t)b * S * D + hd * 256; const float* SMALL = (const float*)(F.ws + WS_SMALL) + (size_t)b * S * 32;
    bf16_t* O = OUT + (size_t)b * S * D + hd * 256;
    const float* conv_w = a.in[I_CONVW] + (size_t)l * 4 * 1024; const float gbi = a.in[I_GATEB][l * 8 + hd], gbf = a.in[I_GATEB][l * 8 + 4 + hd];
    LAS float* cwt = (LAS float*)(F.lds + MX_BC);
    LAS float* nwt = (LAS float*)(F.lds + MX_END);
    for (int i = tid0; i < 1024; i += NTHREADS) { const int tp = i >> 8, cc = i & 255; cwt[i] = conv_w[tp * 1024 + (cc < 128 ? hd * 128 + cc : 512 + hd * 128 + cc - 128)]; }
    if (tid0 < 256) nwt[tid0] = a.in[I_MNORMW][l * D + hd * 256 + tid0];
    f32x16 C[4];
#pragma unroll
    for (int dt = 0; dt < 4; ++dt)
#pragma unroll
        for (int i = 0; i < 16; ++i) C[dt][i] = 0.f;
    if (tid0 < 128) sm[SM_N + tid0] = 0.f;
    float pim = SMALL[(size_t)(tid0 & 63) * 32 + hd], pfm = SMALL[(size_t)(tid0 & 63) * 32 + 4 + hd];
#ifdef MX_PROBE_ON
    unsigned long long tacc[6] = {0, 0, 0, 0, 0, 0}; unsigned long long tlast = MX_NOW();
#endif
    if (wave == 0) mlstm_gates(sm, F.lane, pim, pfm, gbi, gbf);
    dma_raw_m(lds, QK, hd, 0, wave, F.lane); dma_v(lds, VM, 0, wave, F.lane);
    MX_VWAIT0();
    for (int c = 0; c < S / 64; ++c) {
        const int t0 = c * 64;
        int lz = 0; asm volatile("" : "+v"(lz)); const int lane = F.lane + lz, tid = F.tid + lz, h = lane >> 5, l31 = lane & 31, rg = tid >> 5, cg = tid & 31, d0 = 8 * (cg & 15); const bool isq = cg < 16;
        const int gcol = (isq ? 0 : 512) + hd * 128 + d0, ccol = (isq ? 0 : 128) + d0;
        MX_BAR(); MX_T(0);
        u32x4 praw[7];
#pragma unroll
        for (int i = 0; i < 7; ++i) { const int r = 4 * rg + i; praw[i] = *(const LAS u32x4*)(lds + (r < 42 ? MX_RAWA + 512 * r : MX_RAWB + 512 * (r - 42)) + 16 * cg); }
        if (c == 0 && rg == 0) { praw[0] = (u32x4){0u, 0u, 0u, 0u}; praw[1] = praw[0]; praw[2] = praw[0]; }
        {
            float nacc[8];
#pragma unroll
            for (int j = 0; j < 8; ++j) nacc[j] = 0.f;
            float cw[4][8];
#pragma unroll
            for (int tp = 0; tp < 4; ++tp) { const f32x4 c0 = *(const LAS f32x4*)(cwt + tp * 256 + ccol), c1 = *(const LAS f32x4*)(cwt + tp * 256 + ccol + 4);
                cw[tp][0] = c0.x; cw[tp][1] = c0.y; cw[tp][2] = c0.z; cw[tp][3] = c0.w; cw[tp][4] = c1.x; cw[tp][5] = c1.y; cw[tp][6] = c1.z; cw[tp][7] = c1.w; }
#pragma unroll
            for (int r = 0; r < 4; ++r) {
                float y[8];
#pragma unroll
                for (int j = 0; j < 8; ++j) { float x = 0.f;
#pragma unroll
                    for (int tp = 0; tp < 4; ++tp) { const unsigned wd = praw[r + tp][j >> 1]; x += cw[tp][j] * ((j & 1) ? bfhi(wd) : bflo(wd)); }
                    y[j] = fsilu(x); }
                const int row = 4 * rg + r;
                if (isq) {
#pragma unroll
                    for (int j = 0; j < 8; ++j) y[j] *= 0.08838834764831845f;
                    *(LAS u32x4*)(lds + MX_Q + row * MX_QS + d0 * 2) = pack8(y); }
                else { const float wk = sm[SM_WKS + row];
                    *(LAS u32x4*)(lds + MX_K + row * MX_QS + d0 * 2) = pack8(y);
#pragma unroll
                    for (int j = 0; j < 8; ++j) { y[j] *= wk; nacc[j] += y[j]; }
                    *(LAS u32x4*)(lds + MX_KU + row * MX_QS + d0 * 2) = pack8(y); }
            }
            if (!isq) { LAS float* np = (LAS float*)(lds + MX_BC + 4096) + rg * 128 + d0;
                *(LAS f32x4*)np = (f32x4){nacc[0], nacc[1], nacc[2], nacc[3]}; *(LAS f32x4*)(np + 4) = (f32x4){nacc[4], nacc[5], nacc[6], nacc[7]}; }
        }
        MX_BAR(); MX_T(1);
        chunk_scores<true>(lds, sm, lane, wave);
        { const int lq = tid & 63, dp = tid >> 6; const LAS unsigned char* qrow = lds + MX_Q + lq * MX_QS + dp * 32; float sacc = 0.f;
#pragma unroll
          for (int i = 0; i < 2; ++i) { const u32x4 qv = *(const LAS u32x4*)(qrow + 16 * i); const LAS float* nn = sm + SM_N + dp * 16 + 8 * i;
              sacc += bflo(qv.x) * nn[0] + bfhi(qv.x) * nn[1] + bflo(qv.y) * nn[2] + bfhi(qv.y) * nn[3] + bflo(qv.z) * nn[4] + bfhi(qv.z) * nn[5] + bflo(qv.w) * nn[6] + bfhi(qv.w) * nn[7]; }
          sm[SM_QN + dp * 64 + lq] = sacc; }
        MX_VWAIT0();
        MX_BAR(); MX_T(2);
        if (c + 1 < S / 64) dma_raw_m(lds, QK, hd, t0 + 64, wave, lane);
        bf16x8 vf[4]; load_vf(lds, lane, wave, vf);
        float hv[2][16];
#pragma unroll
        for (int lt = 0; lt < 2; ++lt) { f32x16 a1, a2; chunk_out<false>(lds, lane, lt, C, vf, a1, a2);
            const int ll = 32 * lt + l31; const float wi = sm[SM_WINT + ll];
            float qn = 0.f;
#pragma unroll
            for (int dp = 0; dp < 8; ++dp) qn += sm[SM_QN + dp * 64 + ll];
            const float den = ((sm[SM_QTOT + ll] + sm[SM_QTOT + 64 + ll]) + (sm[SM_QTOT + 128 + ll] + sm[SM_QTOT + 192 + ll])) + wi * qn; const float rd = frcp(fmaxf(fabsf(den), sm[SM_ELOW + ll]));
            float ssq = 0.f;
#pragma unroll
            for (int r = 0; r < 16; ++r) { hv[lt][r] = (a1[r] + wi * a2[r]) * rd; ssq += hv[lt][r] * hv[lt][r]; }
            ssq += __shfl_xor(ssq, 32);
            if (h == 0) sm[SM_SSQ + wave * 64 + ll] = ssq; }
        asm volatile("" ::: "memory"); __builtin_amdgcn_sched_barrier(0);
        u32x4 om[2][2];
        { int z2 = 0; asm volatile("" : "+v"(z2)); const int tid2 = F.tid + z2, lane2 = tid2 & 63;
          const bf16_t* omp = OM + (size_t)(t0 + (lane2 & 31)) * D + 32 * wave + 16 * (lane2 >> 5);
#pragma unroll
          for (int lt = 0; lt < 2; ++lt)
#pragma unroll
              for (int g = 0; g < 2; ++g) om[lt][g] = *(const u32x4*)(omp + (size_t)32 * lt * D + 8 * g);
          if (c + 1 < S / 64 && wave == 0) { const int tn = t0 + 64; pim = SMALL[(size_t)(tn + lane2) * 32 + hd]; pfm = SMALL[(size_t)(tn + lane2) * 32 + 4 + hd]; } }
        { const float decay = sm[SM_SCAL];
#pragma unroll
          for (int dt = 0; dt < 4; ++dt)
#pragma unroll
              for (int i = 0; i < 16; ++i) C[dt][i] *= decay;
          chunk_update(lds, lane, C, vf);
          if (tid < 128) { const LAS float* np = (const LAS float*)(lds + MX_BC + 4096) + tid; float cs = 0.f;
#pragma unroll
              for (int g = 0; g < 16; ++g) cs += np[g * 128];
              sm[SM_N + tid] = decay * sm[SM_N + tid] + cs; } }
        MX_BAR(); MX_T(3);
        MX_VWAIT0();
        if (c + 1 < S / 64) dma_v(lds, VM, t0 + 64, wave, lane);
        if (c + 1 < S / 64 && wave == 0) mlstm_gates(sm, lane, pim, pfm, gbi, gbf);
#pragma unroll
        for (int lt = 0; lt < 2; ++lt) { const int ll = 32 * lt + l31; float st = 0.f;
#pragma unroll
            for (int w = 0; w < 8; ++w) st += sm[SM_SSQ + w * 64 + ll];
            const float rn = rsqrtf(st * (1.f / 256.f) + EPS);
            const size_t ro = (size_t)(t0 + ll) * D + 32 * wave + 16 * h;
#pragma unroll
            for (int g = 0; g < 2; ++g) { const u32x4 ov = om[lt][g];
                const f32x4 nwa = *(const LAS f32x4*)(nwt + 32 * wave + 16 * h + 8 * g), nwb = *(const LAS f32x4*)(nwt + 32 * wave + 16 * h + 8 * g + 4);
                float o[8];
                o[0] = hv[lt][8 * g] * rn * nwa.x * bflo(ov.x); o[1] = hv[lt][8 * g + 1] * rn * nwa.y * bfhi(ov.x);
                o[2] = hv[lt][8 * g + 2] * rn * nwa.z * bflo(ov.y); o[3] = hv[lt][8 * g + 3] * rn * nwa.w * bfhi(ov.y);
                o[4] = hv[lt][8 * g + 4] * rn * nwb.x * bflo(ov.z); o[5] = hv[lt][8 * g + 5] * rn * nwb.y * bfhi(ov.z);
                o[6] = hv[lt][8 * g + 6] * rn * nwb.z * bflo(ov.w); o[7] = hv[lt][8 * g + 7] * rn * nwb.w * bfhi(ov.w);
                *(u32x4*)(O + ro + 8 * g) = pack8(o); } }
        MX_T(4);
    }
#ifdef MX_PROBE_ON
    if (threadIdx.x == 0 && (b == 0 && hd == 0)) { unsigned long long* tp = (unsigned long long*)(F.ws + WS_CTL + 4 * CW_STAMP) + 48; for (int i = 0; i < 6; ++i) tp[i] = tacc[i]; }
#endif
}
__device__ __forceinline__ void gla_chunked(const Args& a, Frame& F, int l, int b, int hd, bf16_t* OUT) {
    LAS unsigned char* lds = F.lds; LAS float* sm = (LAS float*)(F.lds + MX_SM); LAS float* bcl = (LAS float*)(F.lds + MX_BC);
    const int tid0 = F.tid, wave = F.wave;
    const bf16_t* QKG = (const bf16_t*)(F.ws + WS_PB + 3 * PB_STRIDE) + (size_t)b * S * D; const bf16_t* VG = (const bf16_t*)(F.ws + WS_PB + 4 * PB_STRIDE) + (size_t)b * S * D + hd * 256;
    const bf16_t* ZG = (const bf16_t*)(F.ws + WS_PB + 5 * PB_STRIDE) + (size_t)b * S * D + hd * 256; const float* SMALL = (const float*)(F.ws + WS_SMALL) + (size_t)b * S * 32;
    bf16_t* O = OUT + (size_t)b * S * D + hd * 256;
    const int rt = wave >> 2, ct = wave & 3;
    u32x4 bhi, blo; float ab;
    { const int n = tid0 & 31, hh = (tid0 >> 5) & 1; float w[8];
#pragma unroll
      for (int j = 0; j < 8; ++j) w[j] = a.in[I_ALPHAW][(size_t)l * 16 * 512 + (8 * hh + j) * 512 + hd * 128 + 32 * ct + n];
      ab = a.in[I_ALPHAB][l * 512 + hd * 128 + 32 * ct + n];
      unsigned hi[4], lo[4];
#pragma unroll
      for (int j = 0; j < 4; ++j) { hi[j] = cvt_pk_bf16(w[2 * j], w[2 * j + 1]); lo[j] = cvt_pk_bf16(w[2 * j] - bflo(hi[j]), w[2 * j + 1] - bfhi(hi[j])); }
      bhi.x = hi[0]; bhi.y = hi[1]; bhi.z = hi[2]; bhi.w = hi[3]; blo.x = lo[0]; blo.y = lo[1]; blo.z = lo[2]; blo.w = lo[3]; }
    asm volatile("" : "+v"(bhi), "+v"(blo), "+v"(ab));
    LAS float* nwt = (LAS float*)(F.lds + MX_END);
    if (tid0 < 256) nwt[tid0] = a.in[I_GNORMW][l * D + hd * 256 + tid0];
    f32x16 C[4];
#pragma unroll
    for (int dt = 0; dt < 4; ++dt)
#pragma unroll
        for (int i = 0; i < 16; ++i) C[dt][i] = 0.f;
    LAS float* rgt = bcl;
    if (tid0 < 256) *(LAS f32x4*)(rgt + tid0 * 4) = *(const f32x4*)(SMALL + (size_t)(tid0 >> 2) * 32 + 8 + (tid0 & 3) * 4);
    MX_SYNC();
    dma_qk(lds, MX_Q, QKG + hd * 128, 0, wave, F.lane); dma_qk(lds, MX_K, QKG + 512 + hd * 128, 0, wave, F.lane); dma_v(lds, VG, 0, wave, F.lane);
#ifdef MX_PROBE_ON
    unsigned long long tacc[6] = {0, 0, 0, 0, 0, 0}; unsigned long long tlast = MX_NOW();
#endif
    for (int c = 0; c < S / 64; ++c) {
        const int t0 = c * 64;
        int lz = 0; asm volatile("" : "+v"(lz)); const int lane = F.lane + lz, tid = F.tid + lz, h = lane >> 5, l31 = lane & 31, rg = tid >> 5, cg = tid & 31, d0 = 8 * (cg & 15), dcol = tid & 127; const bool isq = cg < 16;
        const int gcol = (isq ? 0 : 512) + hd * 128 + d0;
        float lac[16]; float ctot;
        { const LAS float* rp = rgt + (32 * rt + l31) * 16 + 8 * h;
          const f32x4 r0 = *(const LAS f32x4*)rp, r1 = *(const LAS f32x4*)(rp + 4);
          u32x4 ahi, alo;
          ahi.x = cvt_pk_bf16(r0.x, r0.y); ahi.y = cvt_pk_bf16(r0.z, r0.w); ahi.z = cvt_pk_bf16(r1.x, r1.y); ahi.w = cvt_pk_bf16(r1.z, r1.w);
          alo.x = cvt_pk_bf16(r0.x - bflo(ahi.x), r0.y - bfhi(ahi.x)); alo.y = cvt_pk_bf16(r0.z - bflo(ahi.y), r0.w - bfhi(ahi.y));
          alo.z = cvt_pk_bf16(r1.x - bflo(ahi.z), r1.y - bfhi(ahi.z)); alo.w = cvt_pk_bf16(r1.z - bflo(ahi.w), r1.w - bfhi(ahi.w));
          f32x16 x;
#pragma unroll
          for (int i = 0; i < 16; ++i) x[i] = 0.f;
          x = MFMA32(__builtin_bit_cast(bf16x8, alo), __builtin_bit_cast(bf16x8, bhi), x);
          x = MFMA32(__builtin_bit_cast(bf16x8, ahi), __builtin_bit_cast(bf16x8, blo), x);
          x = MFMA32(__builtin_bit_cast(bf16x8, ahi), __builtin_bit_cast(bf16x8, bhi), x);
          float gs[4], go[4];
#pragma unroll
          for (int g = 0; g < 4; ++g) { float run = 0.f;
#pragma unroll
              for (int p = 0; p < 4; ++p) { run += flogsigmoid(x[4 * g + p] + ab) * (1.f / 16.f); lac[4 * g + p] = run; }
              gs[g] = run; }
#pragma unroll
          for (int g = 0; g < 4; ++g) go[g] = __shfl_xor(gs[g], 32);
          float off = 0.f;
#pragma unroll
          for (int g = 0; g < 4; ++g) { const float lo_ = h ? go[g] : gs[g], hi_ = h ? gs[g] : go[g];
              const float base = h ? off + lo_ : off;
#pragma unroll
              for (int p = 0; p < 4; ++p) lac[4 * g + p] += base;
              off = (off + lo_) + hi_; }
          ctot = off;
          if (rt == 0 && h == 0) sm[SM_QTOT + 32 * ct + l31] = ctot; }
        MX_BAR(); MX_T(0);
        { const int dcol = 32 * ct + l31; const float pre = rt ? sm[SM_QTOT + dcol] : 0.f;
#pragma unroll
          for (int i = 0; i < 16; ++i) bcl[(32 * rt + (i & 3) + 8 * (i >> 2) + 4 * h) * 132 + dcol] = pre + lac[i];
          if (rt == 1 && h == 0) { const float gc = pre + ctot; sm[SM_GC + dcol] = gc; sm[SM_EGC + dcol] = __expf(gc); } }
        MX_VWAIT0();
        MX_BAR(); MX_T(1);
        { const bool q_role = wave < 4; const int t1 = tid & 255, rg1 = t1 >> 4, d1 = 8 * (t1 & 15);
          float egv[8];
          { const f32x4 g0 = *(const LAS f32x4*)(sm + SM_EGC + d1), g1 = *(const LAS f32x4*)(sm + SM_EGC + d1 + 4); egv[0] = g0.x; egv[1] = g0.y; egv[2] = g0.z; egv[3] = g0.w; egv[4] = g1.x; egv[5] = g1.y; egv[6] = g1.z; egv[7] = g1.w; }
#pragma unroll
          for (int r = 0; r < 4; ++r) { const int row = 4 * rg1 + r;
            float x[8], e[8], y[8];
            LAS unsigned char* img = lds + (q_role ? MX_Q : MX_K) + row * MX_QS + d1 * 2;
            const u32x4 praw = *(const LAS u32x4*)img;
#pragma unroll
            for (int j = 0; j < 8; ++j) { const unsigned wd = praw[j >> 1]; x[j] = (j & 1) ? bfhi(wd) : bflo(wd); }
            { const f32x4 e0 = *(const LAS f32x4*)(bcl + row * 132 + d1), e1 = *(const LAS f32x4*)(bcl + row * 132 + d1 + 4);
              e[0] = e0.x; e[1] = e0.y; e[2] = e0.z; e[3] = e0.w; e[4] = e1.x; e[5] = e1.y; e[6] = e1.z; e[7] = e1.w; }
            if (q_role) {
#pragma unroll
                for (int j = 0; j < 8; ++j) y[j] = x[j] * 0.08838834764831845f * __expf(e[j]);
                *(LAS u32x4*)img = pack8(y); }
            else {
#pragma unroll
                for (int j = 0; j < 8; ++j) y[j] = x[j] * __expf(-e[j]);
                *(LAS u32x4*)img = pack8(y);
#pragma unroll
                for (int j = 0; j < 8; ++j) y[j] *= egv[j];
                *(LAS u32x4*)(lds + MX_KU + row * MX_QS + d1 * 2) = pack8(y); }
          } }
        MX_BAR(); MX_T(2);
        chunk_scores<false>(lds, sm, lane, wave);
        MX_BAR(); MX_T(3);
        if (c + 1 < S / 64) dma_qk(lds, MX_K, QKG + 512 + hd * 128, t0 + 64, wave, lane);
        bf16x8 vf[4]; load_vf(lds, lane, wave, vf);
        f32x16 acc1[2];
#pragma unroll
        for (int lt = 0; lt < 2; ++lt) { f32x16 a2; chunk_out<true>(lds, lane, lt, C, vf, acc1[lt], a2);
            const int ll = 32 * lt + l31; float ssq = 0.f;
#pragma unroll
            for (int r = 0; r < 16; ++r) ssq += acc1[lt][r] * acc1[lt][r];
            ssq += __shfl_xor(ssq, 32);
            if (h == 0) sm[SM_SSQ + wave * 64 + ll] = ssq; }
        asm volatile("" ::: "memory"); __builtin_amdgcn_sched_barrier(0);
        f32x4 rgn = (f32x4){0.f, 0.f, 0.f, 0.f};
        if (c + 1 < S / 64 && tid < 256) rgn = *(const f32x4*)(SMALL + (size_t)(t0 + 64 + (tid >> 2)) * 32 + 8 + (tid & 3) * 4);
        u32x4 zg[2][2];
#pragma unroll
        for (int lt = 0; lt < 2; ++lt)
#pragma unroll
            for (int g = 0; g < 2; ++g) zg[lt][g] = *(const u32x4*)(ZG + (size_t)(t0 + 32 * lt + l31) * D + 32 * wave + 16 * h + 8 * g);
#pragma unroll
        for (int dt = 0; dt < 4; ++dt)
#pragma unroll
            for (int g = 0; g < 4; ++g) { const f32x4 eg = *(const LAS f32x4*)(sm + SM_EGC + 32 * dt + 8 * g + 4 * h);
                C[dt][4 * g] *= eg.x; C[dt][4 * g + 1] *= eg.y; C[dt][4 * g + 2] *= eg.z; C[dt][4 * g + 3] *= eg.w; }
        chunk_update(lds, lane, C, vf);
        if (tid < 256) *(LAS f32x4*)(rgt + tid * 4) = rgn;
        MX_BAR(); MX_T(4);
        if (c + 1 < S / 64) { dma_qk(lds, MX_Q, QKG + hd * 128, t0 + 64, wave, lane); dma_v(lds, VG, t0 + 64, wave, lane); }
#pragma unroll
        for (int lt = 0; lt < 2; ++lt) { const int ll = 32 * lt + l31; float st = 0.f;
#pragma unroll
            for (int w = 0; w < 8; ++w) st += sm[SM_SSQ + w * 64 + ll];
            const float rn = rsqrtf(st * (1.f / 256.f) + EPS);
            const size_t ro = (size_t)(t0 + ll) * D + 32 * wave + 16 * h;
#pragma unroll
            for (int g = 0; g < 2; ++g) { const u32x4 zv = zg[lt][g];
                const f32x4 nwa = *(const LAS f32x4*)(nwt + 32 * wave + 16 * h + 8 * g), nwb = *(const LAS f32x4*)(nwt + 32 * wave + 16 * h + 8 * g + 4);
                float o[8];
                o[0] = acc1[lt][8 * g] * rn * nwa.x * bflo(zv.x); o[1] = acc1[lt][8 * g + 1] * rn * nwa.y * bfhi(zv.x);
                o[2] = acc1[lt][8 * g + 2] * rn * nwa.z * bflo(zv.y); o[3] = acc1[lt][8 * g + 3] * rn * nwa.w * bfhi(zv.y);
                o[4] = acc1[lt][8 * g + 4] * rn * nwb.x * bflo(zv.z); o[5] = acc1[lt][8 * g + 5] * rn * nwb.y * bfhi(zv.z);
                o[6] = acc1[lt][8 * g + 6] * rn * nwb.z * bflo(zv.w); o[7] = acc1[lt][8 * g + 7] * rn * nwb.w * bfhi(zv.w);
                *(u32x4*)(O + ro + 8 * g) = pack8(o); } }
        MX_T(5);
    }
#ifdef MX_PROBE_ON
    if (threadIdx.x == 0 && (b == 0 && hd == 0)) { unsigned long long* tp = (unsigned long long*)(F.ws + WS_CTL + 4 * CW_STAMP) + 56; for (int i = 0; i < 6; ++i) tp[i] = tacc[i]; }
#endif
}
__device__ __forceinline__ void p_mixers(const Args& a, Frame& F, int l) {
    if (F.G > 128 && F.bid >= 128) {
        const int gw = (F.bid - 128) * NWAVES + F.wave, NGW = (F.G - 128) * NWAVES;
        LAS float* scr = (LAS float*)(F.lds + F.wave * 8704);
        if (l == 0) for (int it = gw; it < SW_DEFER0; it += NGW) small_deferred0(a, F.ws, it, scr, F.lane);
        for (int it = gw; it < EX_ITEMS; it += NGW) expert_item(a, F.ws, l, it, scr, F.lane);
        asm volatile("s_waitcnt vmcnt(0) lgkmcnt(0)" ::: "memory"); __syncthreads();
        p_gates_a_idle(F, l);
        return;
    }
    for (int s = F.bid; s < 128; s += F.G) {
        MX_SYNC();
        if (s < 64) mlstm_chunked(a, F, l, s >> 2, s & 3, (bf16_t*)(F.ws + WS_PB + 2 * PB_STRIDE));
        else gla_chunked(a, F, l, (s - 64) >> 2, s & 3, (bf16_t*)(F.ws + WS_PB + 5 * PB_STRIDE));
    }
    if (F.G <= 128) {
        MX_SYNC();
        const int gw = F.bid * NWAVES + F.wave, NGW = F.G * NWAVES; LAS float* scr = (LAS float*)(F.lds + F.wave * 8704);
        if (l == 0) { for (int it = gw; it < SW_DEFER0; it += NGW) small_deferred0(a, F.ws, it, scr, F.lane); for (int it = gw; it < SW_ITEMS; it += NGW) small_item(a, F.ws, 1, it, scr, F.lane); }
        for (int it = gw; it < EX_ITEMS; it += NGW) expert_item(a, F.ws, l, it, scr, F.lane);
    }
}

#ifdef MK_TEST_MIXERS
__device__ __forceinline__ void p_mixers_test(const Args& a, Frame& F, int l) {
    for (int s = F.bid; s < 128; s += F.G) {
        int sel = -1;
        if (s == 5) sel = 0; else if (s == 38) sel = 1; else if (s == 64 + 9) sel = 2; else if (s == 64 + 50) sel = 3;
        bf16_t* ref = (bf16_t*)(F.ws + WS_LOGITS) + (size_t)(sel < 0 ? 0 : sel) * S * 256;
        MX_SYNC();
        if (sel >= 0) { if (s < 64) mlstm_seq(a, F, l, s >> 2, s & 3, ref, 256); else gla_seq(a, F, l, (s - 64) >> 2, s & 3, ref, 256); }
        MX_SYNC();
        if (s < 64) mlstm_chunked(a, F, l, s >> 2, s & 3, (bf16_t*)(F.ws + WS_PB + 2 * PB_STRIDE));
        else gla_chunked(a, F, l, (s - 64) >> 2, s & 3, (bf16_t*)(F.ws + WS_PB + 5 * PB_STRIDE));
        MX_SYNC();
        __builtin_amdgcn_fence(__ATOMIC_ACQUIRE, "agent"); asm volatile("s_waitcnt vmcnt(0)" ::: "memory");
        if (sel >= 0) {
            const int bb = (s < 64 ? s : s - 64) >> 2, hd = s & 3;
            const bf16_t* got = (const bf16_t*)(F.ws + WS_PB + (s < 64 ? 2 : 5) * PB_STRIDE) + (size_t)bb * S * D + hd * 256;
            float sd = 0.f, sr = 0.f;
            for (int i = F.tid; i < S * 256; i += NTHREADS) { const int t = i >> 8, e = i & 255; const float g = bf2f(got[(size_t)t * D + e]), r = bf2f(ref[i]); sd += (g - r) * (g - r); sr += r * r; }
            sd = wave_sum(sd); sr = wave_sum(sr);
            float* err = (float*)(F.ws + WS_CTL) + CW_ERR;
            if (F.lane == 0) { atomicAdd(&err[2], sd); atomicAdd(&err[3], sr); }
        }
    }
}
#endif

#ifdef MK_DUP_MIX
__device__ __forceinline__ void p_mixers_dummy(const Args& a, Frame& F, int l) {
    for (int s = F.bid; s < 128; s += F.G) {
        MX_SYNC();
        bf16_t* dump = (bf16_t*)(F.ws + WS_LOGITS) - ((size_t)((s & 63) >> 2) * S * D + (s & 3) * 256);
#if MK_DUP_MIX == 2
        if (s < 64) mlstm_chunked(a, F, l, s >> 2, s & 3, dump);
#elif MK_DUP_MIX == 3
        if (s >= 64) gla_chunked(a, F, l, (s - 64) >> 2, s & 3, dump);
#else
        if (s < 64) mlstm_chunked(a, F, l, s >> 2, s & 3, dump); else gla_chunked(a, F, l, (s - 64) >> 2, s & 3, dump);
#endif
    }
}
#endif
__global__ void __launch_bounds__(NTHREADS, 2) mega(Args a) {
    extern __shared__ __attribute__((aligned(16))) unsigned char lds_raw[];
    Frame F; F.lds = (LAS unsigned char*)lds_raw; F.ws = a.ws; F.tid = threadIdx.x; F.lane = F.tid & 63; F.wave = __builtin_amdgcn_readfirstlane(F.tid >> 6); F.G = gridDim.x; F.bid = blockIdx.x;
    volatile LAS unsigned* xbw = (volatile LAS unsigned*)(F.lds + MISC_OFF);
    if (F.tid < 4) xbw[F.tid] = 0u;
    __syncthreads();
    XcdBarrier bar; bar.bar = (unsigned*)(F.ws + WS_CTL) + CW_BAR; bar.x = 0; bar.st = xbw;
#if MK_N_LAUNCHES == 1
    bar = xcd_barrier_post((unsigned*)(F.ws + WS_CTL) + CW_BAR, xbw);
#define IN(k) true
#if defined(MK_PROBE) || defined(MK_TPROBE)
#define STAMP() do { if (blockIdx.x == 0 && threadIdx.x == 0) { ((unsigned long long*)(a.ws + WS_CTL + 4 * CW_STAMP))[sidx] = wall_clock64(); } ++sidx; } while (0)
#else
#define STAMP() do { } while (0)
#endif
#ifdef MK_DUP_BAR
#define EXTRA_BAR(b) xcd_barrier(b);
#else
#define EXTRA_BAR(b)
#endif
#define SEAM() do { XcdBarrier b2_ = bar; unsigned long long zb_ = 0; asm volatile("" : "+s"(zb_)); b2_.bar = bar.bar + zb_; b2_.x = bar.x + (unsigned)zb_; b2_.st = bar.st + (unsigned)zb_; xcd_barrier(b2_); STAMP(); EXTRA_BAR(b2_) } while (0)
#else
    const int lo = a.ph_lo, hi = a.ph_hi;
#define IN(k) (lo <= (k) && (k) < hi)
#define SEAM() do { } while (0)
#endif
#define PH_BEGIN() do { int t_ = threadIdx.x; asm volatile("" : "+v"(t_)); F.tid = t_; F.lane = t_ & 63; F.wave = __builtin_amdgcn_readfirstlane(t_ >> 6); \
        unsigned long long z_ = 0; asm volatile("" : "+s"(z_)); F.ws = a.ws + z_; F.G = (int)gridDim.x + (int)z_; F.bid = (int)blockIdx.x + (int)z_; F.lds = (LAS unsigned char*)lds_raw + (unsigned)z_; } while (0)
    int sidx = 0; STAMP();
    if (IN(0)) { PH_BEGIN(); p0a(a, F, false); SEAM(); }
#ifdef MK_DUP_CVT
    { PH_BEGIN(); p0a(a, F, false); SEAM(); }
#endif
#ifdef MK_DUP_GEMM
#define DUPGK(k, x) if ((MK_DUP_GEMM >> (k)) & 1) { PH_BEGIN(); x; SEAM(); }
#else
#define DUPGK(k, x)
#endif
#ifdef MK_DUP_CVT
#define DUP_CVT2(a, F) PH_BEGIN(); p_expert_cvt(a, F, 1); SEAM();
#else
#define DUP_CVT2(a, F)
#endif
#ifdef MK_DUP_MIX
#define DUPM(a, F, l) PH_BEGIN(); p_mixers_dummy(a, F, l); SEAM();
#else
#define DUPM(a, F, l)
#endif
#ifdef MK_TEST_MIXERS
#define MIXERS p_mixers_test
#else
#define MIXERS p_mixers
#endif
#if defined(MK_TPROBE)
#define TSTAMP_WG(l) do { __syncthreads(); if (threadIdx.x == 0 && (blockIdx.x == 0 || blockIdx.x == 64 || blockIdx.x == 128)) ((unsigned long long*)(a.ws + WS_CTL + 4 * CW_STAMP))[40 + 3 * l + (blockIdx.x >> 6)] = wall_clock64(); } while (0)
#else
#define TSTAMP_WG(l) do { } while (0)
#endif
#define LAYER_BODY(l) \
        if (IN(1)) { PH_BEGIN(); \
            const float* ada = (const float*)(F.ws + WS_ADA) + (size_t)l * NB * 6 * D; \
            p_norm(F, l == 0 ? a.in[I_X] : a.out, a.in[I_NMIXW] + l * D, ada + 0 * D, ada + 1 * D, (bf16_t*)(F.ws + WS_U)); \
            SEAM(); \
        } \
        if (IN(2)) { PH_BEGIN(); p_inproj(F, l); SEAM(); DUPGK(2, p_inproj(F, l)) } \
        if (IN(3)) { DUPM(a, F, l) PH_BEGIN(); MIXERS(a, F, l); TSTAMP_WG(l); SEAM(); } \
        if (IN(4) && (int)gridDim.x <= 128) { PH_BEGIN(); p_gates(F, l); SEAM(); } \
        if (IN(5)) { PH_BEGIN(); p_y(F, l); SEAM(); DUPGK(5, p_y(F, l)) } \
        if (IN(6)) { PH_BEGIN(); p_wo(a, F, l); SEAM(); } \
        if (IN(7)) { PH_BEGIN(); p_norm2(a, F, l); SEAM(); } \
        if (IN(8)) { PH_BEGIN(); p_router(a, F, l); SEAM(); DUPGK(8, p_router(a, F, l)) } \
        if (IN(9)) { PH_BEGIN(); p_topk(a, F, l); SEAM(); } \
        if (IN(10)) { PH_BEGIN(); p_fill(F, l); SEAM(); } \
        if (IN(11)) { PH_BEGIN(); p_gemm1(F, l); SEAM(); DUPGK(11, p_gemm1(F, l)) } \
        if (IN(12)) { PH_BEGIN(); p_gemm2(F, l); SEAM(); DUPGK(12, p_gemm2(F, l)) } \
        if (IN(13)) { PH_BEGIN(); if (l == DEPTH - 1) p_combine<true>(a, F, l); else { p_combine<false>(a, F, l); SEAM(); } }
#if MK_N_LAUNCHES == 1
    { LAYER_BODY(0) }
    { LAYER_BODY(1) }
#else
    for (int l_ = a.l_lo; l_ < a.l_hi; ++l_) { const int l = l_; LAYER_BODY(l) }
#endif
#undef LAYER_BODY
#if defined(MK_TEST_MIXERS) || defined(MK_PROBE)
    { SEAM(); PH_BEGIN(); p_final_scale(a, F); }
#endif
#if defined(MK_TPROBE)
    { SEAM();
      if (blockIdx.x == 0 && threadIdx.x == 0) {
          unsigned long long* st = (unsigned long long*)(a.ws + WS_CTL + 4 * CW_STAMP); unsigned long long tot = 0;
          for (int i = 0; i < 27; ++i) if ((MK_TPROBE >> i) & 1ull) tot += __hip_atomic_load(st + i + 1, __ATOMIC_RELAXED, __HIP_MEMORY_SCOPE_AGENT) - __hip_atomic_load(st + i, __ATOMIC_RELAXED, __HIP_MEMORY_SCOPE_AGENT);
          for (int j = 0; j < 6; ++j) if ((MK_TPROBE >> (27 + j)) & 1ull) tot += __hip_atomic_load(st + 40 + j, __ATOMIC_RELAXED, __HIP_MEMORY_SCOPE_AGENT) - __hip_atomic_load(st + 3 + 12 * (j / 3), __ATOMIC_RELAXED, __HIP_MEMORY_SCOPE_AGENT);
          for (int j = 0; j < 12; ++j) if ((MK_TPROBE >> (33 + j)) & 1ull) tot += __hip_atomic_load(st + 48 + (j / 6) * 8 + (j % 6), __ATOMIC_RELAXED, __HIP_MEMORY_SCOPE_AGENT);
          tot *= MK_TPROBE_K; const unsigned long long t0 = wall_clock64();
          while (wall_clock64() - t0 < tot) __builtin_amdgcn_s_sleep(20);
      } }
#endif
#undef IN
#undef SEAM
#undef PH_BEGIN
}


extern "C" void kernel_launch(void* const* d_in, const int* in_sizes, int n_in, void* d_out, int out_size, void* d_ws, size_t ws_size, hipStream_t stream) {
    static int grid = 0;
    if (grid == 0) {
        if (ws_size < WS_OPT_END || n_in != 25 || out_size != T * D) { fprintf(stderr, "kernel_launch: unexpected problem (ws %zu, n_in %d, out %d)\n", ws_size, n_in, out_size); grid = -1; return; }
        int dev = 0, cus = 0, per_cu = 0;
        if (hipGetDevice(&dev) != hipSuccess || hipDeviceGetAttribute(&cus, hipDeviceAttributeMultiprocessorCount, dev) != hipSuccess) { grid = -1; return; }
        if (hipFuncSetAttribute((const void*)mega, hipFuncAttributeMaxDynamicSharedMemorySize, LDS_BYTES) != hipSuccess) { fprintf(stderr, "kernel_launch: hipFuncSetAttribute failed\n"); grid = -1; return; }
        if (hipOccupancyMaxActiveBlocksPerMultiprocessor(&per_cu, (const void*)mega, NTHREADS, LDS_BYTES) != hipSuccess || per_cu < 1) { fprintf(stderr, "kernel_launch: occupancy query says %d\n", per_cu); grid = -1; (void)hipGetLastError(); return; }
        grid = cus;
    }
    if (grid < 0) return;
    Args a{}; for (int i = 0; i < 25; ++i) a.in[i] = (const float*)d_in[i]; a.out = (float*)d_out; a.ws = (unsigned char*)d_ws;
    hipMemsetAsync((char*)d_ws + WS_CTL, 0, CTL_BYTES, stream);
#if MK_N_LAUNCHES == 1
    a.ph_lo = 0; a.ph_hi = 18; a.l_lo = 0; a.l_hi = DEPTH;
    hipLaunchKernelGGL(mega, dim3(grid), dim3(NTHREADS), LDS_BYTES, stream, a);
#else
    auto launch = [&](int ph, int l) { Args b = a; b.ph_lo = ph; b.ph_hi = ph + 1; b.l_lo = l; b.l_hi = l + 1; hipLaunchKernelGGL(mega, dim3(grid), dim3(NTHREADS), LDS_BYTES, stream, b); };
    launch(0, 0);
    for (int l = 0; l < DEPTH; ++l) { for (int ph = 1; ph <= 15; ++ph) launch(ph, l); if (l == 0) launch(16, 0); }
    launch(17, 0);
#endif
}
```
